# Optimizing an MI355X kernel written in HIP

```python
import jax, jax.numpy as jnp
from jax import lax
import numpy as np

D_MODEL = 1024
BATCH = 32
SEQ = 2048
DEPTH = 1

HG_HEADS = 4
HG_DK = 128
HG_DV = 128
HG_CHUNK = 64
HG_QK_WIDTH = HG_HEADS * HG_DK
HG_V_WIDTH = HG_HEADS * HG_DV
ATT_Q_HEADS = 8
ATT_KV_HEADS = 2
ATT_GROUP = ATT_Q_HEADS // ATT_KV_HEADS
ATT_HEAD_DIM = 64
ATT_Q_WIDTH = ATT_Q_HEADS * ATT_HEAD_DIM
ATT_KV_WIDTH = ATT_KV_HEADS * ATT_HEAD_DIM
WINDOW = 128
ATT_BLOCK = 128
PROJ_SIZES = (HG_QK_WIDTH, HG_QK_WIDTH, HG_V_WIDTH, HG_V_WIDTH,
              ATT_Q_WIDTH, ATT_KV_WIDTH, ATT_KV_WIDTH, D_MODEL, D_MODEL)
PROJ_WIDTH = sum(PROJ_SIZES)
N_GROUPS = 4
EXPERTS_PER_GROUP = 8
N_EXPERTS = N_GROUPS * EXPERTS_PER_GROUP
TOP_K_IN_GROUP = 2
D_EXPERT = 512
MOE_BLOCK = 256
DN_ALPHA = (2.0 * DEPTH) ** 0.25
DN_BETA = (8.0 * DEPTH) ** -0.25
LN_EPS = 1e-5
RMS_EPS = 1e-6
NEG_INF = -1e30

kernel_name = "hybrid_hgrn2_swa_hiermoe_deepnorm"


def layer_norm(x, g, b):
    xf = x.astype(jnp.float32)
    mu = jnp.mean(xf, axis=-1, keepdims=True)
    var = jnp.mean(jnp.square(xf - mu), axis=-1, keepdims=True)
    return ((xf - mu) * lax.rsqrt(var + LN_EPS) * g.astype(jnp.float32) + b.astype(jnp.float32)).astype(x.dtype)


def hgrn2(q, f_logit, inp, g, lb, norm_w):
    B, S, _ = q.shape
    nc = S // HG_CHUNK
    f32 = jnp.float32
    qf = jax.nn.silu(q.astype(f32))
    f = lb + (1.0 - lb) * jax.nn.sigmoid(f_logit.astype(f32))
    logf = jnp.log(f)
    k = 1.0 - f

    def to_chunks(t, d):
        return t.reshape(B, nc, HG_CHUNK, HG_HEADS, d).transpose(1, 0, 3, 2, 4)

    qc = to_chunks(qf, HG_DK)
    kc = to_chunks(k, HG_DK)
    lc = to_chunks(logf, HG_DK)
    vc = to_chunks(inp.astype(f32), HG_DV)
    tri = jnp.tril(jnp.ones((HG_CHUNK, HG_CHUNK), dtype=bool))

    def step(state, xs):
        qb, kb, vb, lb_c = xs
        b = jnp.cumsum(lb_c, axis=2)
        o_inter = jnp.einsum('bhtk,bhkv->bhtv', qb * jnp.exp(b), state)
        diff = b[:, :, :, None, :] - b[:, :, None, :, :]
        decay = jnp.exp(jnp.where(tri[:, :, None], diff, -jnp.inf))
        scores = jnp.einsum('bhtk,bhtsk,bhsk->bhts', qb, decay, kb)
        o_intra = jnp.einsum('bhts,bhsv->bhtv', scores, vb)
        b_last = b[:, :, -1:, :]
        new_state = (jnp.exp(b_last[:, :, 0, :])[..., None] * state
                     + jnp.einsum('bhsk,bhsv->bhkv', kb * jnp.exp(b_last - b), vb))
        return new_state, o_inter + o_intra

    s0 = jnp.zeros((B, HG_HEADS, HG_DK, HG_DV), f32)
    _, o = lax.scan(step, s0, (qc, kc, vc, lc))
    o = o.transpose(1, 0, 3, 2, 4).reshape(B, S, HG_HEADS, HG_DV)
    o = o * lax.rsqrt(jnp.mean(jnp.square(o), axis=-1, keepdims=True) + RMS_EPS) * norm_w.astype(f32)
    o = o * jax.nn.silu(g.astype(f32).reshape(B, S, HG_HEADS, HG_DV))
    return o.reshape(B, S, HG_V_WIDTH).astype(q.dtype)


def sliding_window_attention(q, k, v, sinks):
    B, S, _ = q.shape
    nb = S // ATT_BLOCK
    f32 = jnp.float32
    qb = q.reshape(B, nb, ATT_BLOCK, ATT_KV_HEADS, ATT_GROUP, ATT_HEAD_DIM)
    pad = ((0, 0), (ATT_BLOCK, 0), (0, 0))
    kp = jnp.pad(k, pad).reshape(B, nb + 1, ATT_BLOCK, ATT_KV_HEADS, ATT_HEAD_DIM)
    vp = jnp.pad(v, pad).reshape(B, nb + 1, ATT_BLOCK, ATT_KV_HEADS, ATT_HEAD_DIM)
    kb = jnp.concatenate([kp[:, :-1], kp[:, 1:]], axis=2)
    vb = jnp.concatenate([vp[:, :-1], vp[:, 1:]], axis=2)
    scale = ATT_HEAD_DIM ** -0.5
    scores = jnp.einsum('bnqhgd,bnkhd->bnhgqk', qb, kb).astype(f32) * scale
    dist = (jnp.arange(ATT_BLOCK)[:, None] + ATT_BLOCK - jnp.arange(2 * ATT_BLOCK)[None, :])
    key_pos = jnp.arange(nb)[:, None] * ATT_BLOCK - ATT_BLOCK + jnp.arange(2 * ATT_BLOCK)[None, :]
    valid = ((dist >= 0) & (dist < WINDOW))[None] & (key_pos >= 0)[:, None, :]
    slopes = jnp.exp2(-8.0 * (jnp.arange(ATT_Q_HEADS, dtype=f32) + 1.0) / ATT_Q_HEADS)
    alibi = slopes.reshape(ATT_KV_HEADS, ATT_GROUP, 1, 1) * dist.astype(f32)
    logits = jnp.where(valid[None, :, None, None], scores - alibi, NEG_INF)
    sink_col = jnp.broadcast_to(sinks.astype(f32).reshape(ATT_KV_HEADS, ATT_GROUP, 1, 1),
                                logits.shape[:-1] + (1,))
    probs = jax.nn.softmax(jnp.concatenate([logits, sink_col], axis=-1), axis=-1)[..., :-1]
    out = jnp.einsum('bnhgqk,bnkhd->bnqhgd', probs.astype(v.dtype), vb)
    return out.reshape(B, S, ATT_Q_WIDTH)


def hierarchical_moe(x, w_rg, b_rg, w_re, b_re, w_gate, w_up, w_down):
    B, S, D = x.shape
    T = B * S
    A = T * TOP_K_IN_GROUP
    P = A + N_EXPERTS * MOE_BLOCK
    NB = P // MOE_BLOCK
    f32 = jnp.float32
    xt = x.reshape(T, D)
    glog = (xt @ w_rg + b_rg).astype(f32)
    gprob = jax.nn.softmax(glog, axis=-1)
    gval, gsel = lax.top_k(glog, 1)
    gw = jnp.take_along_axis(gprob, gsel, axis=-1)
    elog = (xt @ w_re + b_re).astype(f32).reshape(T, N_GROUPS, EXPERTS_PER_GROUP)
    elog_sel = jnp.take_along_axis(elog, gsel[:, :, None], axis=1)[:, 0]
    top_v, top_i = lax.top_k(elog_sel, TOP_K_IN_GROUP)
    weights = gw * jax.nn.softmax(top_v, axis=-1)
    expert_id = (gsel * EXPERTS_PER_GROUP + top_i).astype(jnp.int32)

    flat_e = expert_id.reshape(-1)
    flat_tok = jnp.repeat(jnp.arange(T, dtype=jnp.int32), TOP_K_IN_GROUP)
    flat_w = weights.reshape(-1)
    order = jnp.argsort(flat_e)
    se = flat_e[order]
    counts = jnp.bincount(flat_e, length=N_EXPERTS)
    padded = ((counts + MOE_BLOCK - 1) // MOE_BLOCK) * MOE_BLOCK
    start = jnp.cumsum(counts) - counts
    pend = jnp.cumsum(padded)
    pstart = pend - padded
    dest = pstart[se] + (jnp.arange(A) - start[se])
    slot_tok = jnp.zeros((P,), jnp.int32).at[dest].set(flat_tok[order])
    slot_w = jnp.zeros((P,), f32).at[dest].set(flat_w[order])
    block_expert = jnp.clip(jnp.searchsorted(pend, jnp.arange(NB) * MOE_BLOCK, side='right'),
                            0, N_EXPERTS - 1)
    xbuf = xt[slot_tok].reshape(NB, MOE_BLOCK, D)

    def expert_block(args):
        xb, e = args
        h = jax.nn.silu(xb @ w_gate[e]) * (xb @ w_up[e])
        return h @ w_down[e]

    ybuf = lax.map(expert_block, (xbuf, block_expert)).reshape(P, D)
    y = jnp.zeros((T, D), x.dtype).at[slot_tok].add(ybuf * slot_w[:, None].astype(x.dtype))
    return y.reshape(B, S, D)


def setup_inputs(seed: int = 0) -> dict:
    key = jax.random.key(seed)
    ks = jax.random.split(key, 20)
    n = jax.random.normal
    f32 = jnp.float32
    L = DEPTH
    return {
        "x": n(ks[0], (BATCH, SEQ, D_MODEL), f32),
        "lb_logits": 0.1 * n(ks[1], (DEPTH + 1, HG_QK_WIDTH), f32),
        "w_in": n(ks[2], (L, D_MODEL, PROJ_WIDTH), f32) * D_MODEL ** -0.5,
        "hg_norm_w": 1.0 + 0.02 * n(ks[3], (L, HG_DV), f32),
        "sinks": 0.5 * n(ks[4], (L, ATT_Q_HEADS), f32),
        "w_branch_a": n(ks[5], (L, HG_V_WIDTH, D_MODEL), f32) * HG_V_WIDTH ** -0.5,
        "w_branch_b": n(ks[6], (L, ATT_Q_WIDTH, D_MODEL), f32) * ATT_Q_WIDTH ** -0.5,
        "w_out": n(ks[7], (L, D_MODEL, D_MODEL), f32) * (D_MODEL ** -0.5 * DN_BETA),
        "ln1_g": 1.0 + 0.02 * n(ks[8], (L, D_MODEL), f32),
        "ln1_b": 0.02 * n(ks[9], (L, D_MODEL), f32),
        "router_group_w": n(ks[10], (L, D_MODEL, N_GROUPS), f32) * D_MODEL ** -0.5,
        "router_group_b": 0.01 * n(ks[11], (L, N_GROUPS), f32),
        "router_expert_w": n(ks[12], (L, D_MODEL, N_EXPERTS), f32) * D_MODEL ** -0.5,
        "router_expert_b": 0.01 * n(ks[13], (L, N_EXPERTS), f32),
        "w_exp_gate": n(ks[14], (L, N_EXPERTS, D_MODEL, D_EXPERT), f32) * D_MODEL ** -0.5,
        "w_exp_up": n(ks[15], (L, N_EXPERTS, D_MODEL, D_EXPERT), f32) * D_MODEL ** -0.5,
        "w_exp_down": n(ks[16], (L, N_EXPERTS, D_EXPERT, D_MODEL), f32) * (D_EXPERT ** -0.5 * DN_BETA),
        "ln2_g": 1.0 + 0.02 * n(ks[17], (L, D_MODEL), f32),
        "ln2_b": 0.02 * n(ks[18], (L, D_MODEL), f32),
    }


def reference(x, lb_logits, w_in, hg_norm_w, sinks, w_branch_a, w_branch_b, w_out,
              ln1_g, ln1_b, router_group_w, router_group_b, router_expert_w, router_expert_b,
              w_exp_gate, w_exp_up, w_exp_down, ln2_g, ln2_b):
    split_idx = list(np.cumsum(PROJ_SIZES)[:-1])
    lb_all = jnp.cumsum(jax.nn.softmax(lb_logits.astype(jnp.float32), axis=0), axis=0)
    for l in range(DEPTH):
        proj = x @ w_in[l]
        hq, hf, hi, hg, aq, ak, av, ga, gb = jnp.split(proj, split_idx, axis=-1)
        y_a = hgrn2(hq, hf, hi, hg, lb_all[l], hg_norm_w[l]) @ w_branch_a[l]
        y_b = sliding_window_attention(aq, ak, av, sinks[l]) @ w_branch_b[l]
        merged = jax.nn.sigmoid(ga) * y_a + jax.nn.sigmoid(gb) * y_b
        x = layer_norm(DN_ALPHA * x + merged @ w_out[l], ln1_g[l], ln1_b[l])
        moe = hierarchical_moe(x, router_group_w[l], router_group_b[l], router_expert_w[l],
                               router_expert_b[l], w_exp_gate[l], w_exp_up[l], w_exp_down[l])
        x = layer_norm(DN_ALPHA * x + moe, ln2_g[l], ln2_b[l])
    return x
```

```cpp
#include <hip/hip_runtime.h>
#include <hip/hip_cooperative_groups.h>
#include <cstdio>
#include <cstdint>
namespace cg = cooperative_groups;

#ifndef NAIVE_GEMM
#define NAIVE_GEMM 1
#endif
#ifndef N_LAUNCH_MODE
#define N_LAUNCH_MODE 0
#endif

#define LAS __attribute__((address_space(3)))
typedef unsigned short bf16_t;
typedef short bf16x8 __attribute__((ext_vector_type(8)));
typedef float f32x4 __attribute__((ext_vector_type(4)));
typedef float f32x2 __attribute__((ext_vector_type(2)));
typedef unsigned u32x4 __attribute__((ext_vector_type(4)));
typedef unsigned u32x2 __attribute__((ext_vector_type(2)));

constexpr int T_ = 65536, DM = 1024, SEQ = 2048, NBATCH = 32;
constexpr int PW = 4864;
constexpr int NE = 32, DE = 512;
constexpr int CAP = 131072;
constexpr float DN_ALPHA = 1.189207115002721f;
constexpr float LN_EPS = 1e-5f, RMS_EPS = 1e-6f;
constexpr int NWAVES = 8, NTHREADS = 512;

constexpr size_t MiB = 1u << 20;
constexpr size_t WS_CTL = 0;
constexpr size_t WS_LB = 1 * MiB;
constexpr size_t WS_WIN = 2 * MiB;
constexpr size_t WS_WA = 12 * MiB;
constexpr size_t WS_WB = 13 * MiB;
constexpr size_t WS_WO = 14 * MiB;
constexpr size_t WS_WGU = 16 * MiB;
constexpr size_t WS_WD = 80 * MiB;
constexpr size_t WS_SLOT = 112 * MiB;
constexpr size_t WS_ASGW = 128 * MiB;
constexpr size_t WS_RA = 132 * MiB;
constexpr size_t WS_RB = 260 * MiB;
constexpr size_t WS_RC = 516 * MiB;
constexpr size_t WS_RD = 612 * MiB;
constexpr size_t WS_RE = 868 * MiB;
constexpr size_t WS_RF = 932 * MiB;
constexpr size_t WS_END = 996 * MiB;
constexpr int CW_CNT = 64;
constexpr int CW_ATTQ = 128;

constexpr int RING_BYTES = 131072;
constexpr int MISC_OFF = RING_BYTES;
constexpr int LDS_BYTES = 147456;

__device__ __forceinline__ float bf2f(bf16_t v) { return __uint_as_float((unsigned)v << 16); }
__device__ __forceinline__ unsigned f2bf(float f) { unsigned u = __float_as_uint(f); return (u + 0x7fffu + ((u >> 16) & 1u)) >> 16; }
__device__ __forceinline__ unsigned pk2(float lo, float hi) { return f2bf(lo) | (f2bf(hi) << 16); }
__device__ __forceinline__ float bflo(unsigned w) { return __uint_as_float(w << 16); }
__device__ __forceinline__ float bfhi(unsigned w) { return __uint_as_float(w & 0xffff0000u); }
__device__ __forceinline__ float sigm(float x) { return 1.f / (1.f + __expf(-x)); }
__device__ __forceinline__ float silu(float x) { return x / (1.f + __expf(-x)); }
__device__ __forceinline__ float wave_sum(float v) {
#pragma unroll
    for (int o = 1; o < 64; o <<= 1) v += __shfl_xor(v, o);
    return v;
}
__device__ __forceinline__ float wave_max(float v) {
#pragma unroll
    for (int o = 1; o < 64; o <<= 1) v = fmaxf(v, __shfl_xor(v, o));
    return v;
}
#define LDS_WAIT() asm volatile("s_waitcnt lgkmcnt(0)" ::: "memory")

constexpr int BM = 256, BK = 64, HALF = 128, HTB = HALF * BK * 2, NXCD = 8, WGM = 8;
__host__ __device__ __forceinline__ int lds_byte(int r, int c) { const int st = (r >> 4) * 2 + (c >> 5), rr = r & 15, cc = c & 31, ob = rr * 64 + cc * 2; return st * 1024 + (ob ^ (((ob >> 9) & 1) << 5)); }
__host__ __device__ __forceinline__ void stage_rc(int b, int& R, int& C) { const int st = b / 1024, sb = b % 1024, swz = sb ^ (((sb >> 9) & 1) << 5); R = (st >> 1) * 16 + swz / 64; C = (st & 1) * 32 + (swz % 64) / 2; }
__host__ __device__ __forceinline__ int perm32(int rho) { const int n = rho >> 4, i = rho & 15; return 8 * (i >> 2) + 4 * n + (i & 3); }

struct Unit { int pm, pn, e, mt; };

struct DenseProb {
    const char* Abase; const char* Bt; int K; int nM, nN, nwg, G, c;
    __device__ __forceinline__ void init(const void* A, const void* B, int M, int N, int K_, int G_, int c_) { Abase = (const char*)A; Bt = (const char*)B; K = K_; nM = M / BM; nN = N / BM; nwg = nM * nN; G = G_; c = c_; }
    __device__ __forceinline__ bool next(int i, Unit& u) const {
        const long L = (long)i * G + c; if (L >= nwg) return false;
        int wgid = (int)L; { const int q = nwg / NXCD, r = nwg % NXCD, xcd = wgid % NXCD, off = wgid / NXCD; wgid = (xcd < r ? xcd * (q + 1) : r * (q + 1) + (xcd - r) * q) + off; }
        const int nig = WGM * nN, gid = wgid / nig, fm = gid * WGM, gsz = (nM - fm) < WGM ? (nM - fm) : WGM;
        u.pm = fm + ((wgid % nig) % gsz); u.pn = (wgid % nig) / gsz; u.e = 0; u.mt = 0; return true;
    }
    __device__ __forceinline__ unsigned a_rowoff(const Unit& u, int r) const { return (unsigned)(u.pm * BM + r) * (unsigned)K * 2u; }
    __device__ __forceinline__ const char* b_base(const Unit& u) const { return Bt + (size_t)u.pn * BM * K * 2; }
};

template <bool GATHER> struct MoeProb {
    const char* Abase; const char* Bt; int K; int G, c; const LAS int* tp; const LAS int* cn; const int* slot; size_t estride;
    __device__ __forceinline__ bool next(int i, Unit& u) const {
        const int L = i * G + c; const int total = tp[32] * 4; if (L >= total) return false;
        const int tau = L >> 2; int e = 0;
        for (int j = 1; j < 32; ++j) e = (tau >= tp[j]) ? j : e;
        u.pm = tau; u.pn = L & 3; u.e = __builtin_amdgcn_readfirstlane(e); u.mt = __builtin_amdgcn_readfirstlane(tau - tp[e]); return true;
    }
    __device__ __forceinline__ unsigned a_rowoff(const Unit& u, int r) const {
        if (GATHER) { const int s = u.mt * BM + r; const int asg = (s < cn[u.e]) ? slot[(size_t)u.e * CAP + s] : 0; return (unsigned)(asg >> 1) * (unsigned)K * 2u; }
        else return (unsigned)(u.pm * BM + r) * (unsigned)K * 2u;
    }
    __device__ __forceinline__ const char* b_base(const Unit& u) const { return Bt + (size_t)u.e * estride + (size_t)u.pn * BM * K * 2; }
};

struct EpiProj {
    static constexpr bool PERM = true;
    bf16_t* HB; bf16_t* AB; bf16_t* GB; const float* lb;
    template <int MODE> __device__ __forceinline__ void run(const f32x4 (&acc)[2][4][2], bf16_t* base, int ld, int row0, int col0, int lbcol) const {
#pragma unroll
        for (int bj = 0; bj < 2; ++bj) {
            float l8[8];
            if (MODE == 2) {
#pragma unroll
                for (int j = 0; j < 8; ++j) l8[j] = lb[lbcol + bj * HALF + j];
            }
#pragma unroll
            for (int m = 0; m < 4; ++m) {
                float v[8];
#pragma unroll
                for (int j = 0; j < 4; ++j) { v[j] = acc[bj][m][0][j]; v[4 + j] = acc[bj][m][1][j]; }
#pragma unroll
                for (int j = 0; j < 8; ++j) {
                    if (MODE == 1) v[j] = silu(v[j]);
                    else if (MODE == 2) v[j] = __logf(l8[j] + (1.f - l8[j]) * sigm(v[j]));
                    else if (MODE == 3) v[j] = v[j] * 0.125f;
                    else if (MODE == 4) v[j] = sigm(v[j]);
                }
                u32x4 w; w.x = pk2(v[0], v[1]); w.y = pk2(v[2], v[3]); w.z = pk2(v[4], v[5]); w.w = pk2(v[6], v[7]);
                *(u32x4*)(base + (size_t)(row0 + m * 16) * ld + col0 + bj * HALF) = w;
            }
        }
    }
    __device__ __forceinline__ void operator()(const f32x4 (&acc)[2][4][2], int ai, const Unit& u, int wr, int wc, int fr, int fq) const {
        const int pn = u.pn, row0 = u.pm * BM + ai * HALF + wr * 64 + fr, colg = pn * BM + wc * 32 + 8 * fq;
        if (pn < 2) run<1>(acc, HB, 2048, row0, colg, 0);
        else if (pn < 4) run<2>(acc, HB, 2048, row0, colg, colg - 512);
        else if (pn < 6) run<0>(acc, HB, 2048, row0, colg, 0);
        else if (pn < 8) run<1>(acc, HB, 2048, row0, colg, 0);
        else if (pn < 10) run<3>(acc, AB, 768, row0, colg - 2048, 0);
        else if (pn < 11) run<0>(acc, AB, 768, row0, colg - 2048, 0);
        else run<4>(acc, GB, 2048, row0, colg - 2816, 0);
    }
};
template <int PASS> struct EpiGate {
    static constexpr bool PERM = true;
    bf16_t* MG; const bf16_t* GB;
    __device__ __forceinline__ void operator()(const f32x4 (&acc)[2][4][2], int ai, const Unit& u, int wr, int wc, int fr, int fq) const {
        const int row0 = u.pm * BM + ai * HALF + wr * 64 + fr, col0 = u.pn * BM + wc * 32 + 8 * fq;
#pragma unroll
        for (int m = 0; m < 4; ++m) {
#pragma unroll
            for (int bj = 0; bj < 2; ++bj) {
                const size_t row = (size_t)(row0 + m * 16); const int col = col0 + bj * HALF;
                const u32x4 g = *(const u32x4*)(GB + row * 2048 + PASS * 1024 + col);
                float v[8];
#pragma unroll
                for (int j = 0; j < 4; ++j) { v[j] = acc[bj][m][0][j]; v[4 + j] = acc[bj][m][1][j]; }
                v[0] *= bflo(g.x); v[1] *= bfhi(g.x); v[2] *= bflo(g.y); v[3] *= bfhi(g.y); v[4] *= bflo(g.z); v[5] *= bfhi(g.z); v[6] *= bflo(g.w); v[7] *= bfhi(g.w);
                if (PASS == 1) { const u32x4 p = *(const u32x4*)(MG + row * 1024 + col);
                    v[0] += bflo(p.x); v[1] += bfhi(p.x); v[2] += bflo(p.y); v[3] += bfhi(p.y); v[4] += bflo(p.z); v[5] += bfhi(p.z); v[6] += bflo(p.w); v[7] += bfhi(p.w); }
                u32x4 w; w.x = pk2(v[0], v[1]); w.y = pk2(v[2], v[3]); w.z = pk2(v[4], v[5]); w.w = pk2(v[6], v[7]);
                *(u32x4*)(MG + row * 1024 + col) = w;
            }
            asm volatile("" ::: "memory");
        }
    }
};
struct EpiPre1 {
    static constexpr bool PERM = false;
    const float* x; float* out;
    __device__ __forceinline__ void operator()(const f32x4 (&acc)[2][4][2], int ai, const Unit& u, int wr, int wc, int fr, int fq) const {
        const unsigned base = ((unsigned)(u.pm * BM + ai * HALF + wr * 64 + fr) * DM + (unsigned)(u.pn * BM + wc * 32 + 4 * fq)) * 4u;
#pragma unroll
        for (int m = 0; m < 4; ++m) {
#pragma unroll
            for (int bj = 0; bj < 2; ++bj)
#pragma unroll
                for (int n = 0; n < 2; ++n) {
                    const unsigned off = base + (unsigned)(((m * 16) * DM + bj * HALF + n * 16) * 4);
                    const f32x4 xv = *(const f32x4*)((const char*)x + off);
                    *(f32x4*)((char*)out + off) = acc[bj][m][n] + xv * DN_ALPHA;
                }
            asm volatile("" ::: "memory");
        }
    }
};
struct EpiSwiGLU {
    static constexpr bool PERM = true;
    bf16_t* H;
    __device__ __forceinline__ void operator()(const f32x4 (&acc)[2][4][2], int ai, const Unit& u, int wr, int wc, int fr, int fq) const {
        const int row0 = u.pm * BM + ai * HALF + wr * 64 + fr, col0 = u.pn * 128 + wc * 16 + 4 * fq;
#pragma unroll
        for (int m = 0; m < 4; ++m)
#pragma unroll
            for (int bj = 0; bj < 2; ++bj) {
                const f32x4 g = acc[bj][m][0], up = acc[bj][m][1];
                u32x2 w; w.x = pk2(silu(g[0]) * up[0], silu(g[1]) * up[1]); w.y = pk2(silu(g[2]) * up[2], silu(g[3]) * up[3]);
                *(u32x2*)(H + (size_t)(row0 + m * 16) * DE + col0 + bj * 64) = w;
            }
    }
};
struct EpiDown {
    static constexpr bool PERM = true;
    bf16_t* Y; const int* slot; const float* asgw; const LAS int* cn;
    __device__ __forceinline__ void operator()(const f32x4 (&acc)[2][4][2], int ai, const Unit& u, int wr, int wc, int fr, int fq) const {
        const int col0 = u.pn * BM + wc * 32 + 8 * fq; const int cnt = cn[u.e];
#pragma unroll
        for (int m = 0; m < 4; ++m) {
            const int s = u.mt * BM + ai * HALF + wr * 64 + m * 16 + fr;
            if (s < cnt) {
                const int asg = slot[(size_t)u.e * CAP + s]; const float w = asgw[asg];
#pragma unroll
                for (int bj = 0; bj < 2; ++bj) {
                    const f32x4 a = acc[bj][m][0] * w, b = acc[bj][m][1] * w;
                    u32x4 o; o.x = pk2(a[0], a[1]); o.y = pk2(a[2], a[3]); o.z = pk2(b[0], b[1]); o.w = pk2(b[2], b[3]);
                    *(u32x4*)(Y + (size_t)asg * DM + col0 + bj * HALF) = o;
                }
            }
            asm volatile("" ::: "memory");
        }
    }
};

template <class Prob, class Epi>
__device__ __forceinline__ void gemm_phase_naive(const Prob& P, const Epi& E) {
    const int tid = threadIdx.x, wid = tid >> 6, lane = tid & 63, wr = wid >> 2, wc = wid & 3, fr = lane & 15, fq = lane >> 4;
    const int K = P.K;
    Unit u;
    for (int i = 0; P.next(i, u); ++i) {
        const char* bB = P.b_base(u);
        for (int ai = 0; ai < 2; ++ai) {
            f32x4 acc[2][4][2];
#pragma unroll
            for (int b = 0; b < 2; ++b)
#pragma unroll
                for (int m = 0; m < 4; ++m)
#pragma unroll
                    for (int n = 0; n < 2; ++n) acc[b][m][n] = (f32x4){0.f, 0.f, 0.f, 0.f};
            unsigned ro[4];
#pragma unroll
            for (int m = 0; m < 4; ++m) ro[m] = P.a_rowoff(u, ai * HALF + wr * 64 + m * 16 + fr);
#pragma unroll 1
            for (int k = 0; k < K; k += 4) {
                u32x2 ap[4];
#pragma unroll
                for (int m = 0; m < 4; ++m) ap[m] = *(const u32x2*)(P.Abase + (ro[m] + (unsigned)k * 2u));
#pragma unroll
                for (int bj = 0; bj < 2; ++bj)
#pragma unroll
                    for (int n = 0; n < 2; ++n)
#pragma unroll
                        for (int j = 0; j < 4; ++j) {
                            const unsigned col = (unsigned)(bj * HALF + wc * 32 + (Epi::PERM ? (8 * fq + 4 * n + j) : (16 * n + 4 * fq + j)));
                            const u32x2 b = *(const u32x2*)(bB + (col * (unsigned)K + (unsigned)k) * 2u);
                            const float b0 = bflo(b.x), b1 = bfhi(b.x), b2 = bflo(b.y), b3 = bfhi(b.y);
#pragma unroll
                            for (int m = 0; m < 4; ++m) {
                                const u32x2 a = ap[m];
                                float s = acc[bj][m][n][j];
                                s = fmaf(bflo(a.x), b0, s); s = fmaf(bfhi(a.x), b1, s); s = fmaf(bflo(a.y), b2, s); s = fmaf(bfhi(a.y), b3, s);
                                acc[bj][m][n][j] = s;
                            }
                        }
                asm volatile("" ::: "memory");
            }
            E(acc, ai, u, wr, wc, fr, fq);
        }
    }
}

template <class Prob, class Epi, bool ALIGN_EPI, bool SP2>
__device__ __forceinline__ void gemm_phase_mfma(LAS unsigned char* lds, const Prob& P, const Epi& E) {
    const int tid = threadIdx.x, wid = __builtin_amdgcn_readfirstlane(tid >> 6), lane = tid & 63, wr = wid >> 2, wc = wid & 3, fr = lane & 15, fq = lane >> 4;
    const int K = P.K, nt = K / BK;
    int Ra[2]; unsigned Ca[2], voffB[2];
#pragma unroll
    for (int i = 0; i < 2; ++i) { int R, C; stage_rc(tid * 16 + i * 8192, R, C); const int Rb = Epi::PERM ? ((R & ~31) + perm32(R & 31)) : R;
        Ra[i] = R; Ca[i] = (unsigned)C * 2u; voffB[i] = (unsigned)(Rb * K + C) * 2u; }
    const size_t kstep = (size_t)(BK * 2);
    const size_t hstep = (size_t)HALF * K * 2;
    const unsigned ldsw = (unsigned)wid * 1024u;
    const int aoff = lds_byte(wr * 64 + fr, fq * 8), boff = lds_byte(wc * 32 + fr, fq * 8);
#define PG8_SA(b, h) (((b) * 2 + (h)) * HTB)
#define PG8_SB(b, h) ((4 + (b) * 2 + (h)) * HTB)
#define PG8_STAGEB(bufoff, gbase) do { _Pragma("unroll") for (int _i = 0; _i < 2; ++_i) \
        __builtin_amdgcn_global_load_lds((const unsigned*)((const char*)(gbase) + voffB[_i]), (LAS unsigned*)(lds + (bufoff) + ldsw + _i * 8192), 16, 0, 0); } while (0)
#define PG8_STAGEA(bufoff, gbase, v0, v1) do { \
        __builtin_amdgcn_global_load_lds((const unsigned*)((const char*)(gbase) + (v0)), (LAS unsigned*)(lds + (bufoff) + ldsw), 16, 0, 0); \
        __builtin_amdgcn_global_load_lds((const unsigned*)((const char*)(gbase) + (v1)), (LAS unsigned*)(lds + (bufoff) + ldsw + 8192), 16, 0, 0); } while (0)
#define PG8_LDA(dst, b, h) do { _Pragma("unroll") for (int m = 0; m < 4; ++m) _Pragma("unroll") for (int k = 0; k < 2; ++k) dst[m][k] = *(const LAS bf16x8*)(lds + PG8_SA(b, h) + aoff + m * 2048 + k * 1024); } while (0)
#define PG8_LDB(dst, b, h) do { _Pragma("unroll") for (int n = 0; n < 2; ++n) _Pragma("unroll") for (int k = 0; k < 2; ++k) dst[n][k] = *(const LAS bf16x8*)(lds + PG8_SB(b, h) + boff + n * 2048 + k * 1024); } while (0)
#define PG8_MMA(ai, bj, At, Bt) do { __builtin_amdgcn_s_setprio(1); _Pragma("unroll") for (int m = 0; m < 4; ++m) _Pragma("unroll") for (int n = 0; n < 2; ++n) _Pragma("unroll") for (int k = 0; k < 2; ++k) \
        acc[ai][bj][m][n] = __builtin_amdgcn_mfma_f32_16x16x32_bf16(Bt[n][k], At[m][k], acc[ai][bj][m][n], 0, 0, 0); __builtin_amdgcn_s_setprio(0); } while (0)
#define PG8_WAIT_V(n) asm volatile("s_waitcnt vmcnt(" #n ")" ::: "memory")
#define PG8_WAIT_L(n) asm volatile("s_waitcnt lgkmcnt(" #n ")" ::: "memory")
#define PG8_BAR __builtin_amdgcn_s_barrier()
#define PG8_SCHED __builtin_amdgcn_sched_barrier(0)
    Unit cur, nxt; int ui = 0;
    if (!P.next(0, cur)) return;
    f32x4 acc[2][2][4][2];
#pragma unroll
    for (int a = 0; a < 2; ++a)
#pragma unroll
        for (int b = 0; b < 2; ++b)
#pragma unroll
            for (int m = 0; m < 4; ++m)
#pragma unroll
                for (int n = 0; n < 2; ++n) acc[a][b][m][n] = (f32x4){0.f, 0.f, 0.f, 0.f};
    bf16x8 At[4][2], B0[2][2], B1[2][2];
    const char* const cA = P.Abase;
    const char* cB = P.b_base(cur);
    unsigned va0, va1, va2, va3;
    va0 = P.a_rowoff(cur, Ra[0]) + Ca[0]; va1 = P.a_rowoff(cur, Ra[1]) + Ca[1]; va2 = P.a_rowoff(cur, HALF + Ra[0]) + Ca[0]; va3 = P.a_rowoff(cur, HALF + Ra[1]) + Ca[1];
    if constexpr (SP2) {
        PG8_STAGEB(PG8_SB(0, 0), cB); PG8_STAGEB(PG8_SB(0, 1), cB + hstep); PG8_STAGEA(PG8_SA(0, 0), cA, va0, va1); PG8_STAGEA(PG8_SA(0, 1), cA, va2, va3);
        if (wr == 1) PG8_BAR;
        PG8_WAIT_V(2); PG8_BAR;
        PG8_STAGEB(PG8_SB(1, 0), cB + kstep); PG8_STAGEA(PG8_SA(1, 0), cA + kstep, va0, va1); PG8_STAGEB(PG8_SB(1, 1), cB + hstep + kstep);
        PG8_WAIT_V(6); PG8_BAR;
    } else {
        PG8_STAGEB(PG8_SB(0, 0), cB); PG8_STAGEA(PG8_SA(0, 0), cA, va0, va1); PG8_STAGEB(PG8_SB(0, 1), cB + hstep); PG8_STAGEA(PG8_SA(0, 1), cA, va2, va3);
        if (wr == 1) PG8_BAR;
        PG8_WAIT_V(4); PG8_BAR;
        PG8_STAGEB(PG8_SB(1, 0), cB + kstep); PG8_STAGEA(PG8_SA(1, 0), cA + kstep, va0, va1); PG8_STAGEB(PG8_SB(1, 1), cB + hstep + kstep);
        PG8_WAIT_V(6); PG8_BAR;
    }
    for (;;) {
        const bool has_next = P.next(ui + 1, nxt);
        unsigned vn0 = va0, vn1 = va1, vn2 = va2, vn3 = va3; const char* nB = cB;
        if (has_next) { nB = P.b_base(nxt);
            vn0 = P.a_rowoff(nxt, Ra[0]) + Ca[0]; vn1 = P.a_rowoff(nxt, Ra[1]) + Ca[1]; vn2 = P.a_rowoff(nxt, HALF + Ra[0]) + Ca[0]; vn3 = P.a_rowoff(nxt, HALF + Ra[1]) + Ca[1]; }
        for (int t = 0; t < nt; t += 2) {
            const bool last = (t == nt - 2);
            const char* a1 = cA + (size_t)(t + 1) * kstep;
            const char* a2 = last ? cA : cA + (size_t)(t + 2) * kstep; const char* b2 = last ? nB : cB + (size_t)(t + 2) * kstep;
            const char* a3 = a2 + kstep; const char* b3 = b2 + kstep;
            const unsigned w0 = last ? vn0 : va0, w1 = last ? vn1 : va1, w2 = last ? vn2 : va2, w3 = last ? vn3 : va3;
            if constexpr (SP2) {
            PG8_LDB(B0, 0, 0); PG8_LDB(B1, 0, 1); PG8_SCHED; PG8_LDA(At, 0, 0); PG8_STAGEA(PG8_SA(1, 1), a1, va2, va3);
            PG8_WAIT_V(8); PG8_WAIT_L(0); PG8_BAR; PG8_MMA(0, 0, At, B0); PG8_MMA(0, 1, At, B1); PG8_BAR; PG8_SCHED;
            PG8_LDA(At, 0, 1); PG8_STAGEB(PG8_SB(0, 0), b2); PG8_STAGEB(PG8_SB(0, 1), b2 + hstep); PG8_STAGEA(PG8_SA(0, 0), a2, w0, w1);
            PG8_WAIT_V(8); PG8_WAIT_L(0); PG8_BAR; PG8_MMA(1, 0, At, B0); PG8_MMA(1, 1, At, B1); PG8_BAR; PG8_SCHED;
            PG8_LDB(B0, 1, 0); PG8_LDB(B1, 1, 1); PG8_SCHED; PG8_LDA(At, 1, 0); PG8_STAGEA(PG8_SA(0, 1), a2, w2, w3);
            PG8_WAIT_V(8); PG8_WAIT_L(0); PG8_BAR; PG8_MMA(0, 0, At, B0); PG8_MMA(0, 1, At, B1); PG8_BAR; PG8_SCHED;
            PG8_LDA(At, 1, 1); PG8_STAGEB(PG8_SB(1, 0), b3); PG8_STAGEB(PG8_SB(1, 1), b3 + hstep); PG8_STAGEA(PG8_SA(1, 0), a3, w0, w1);
            PG8_WAIT_V(8); PG8_WAIT_L(0); PG8_BAR; PG8_MMA(1, 0, At, B0); PG8_MMA(1, 1, At, B1); PG8_BAR; PG8_SCHED;
            } else {
            PG8_LDB(B0, 0, 0); PG8_SCHED; PG8_LDA(At, 0, 0); PG8_STAGEA(PG8_SA(1, 1), a1, va2, va3);
            PG8_WAIT_L(8); PG8_BAR; PG8_WAIT_L(0); PG8_MMA(0, 0, At, B0); PG8_BAR; PG8_SCHED;
            PG8_LDB(B1, 0, 1); PG8_STAGEB(PG8_SB(0, 0), b2);
            PG8_BAR; PG8_WAIT_L(0); PG8_MMA(0, 1, At, B1); PG8_BAR;
            PG8_LDA(At, 0, 1); PG8_STAGEA(PG8_SA(0, 0), a2, w0, w1);
            PG8_BAR; PG8_WAIT_L(0); PG8_MMA(1, 0, At, B0); PG8_BAR; PG8_SCHED;
            PG8_STAGEB(PG8_SB(0, 1), b2 + hstep);
            PG8_WAIT_V(6); PG8_BAR; PG8_MMA(1, 1, At, B1); PG8_BAR;
            PG8_LDB(B0, 1, 0); PG8_SCHED; PG8_LDA(At, 1, 0); PG8_STAGEA(PG8_SA(0, 1), a2, w2, w3);
            PG8_WAIT_L(8); PG8_BAR; PG8_WAIT_L(0); PG8_MMA(0, 0, At, B0); PG8_BAR; PG8_SCHED;
            PG8_LDB(B1, 1, 1); PG8_STAGEB(PG8_SB(1, 0), b3);
            PG8_BAR; PG8_WAIT_L(0); PG8_MMA(0, 1, At, B1); PG8_BAR;
            PG8_LDA(At, 1, 1); PG8_STAGEA(PG8_SA(1, 0), a3, w0, w1);
            PG8_BAR; PG8_WAIT_L(0); PG8_MMA(1, 0, At, B0); PG8_BAR; PG8_SCHED;
            PG8_STAGEB(PG8_SB(1, 1), b3 + hstep);
            PG8_WAIT_V(6); PG8_BAR; PG8_MMA(1, 1, At, B1); PG8_BAR;
            }
        }
        if constexpr (ALIGN_EPI) { if (wr == 0) PG8_BAR; }
        E(acc[0], 0, cur, wr, wc, fr, fq); E(acc[1], 1, cur, wr, wc, fr, fq);
        if (!has_next) break;
#pragma unroll
        for (int a = 0; a < 2; ++a)
#pragma unroll
            for (int b = 0; b < 2; ++b)
#pragma unroll
                for (int m = 0; m < 4; ++m)
#pragma unroll
                    for (int n = 0; n < 2; ++n) acc[a][b][m][n] = (f32x4){0.f, 0.f, 0.f, 0.f};
        cur = nxt; cB = nB; va0 = vn0; va1 = vn1; va2 = vn2; va3 = vn3; ++ui;
        if constexpr (ALIGN_EPI) { if (wr == 1) PG8_BAR; }
    }
    PG8_WAIT_V(0);
    if constexpr (!ALIGN_EPI) { if (wr == 0) PG8_BAR; }
    PG8_BAR;
#undef PG8_SA
#undef PG8_SB
#undef PG8_STAGEA
#undef PG8_STAGEB
#undef PG8_LDA
#undef PG8_LDB
#undef PG8_MMA
#undef PG8_WAIT_V
#undef PG8_WAIT_L
#undef PG8_BAR
#undef PG8_SCHED
}

template <class Prob, class Epi>
__device__ __forceinline__ void gemm_phase(LAS unsigned char* lds, const Prob& P, const Epi& E) {
#if NAIVE_GEMM
    gemm_phase_naive<Prob, Epi>(P, E);
#else
    gemm_phase_mfma<Prob, Epi, true, true>(lds, P, E);
#endif
}

struct Args {
    const float* in[19]; float* out; unsigned char* ws; int ph_lo, ph_hi, coop, pad;
};

template <int MAPMODE  >
__device__ __forceinline__ void p0_transpose_item(const float* W, int K, int N, bf16_t* WT, LAS float* scr, int item, int lane) {
    const int nblk = N / 32, kb = item / nblk, nb = item % nblk, k0 = 64 * kb, n0 = 32 * nb;
#pragma unroll 8
    for (int i = 0; i < 32; ++i) { const int kk = 2 * i + (lane >> 5); scr[kk * 33 + (lane & 31)] = W[(size_t)(k0 + kk) * N + n0 + (lane & 31)]; }
    LDS_WAIT();
    const int c = lane & 7;
#pragma unroll
    for (int j = 0; j < 4; ++j) { const int n = (lane >> 3) + 8 * j; const LAS float* s = scr + (8 * c) * 33 + n;
        u32x4 o; o.x = pk2(s[0 * 33], s[1 * 33]); o.y = pk2(s[2 * 33], s[3 * 33]); o.z = pk2(s[4 * 33], s[5 * 33]); o.w = pk2(s[6 * 33], s[7 * 33]);
        const int ng = n0 + n; const int row = (MAPMODE == 0) ? ng : ((ng >> 2) * 8 + (MAPMODE == 2 ? 4 : 0) + (ng & 3));
        *(u32x4*)(WT + (size_t)row * K + k0 + 8 * c) = o; }
    LDS_WAIT();
}
__device__ __forceinline__ void p0_prologue(const Args& a, LAS unsigned char* lds) {
    const int tid = threadIdx.x, lane = tid & 63, wave = tid >> 6;
    unsigned char* ws = a.ws;
    LAS float* scr = (LAS float*)(lds + wave * 16384);
    const int gw = blockIdx.x * NWAVES + wave, NGW = gridDim.x * NWAVES;
    constexpr int I_IN = (DM / 64) * (PW / 32), I_A = (512 / 64) * (DM / 32), I_O = (DM / 64) * (DM / 32), I_G = (DM / 64) * (DE / 32), I_D = (DE / 64) * (DM / 32);
    constexpr int NITEMS = I_IN + 2 * I_A + I_O + NE * (2 * I_G + I_D);
    for (int it = gw; it < NITEMS; it += NGW) {
        int r = it;
        if (r < I_IN) { p0_transpose_item<0>(a.in[2], DM, PW, (bf16_t*)(ws + WS_WIN), scr, r, lane); continue; } r -= I_IN;
        if (r < I_A) { p0_transpose_item<0>(a.in[5], 512, DM, (bf16_t*)(ws + WS_WA), scr, r, lane); continue; } r -= I_A;
        if (r < I_A) { p0_transpose_item<0>(a.in[6], 512, DM, (bf16_t*)(ws + WS_WB), scr, r, lane); continue; } r -= I_A;
        if (r < I_O) { p0_transpose_item<0>(a.in[7], DM, DM, (bf16_t*)(ws + WS_WO), scr, r, lane); continue; } r -= I_O;
        const int e = r / (2 * I_G + I_D); r -= e * (2 * I_G + I_D);
        if (r < I_G) { p0_transpose_item<1>(a.in[14] + (size_t)e * DM * DE, DM, DE, (bf16_t*)(ws + WS_WGU) + (size_t)e * DM * DM, scr, r, lane); continue; } r -= I_G;
        if (r < I_G) { p0_transpose_item<2>(a.in[15] + (size_t)e * DM * DE, DM, DE, (bf16_t*)(ws + WS_WGU) + (size_t)e * DM * DM, scr, r, lane); continue; } r -= I_G;
        p0_transpose_item<0>(a.in[16] + (size_t)e * DE * DM, DE, DM, (bf16_t*)(ws + WS_WD) + (size_t)e * DM * DE, scr, r, lane);
    }
    {
        const f32x4* x4 = (const f32x4*)a.in[0]; u32x4* o = (u32x4*)(ws + WS_RA);
        const size_t n8 = (size_t)T_ * DM / 8, stride = (size_t)gridDim.x * NTHREADS;
        for (size_t i = (size_t)blockIdx.x * NTHREADS + tid; i < n8; i += stride) {
            const f32x4 p = x4[2 * i], q = x4[2 * i + 1];
            u32x4 w; w.x = pk2(p[0], p[1]); w.y = pk2(p[2], p[3]); w.z = pk2(q[0], q[1]); w.w = pk2(q[2], q[3]);
            o[i] = w;
        }
    }
    if (blockIdx.x == 0) {
        float* lb = (float*)(ws + WS_LB); const float* lg = a.in[1];
        lb[tid] = 1.f / (1.f + __expf(lg[512 + tid] - lg[tid]));
        unsigned* ctl = (unsigned*)(ws + WS_CTL);
        if (tid < 32) ctl[CW_CNT + tid] = 0u;
        if (tid == 32) ctl[CW_ATTQ] = 0u;
    }
}

__device__ __forceinline__ void hgrn_naive(LAS unsigned char* lds, const bf16_t* HB, const float* normw, bf16_t* OH, int item) {
    const int tid = threadIdx.x, lane = tid & 63, wave = tid >> 6, v = tid & 127, kg = tid >> 7;
    const int b = item >> 2, h = item & 3;
    LAS float* sq = (LAS float*)lds;
    LAS float* sf = sq + 64 * 128;
    LAS float* sv = sf + 64 * 128;
    LAS float* so = sv + 64 * 128;
    LAS float* sp = so + 64 * 128;
    float S[32];
#pragma unroll
    for (int i = 0; i < 32; ++i) S[i] = 0.f;
    for (int c = 0; c < 32; ++c) {
        const size_t row0 = (size_t)b * SEQ + c * 64;
        for (int i = 0; i < 16; ++i) { const int idx = tid + 512 * i, r = idx >> 7, col = idx & 127; const bf16_t* p = HB + (row0 + r) * 2048 + h * 128 + col;
            sq[idx] = bf2f(p[0]); sf[idx] = __expf(bf2f(p[512])); sv[idx] = bf2f(p[1024]); }
        __syncthreads();
        for (int t = 0; t < 64; ++t) {
            const float vt = sv[t * 128 + v]; float part = 0.f;
#pragma unroll
            for (int i = 0; i < 32; ++i) { const float f = sf[t * 128 + kg * 32 + i]; S[i] = f * S[i] + (1.f - f) * vt; part += sq[t * 128 + kg * 32 + i] * S[i]; }
            sp[((t & 1) * 4 + kg) * 128 + v] = part;
            __syncthreads();
            if (kg == 0) { const LAS float* q = sp + (t & 1) * 4 * 128 + v; so[t * 128 + v] = (q[0] + q[128]) + (q[256] + q[384]); }
        }
        __syncthreads();
        for (int tt = 0; tt < 8; ++tt) { const int t = wave * 8 + tt; const float o0 = so[t * 128 + lane], o1 = so[t * 128 + 64 + lane];
            const float ss = wave_sum(o0 * o0 + o1 * o1); const float rstd = rsqrtf(ss * (1.f / 128.f) + RMS_EPS);
            const bf16_t* g = HB + (row0 + t) * 2048 + 1536 + h * 128; bf16_t* o = OH + (row0 + t) * 512 + h * 128;
            o[lane] = (bf16_t)f2bf(o0 * rstd * normw[lane] * bf2f(g[lane])); o[64 + lane] = (bf16_t)f2bf(o1 * rstd * normw[64 + lane] * bf2f(g[64 + lane])); }
        __syncthreads();
    }
}

__device__ __forceinline__ void attn_naive(LAS unsigned char* lds, const bf16_t* AB, const float* sinks, bf16_t* OA, int item) {
    const int tid = threadIdx.x, lane = tid & 63, wave = tid >> 6;
    const int hk = item & 1, n = (item >> 1) & 15, b = item >> 5;
    LAS bf16_t* Ks = (LAS bf16_t*)lds;
    LAS bf16_t* Vs = Ks + 256 * 64;
    LAS float* qs = (LAS float*)(lds + 65536) + wave * 192;
    LAS float* ps = qs + 64;
    __syncthreads();
    for (int i = 0; i < 8; ++i) { const int ch = tid + 512 * i; const int kv = ch >> 11, rr = (ch >> 3) & 255, c8 = ch & 7; const int kp = n * 128 - 128 + rr;
        u32x4 val = (u32x4){0u, 0u, 0u, 0u};
        if (kp >= 0) val = *(const u32x4*)(AB + ((size_t)b * SEQ + kp) * 768 + 512 + kv * 128 + hk * 64 + c8 * 8);
        *(LAS u32x4*)((kv ? Vs : Ks) + rr * 64 + c8 * 8) = val; }
    __syncthreads();
    const int g = wave >> 1, head = hk * 4 + g; const float slope = exp2f(-(float)(head + 1)); const float sink = sinks[head];
    for (int ii = 0; ii < 64; ++ii) {
        const int i = (wave & 1) * 64 + ii; const size_t row = (size_t)b * SEQ + n * 128 + i;
        qs[lane] = bf2f(AB[row * 768 + head * 64 + lane]);
        LDS_WAIT();
        float s0 = 0.f, s1 = 0.f; const int j0 = i + 1 + lane, j1 = i + 65 + lane;
#pragma unroll
        for (int d8 = 0; d8 < 8; ++d8) {
            const u32x4 k0 = *(const LAS u32x4*)(Ks + j0 * 64 + d8 * 8), k1 = *(const LAS u32x4*)(Ks + j1 * 64 + d8 * 8);
            const f32x4 qa = *(const LAS f32x4*)(qs + d8 * 8), qb = *(const LAS f32x4*)(qs + d8 * 8 + 4);
            s0 += qa[0] * bflo(k0.x) + qa[1] * bfhi(k0.x) + qa[2] * bflo(k0.y) + qa[3] * bfhi(k0.y) + qb[0] * bflo(k0.z) + qb[1] * bfhi(k0.z) + qb[2] * bflo(k0.w) + qb[3] * bfhi(k0.w);
            s1 += qa[0] * bflo(k1.x) + qa[1] * bfhi(k1.x) + qa[2] * bflo(k1.y) + qa[3] * bfhi(k1.y) + qb[0] * bflo(k1.z) + qb[1] * bfhi(k1.z) + qb[2] * bflo(k1.w) + qb[3] * bfhi(k1.w);
        }
        const bool v0 = (n * 128 - 128 + j0) >= 0, v1 = (n * 128 - 128 + j1) >= 0;
        const float l0 = v0 ? s0 - slope * (float)(127 - lane) : -1e30f, l1 = v1 ? s1 - slope * (float)(63 - lane) : -1e30f;
        const float mx = fmaxf(wave_max(fmaxf(l0, l1)), sink);
        const float e0 = __expf(l0 - mx), e1 = __expf(l1 - mx);
        const float den = wave_sum(e0 + e1) + __expf(sink - mx); const float inv = 1.f / den;
        ps[lane] = e0 * inv; ps[64 + lane] = e1 * inv;
        LDS_WAIT();
        float o = 0.f;
#pragma unroll 8
        for (int jj = 0; jj < 128; ++jj) o += ps[jj] * bf2f(Vs[(i + 1 + jj) * 64 + lane]);
        OA[row * 512 + head * 64 + lane] = (bf16_t)f2bf(o);
        LDS_WAIT();
    }
}

__device__ __forceinline__ void p5_ln_router(const Args& a, LAS unsigned char* lds) {
    const int tid = threadIdx.x, lane = tid & 63, wave = tid >> 6;
    unsigned char* ws = a.ws;
    const float* pre1 = a.out; bf16_t* X1B = (bf16_t*)(ws + WS_RA);
    const float* g1 = a.in[8]; const float* b1 = a.in[9];
    const float* rgw = a.in[10]; const float* rgb = a.in[11]; const float* rew = a.in[12]; const float* reb = a.in[13];
    unsigned* ctl = (unsigned*)(ws + WS_CTL); int* slot = (int*)(ws + WS_SLOT); float* asgw = (float*)(ws + WS_ASGW);
    LAS int* hist = (LAS int*)(lds);
    LAS int* base = hist + 32;
    LAS int* se = base + 32;
    LAS int* sr = se + 128;
    LAS float* sw = (LAS float*)(sr + 128);
    f32x4 gv[4], bv[4];
#pragma unroll
    for (int j = 0; j < 4; ++j) { gv[j] = *(const f32x4*)(g1 + 4 * lane + 256 * j); bv[j] = *(const f32x4*)(b1 + 4 * lane + 256 * j); }
    for (int it = blockIdx.x; it < T_ / 64; it += gridDim.x) {
        __syncthreads();
        if (tid < 32) hist[tid] = 0;
        __syncthreads();
        for (int rr = 0; rr < 8; ++rr) {
            const int rl = wave * 8 + rr; const size_t row = (size_t)it * 64 + rl;
            f32x4 v[4]; float s = 0.f;
#pragma unroll
            for (int j = 0; j < 4; ++j) { v[j] = *(const f32x4*)(pre1 + row * DM + 4 * lane + 256 * j); s += (v[j][0] + v[j][1]) + (v[j][2] + v[j][3]); }
            const float mean = wave_sum(s) * (1.f / DM); float s2 = 0.f;
#pragma unroll
            for (int j = 0; j < 4; ++j) { v[j] = v[j] - mean; s2 += (v[j][0] * v[j][0] + v[j][1] * v[j][1]) + (v[j][2] * v[j][2] + v[j][3] * v[j][3]); }
            const float rstd = rsqrtf(wave_sum(s2) * (1.f / DM) + LN_EPS);
#pragma unroll
            for (int j = 0; j < 4; ++j) { v[j] = v[j] * rstd * gv[j] + bv[j];
                u32x2 w; w.x = pk2(v[j][0], v[j][1]); w.y = pk2(v[j][2], v[j][3]); *(u32x2*)(X1B + row * DM + 4 * lane + 256 * j) = w; }
            float lg[36];
#pragma unroll
            for (int o = 0; o < 36; ++o) lg[o] = 0.f;
#pragma unroll
            for (int j = 0; j < 4; ++j)
#pragma unroll
                for (int c = 0; c < 4; ++c) { const int k = 4 * lane + 256 * j + c; const float xv = v[j][c];
                    const f32x4 wg = *(const f32x4*)(rgw + (size_t)k * 4);
#pragma unroll
                    for (int o = 0; o < 4; ++o) lg[o] += xv * wg[o];
#pragma unroll
                    for (int q = 0; q < 8; ++q) { const f32x4 we = *(const f32x4*)(rew + (size_t)k * 32 + 4 * q);
#pragma unroll
                        for (int o = 0; o < 4; ++o) lg[4 + 4 * q + o] += xv * we[o]; }
                    asm volatile("" ::: "memory"); }
#pragma unroll
            for (int o = 0; o < 36; ++o) lg[o] = wave_sum(lg[o]);
            if (lane == 0) {
                float gl[4]; int gs = 0; float gm;
#pragma unroll
                for (int o = 0; o < 4; ++o) gl[o] = lg[o] + rgb[o];
                gm = gl[0];
#pragma unroll
                for (int o = 1; o < 4; ++o) if (gl[o] > gm) { gm = gl[o]; gs = o; }
                float gsum = 0.f;
#pragma unroll
                for (int o = 0; o < 4; ++o) gsum += __expf(gl[o] - gm);
                const float gw = 1.f / gsum;
                float el[8];
#pragma unroll
                for (int o = 0; o < 8; ++o) { float t = 0.f;
#pragma unroll
                    for (int q = 0; q < 4; ++q) t = (gs == q) ? (lg[4 + 8 * q + o] + reb[8 * q + o]) : t;
                    el[o] = t; }
                int i1 = 0; float m1 = el[0];
#pragma unroll
                for (int o = 1; o < 8; ++o) if (el[o] > m1) { m1 = el[o]; i1 = o; }
                int i2 = -1; float m2 = -3.0e38f;
#pragma unroll
                for (int o = 0; o < 8; ++o) if (o != i1 && el[o] > m2) { m2 = el[o]; i2 = o; }
                const float e2 = __expf(m2 - m1); const float w1 = gw / (1.f + e2), w2 = gw * e2 / (1.f + e2);
                const int x1 = gs * 8 + i1, x2 = gs * 8 + i2;
                se[rl * 2] = x1; se[rl * 2 + 1] = x2; sw[rl * 2] = w1; sw[rl * 2 + 1] = w2;
                sr[rl * 2] = atomicAdd((int*)(hist + x1), 1); sr[rl * 2 + 1] = atomicAdd((int*)(hist + x2), 1);
            }
        }
        __syncthreads();
        if (tid < 32) { const int hcount = hist[tid]; base[tid] = hcount > 0 ? (int)atomicAdd(ctl + CW_CNT + tid, (unsigned)hcount) : 0; }
        __syncthreads();
        if (tid < 128) { const int e = se[tid]; const int pos = base[e] + sr[tid]; const int asg = (it * 64 + (tid >> 1)) * 2 + (tid & 1);
            slot[(size_t)e * CAP + pos] = asg; asgw[asg] = sw[tid]; }
    }
}

__device__ __forceinline__ void p7_final(const Args& a) {
    const int tid = threadIdx.x, lane = tid & 63, wave = tid >> 6;
    const bf16_t* X1B = (const bf16_t*)(a.ws + WS_RA); const bf16_t* Y = (const bf16_t*)(a.ws + WS_RB);
    const float* g2 = a.in[17]; const float* b2 = a.in[18];
    f32x4 gv[4], bv[4];
#pragma unroll
    for (int j = 0; j < 4; ++j) { gv[j] = *(const f32x4*)(g2 + 4 * lane + 256 * j); bv[j] = *(const f32x4*)(b2 + 4 * lane + 256 * j); }
    const int gw = blockIdx.x * NWAVES + wave, NGW = gridDim.x * NWAVES;
    for (int row = gw; row < T_; row += NGW) {
        f32x4 v[4]; float s = 0.f;
#pragma unroll
        for (int j = 0; j < 4; ++j) {
            const u32x2 xw = *(const u32x2*)(X1B + (size_t)row * DM + 4 * lane + 256 * j);
            const u32x2 y0 = *(const u32x2*)(Y + (size_t)(2 * row) * DM + 4 * lane + 256 * j);
            const u32x2 y1 = *(const u32x2*)(Y + (size_t)(2 * row + 1) * DM + 4 * lane + 256 * j);
            v[j][0] = DN_ALPHA * bflo(xw.x) + (bflo(y0.x) + bflo(y1.x)); v[j][1] = DN_ALPHA * bfhi(xw.x) + (bfhi(y0.x) + bfhi(y1.x));
            v[j][2] = DN_ALPHA * bflo(xw.y) + (bflo(y0.y) + bflo(y1.y)); v[j][3] = DN_ALPHA * bfhi(xw.y) + (bfhi(y0.y) + bfhi(y1.y));
            s += (v[j][0] + v[j][1]) + (v[j][2] + v[j][3]);
        }
        const float mean = wave_sum(s) * (1.f / DM); float s2 = 0.f;
#pragma unroll
        for (int j = 0; j < 4; ++j) { v[j] = v[j] - mean; s2 += (v[j][0] * v[j][0] + v[j][1] * v[j][1]) + (v[j][2] * v[j][2] + v[j][3] * v[j][3]); }
        const float rstd = rsqrtf(wave_sum(s2) * (1.f / DM) + LN_EPS);
#pragma unroll
        for (int j = 0; j < 4; ++j) *(f32x4*)(a.out + (size_t)row * DM + 4 * lane + 256 * j) = v[j] * rstd * gv[j] + bv[j];
    }
}

__device__ __forceinline__ void moe_tables(const Args& a, LAS unsigned char* lds) {
    LAS int* cn = (LAS int*)(lds + MISC_OFF); LAS int* tp = cn + 32;
    const unsigned* ctl = (const unsigned*)(a.ws + WS_CTL);
    __syncthreads();
    if (threadIdx.x < 32) cn[threadIdx.x] = (int)__hip_atomic_load(ctl + CW_CNT + threadIdx.x, __ATOMIC_RELAXED, __HIP_MEMORY_SCOPE_AGENT);
    __syncthreads();
    if (threadIdx.x == 0) { int s = 0; for (int e = 0; e < 32; ++e) { tp[e] = s; s += (cn[e] + BM - 1) / BM; } tp[32] = s; }
    __syncthreads();
}

constexpr int NPHASES = 10;
__global__ void __launch_bounds__(NTHREADS, 2) mk_fwd(Args a) {
    extern __shared__ __attribute__((aligned(16))) unsigned char lds_raw[];
    LAS unsigned char* lds = (LAS unsigned char*)lds_raw;
    unsigned char* ws = a.ws;
    const int lo = a.ph_lo, hi = a.ph_hi;
    const int G = gridDim.x, bid = blockIdx.x;
#ifndef PHASE_MASK
#define PHASE_MASK 0x3ff
#endif
#define IN(k) (((PHASE_MASK >> (k)) & 1) && lo <= (k) && (k) < hi)
#define SEAM(k) do { if (IN(k) && IN((k) + 1) && a.coop) { cg::this_grid().sync(); } } while (0)
    bf16_t* XB = (bf16_t*)(ws + WS_RA); bf16_t* MG = (bf16_t*)(ws + WS_RA); bf16_t* X1B = (bf16_t*)(ws + WS_RA);
    bf16_t* HB = (bf16_t*)(ws + WS_RB); bf16_t* Yb = (bf16_t*)(ws + WS_RB);
    bf16_t* AB = (bf16_t*)(ws + WS_RC); bf16_t* GB = (bf16_t*)(ws + WS_RD); bf16_t* HM = (bf16_t*)(ws + WS_RD);
    bf16_t* OH = (bf16_t*)(ws + WS_RE); bf16_t* OA = (bf16_t*)(ws + WS_RF);

    if (IN(0)) { p0_prologue(a, lds); }
    SEAM(0);
    if (IN(1)) {
        DenseProb P; P.init(XB, ws + WS_WIN, T_, PW, DM, G, bid);
        EpiProj E{HB, AB, GB, (const float*)(ws + WS_LB)};
        gemm_phase<DenseProb, EpiProj>(lds, P, E);
    }
    SEAM(1);
    if (IN(2)) {
        if (bid < 128) hgrn_naive(lds, HB, a.in[3], OH, bid);
        unsigned* ctl = (unsigned*)(ws + WS_CTL);
        LAS int* qi = (LAS int*)(lds + MISC_OFF + 1024);
        for (;;) {
            __syncthreads();
            if (threadIdx.x == 0) qi[0] = (int)atomicAdd(ctl + CW_ATTQ, 1u);
            __syncthreads();
            const int item = qi[0];
            if (item >= 1024) break;
            attn_naive(lds, AB, a.in[4], OA, item);
        }
    }
    SEAM(2);
    if (IN(3)) {
        DenseProb P; P.init(OH, ws + WS_WA, T_, DM, 512, G, bid);
        EpiGate<0> E{MG, GB};
        gemm_phase<DenseProb, EpiGate<0>>(lds, P, E);
    }
    SEAM(3);
    if (IN(4)) {
        DenseProb P; P.init(OA, ws + WS_WB, T_, DM, 512, G, bid);
        EpiGate<1> E{MG, GB};
        gemm_phase<DenseProb, EpiGate<1>>(lds, P, E);
    }
    SEAM(4);
    if (IN(5)) {
        DenseProb P; P.init(MG, ws + WS_WO, T_, DM, DM, G, bid);
        EpiPre1 E{a.in[0], a.out};
        gemm_phase<DenseProb, EpiPre1>(lds, P, E);
    }
    SEAM(5);
    if (IN(6)) { p5_ln_router(a, lds); }
    SEAM(6);
    if (IN(7)) {
        moe_tables(a, lds);
        MoeProb<true> P; P.Abase = (const char*)X1B; P.Bt = (const char*)(ws + WS_WGU); P.K = DM; P.G = G; P.c = bid;
        P.tp = (const LAS int*)(lds + MISC_OFF) + 32; P.cn = (const LAS int*)(lds + MISC_OFF); P.slot = (const int*)(ws + WS_SLOT); P.estride = (size_t)DM * DM * 2;
        EpiSwiGLU E{HM};
        gemm_phase<MoeProb<true>, EpiSwiGLU>(lds, P, E);
    }
    SEAM(7);
    if (IN(8)) {
        moe_tables(a, lds);
        MoeProb<false> P; P.Abase = (const char*)HM; P.Bt = (const char*)(ws + WS_WD); P.K = DE; P.G = G; P.c = bid;
        P.tp = (const LAS int*)(lds + MISC_OFF) + 32; P.cn = (const LAS int*)(lds + MISC_OFF); P.slot = (const int*)(ws + WS_SLOT); P.estride = (size_t)DM * DE * 2;
        EpiDown E{Yb, (const int*)(ws + WS_SLOT), (const float*)(ws + WS_ASGW), (const LAS int*)(lds + MISC_OFF)};
        gemm_phase<MoeProb<false>, EpiDown>(lds, P, E);
    }
    SEAM(8);
    if (IN(9)) { p7_final(a); }
#undef IN
#undef SEAM
}

extern "C" void kernel_launch(void* const* d_in, const int* in_sizes, int n_in, void* d_out, int out_size, void* d_ws, size_t ws_size, hipStream_t stream) {
    static int grid = 0;
    if (grid == 0) {
        if (n_in != 19 || out_size != T_ * DM || ws_size < WS_END) { fprintf(stderr, "kernel_launch: unexpected shapes (n_in %d out %d ws %zu)\n", n_in, out_size, ws_size); grid = -1; return; }
        int dev = 0, cus = 0, per_cu = 0;
        (void)hipGetDevice(&dev); (void)hipDeviceGetAttribute(&cus, hipDeviceAttributeMultiprocessorCount, dev);
        (void)hipFuncSetAttribute((const void*)mk_fwd, hipFuncAttributeMaxDynamicSharedMemorySize, LDS_BYTES);
        (void)hipOccupancyMaxActiveBlocksPerMultiprocessor(&per_cu, (const void*)mk_fwd, NTHREADS, LDS_BYTES);
        if (per_cu < 1) { fprintf(stderr, "kernel_launch: occupancy query says %d blocks/CU\n", per_cu); per_cu = 1; }
        (void)hipGetLastError();
        grid = cus * 1;
        fprintf(stderr, "kernel_launch: cus %d per_cu %d grid %d\n", cus, per_cu, grid);
    }
    if (grid < 0) return;
    (void)hipMemsetAsync((char*)d_ws + WS_CTL, 0, 65536, stream);
    Args a{};
    for (int i = 0; i < 19; ++i) a.in[i] = (const float*)d_in[i];
    a.out = (float*)d_out; a.ws = (unsigned char*)d_ws;
#if N_LAUNCH_MODE == 1
    a.ph_lo = 0; a.ph_hi = NPHASES; a.coop = 1;
    void* args[] = {&a};
    hipError_t e = hipLaunchCooperativeKernel((const void*)mk_fwd, dim3(grid), dim3(NTHREADS), args, LDS_BYTES, stream);
    if (e != hipSuccess) fprintf(stderr, "cooperative launch failed: %s (grid %d)\n", hipGetErrorString(e), grid);
#else
    for (int p = 0; p < NPHASES; ++p) {
        a.ph_lo = p; a.ph_hi = p + 1; a.coop = 0;
        hipLaunchKernelGGL(mk_fwd, dim3(grid), dim3(NTHREADS), LDS_BYTES, stream, a);
    }
#endif
}
```

```cpp
#include <hip/hip_runtime.h>
#include <hip/hip_cooperative_groups.h>
#include <cstdio>
#include <cstdint>
namespace cg = cooperative_groups;

#ifndef NAIVE_GEMM
#define NAIVE_GEMM 1
#endif
#ifndef N_LAUNCH_MODE
#define N_LAUNCH_MODE 1
#endif

#define LAS __attribute__((address_space(3)))
typedef unsigned short bf16_t;
typedef short bf16x8 __attribute__((ext_vector_type(8)));
typedef float f32x4 __attribute__((ext_vector_type(4)));
typedef float f32x2 __attribute__((ext_vector_type(2)));
typedef unsigned u32x4 __attribute__((ext_vector_type(4)));
typedef unsigned u32x2 __attribute__((ext_vector_type(2)));

constexpr int T_ = 65536, DM = 1024, SEQ = 2048, NBATCH = 32;
constexpr int PW = 4864;
constexpr int NE = 32, DE = 512;
constexpr int CAP = 131072;
constexpr float DN_ALPHA = 1.189207115002721f;
constexpr float LN_EPS = 1e-5f, RMS_EPS = 1e-6f;
constexpr int NWAVES = 8, NTHREADS = 512;

constexpr size_t MiB = 1u << 20;
constexpr size_t WS_CTL = 0;
constexpr size_t WS_LB = 1 * MiB;
constexpr size_t WS_WIN = 2 * MiB;
constexpr size_t WS_WA = 12 * MiB;
constexpr size_t WS_WB = 13 * MiB;
constexpr size_t WS_WO = 14 * MiB;
constexpr size_t WS_WGU = 16 * MiB;
constexpr size_t WS_WD = 80 * MiB;
constexpr size_t WS_SLOT = 112 * MiB;
constexpr size_t WS_ASGW = 128 * MiB;
constexpr size_t WS_RA = 132 * MiB;
constexpr size_t WS_RB = 260 * MiB;
constexpr size_t WS_RC = 516 * MiB;
constexpr size_t WS_RD = 612 * MiB;
constexpr size_t WS_RE = 868 * MiB;
constexpr size_t WS_RF = 932 * MiB;
constexpr size_t WS_END = 996 * MiB;
constexpr int CW_CNT = 64;
constexpr int CW_ATTQ = 128;

constexpr int RING_BYTES = 131072;
constexpr int MISC_OFF = RING_BYTES;
constexpr int LDS_BYTES = 147456;

__device__ __forceinline__ float bf2f(bf16_t v) { return __uint_as_float((unsigned)v << 16); }
__device__ __forceinline__ unsigned f2bf(float f) { unsigned u = __float_as_uint(f); return (u + 0x7fffu + ((u >> 16) & 1u)) >> 16; }
__device__ __forceinline__ unsigned pk2(float lo, float hi) { return f2bf(lo) | (f2bf(hi) << 16); }
__device__ __forceinline__ float bflo(unsigned w) { return __uint_as_float(w << 16); }
__device__ __forceinline__ float bfhi(unsigned w) { return __uint_as_float(w & 0xffff0000u); }
__device__ __forceinline__ float sigm(float x) { return 1.f / (1.f + __expf(-x)); }
__device__ __forceinline__ float silu(float x) { return x / (1.f + __expf(-x)); }
__device__ __forceinline__ float wave_sum(float v) {
#pragma unroll
    for (int o = 1; o < 64; o <<= 1) v += __shfl_xor(v, o);
    return v;
}
__device__ __forceinline__ float wave_max(float v) {
#pragma unroll
    for (int o = 1; o < 64; o <<= 1) v = fmaxf(v, __shfl_xor(v, o));
    return v;
}
#define LDS_WAIT() asm volatile("s_waitcnt lgkmcnt(0)" ::: "memory")

constexpr int BM = 256, BK = 64, HALF = 128, HTB = HALF * BK * 2, NXCD = 8, WGM = 8;
__host__ __device__ __forceinline__ int lds_byte(int r, int c) { const int st = (r >> 4) * 2 + (c >> 5), rr = r & 15, cc = c & 31, ob = rr * 64 + cc * 2; return st * 1024 + (ob ^ (((ob >> 9) & 1) << 5)); }
__host__ __device__ __forceinline__ void stage_rc(int b, int& R, int& C) { const int st = b / 1024, sb = b % 1024, swz = sb ^ (((sb >> 9) & 1) << 5); R = (st >> 1) * 16 + swz / 64; C = (st & 1) * 32 + (swz % 64) / 2; }
__host__ __device__ __forceinline__ int perm32(int rho) { const int n = rho >> 4, i = rho & 15; return 8 * (i >> 2) + 4 * n + (i & 3); }

struct Unit { int pm, pn, e, mt; };

struct DenseProb {
    const char* Abase; const char* Bt; int K; int nM, nN, nwg, G, c;
    __device__ __forceinline__ void init(const void* A, const void* B, int M, int N, int K_, int G_, int c_) { Abase = (const char*)A; Bt = (const char*)B; K = K_; nM = M / BM; nN = N / BM; nwg = nM * nN; G = G_; c = c_; }
    __device__ __forceinline__ bool next(int i, Unit& u) const {
        const long L = (long)i * G + c; if (L >= nwg) return false;
        int wgid = (int)L; { const int q = nwg / NXCD, r = nwg % NXCD, xcd = wgid % NXCD, off = wgid / NXCD; wgid = (xcd < r ? xcd * (q + 1) : r * (q + 1) + (xcd - r) * q) + off; }
        const int nig = WGM * nN, gid = wgid / nig, fm = gid * WGM, gsz = (nM - fm) < WGM ? (nM - fm) : WGM;
        u.pm = fm + ((wgid % nig) % gsz); u.pn = (wgid % nig) / gsz; u.e = 0; u.mt = 0; return true;
    }
    __device__ __forceinline__ unsigned a_rowoff(const Unit& u, int r) const { return (unsigned)(u.pm * BM + r) * (unsigned)K * 2u; }
    __device__ __forceinline__ const char* b_base(const Unit& u) const { return Bt + (size_t)u.pn * BM * K * 2; }
};

template <bool GATHER> struct MoeProb {
    const char* Abase; const char* Bt; int K; int G, c; const LAS int* tp; const LAS int* cn; const int* slot; size_t estride;
    __device__ __forceinline__ bool next(int i, Unit& u) const {
        const int L = i * G + c; const int total = tp[32] * 4; if (L >= total) return false;
        const int tau = L >> 2; int e = 0;
        for (int j = 1; j < 32; ++j) e = (tau >= tp[j]) ? j : e;
        u.pm = tau; u.pn = L & 3; u.e = __builtin_amdgcn_readfirstlane(e); u.mt = __builtin_amdgcn_readfirstlane(tau - tp[e]); return true;
    }
    __device__ __forceinline__ unsigned a_rowoff(const Unit& u, int r) const {
        if (GATHER) { const int s = u.mt * BM + r; const int asg = (s < cn[u.e]) ? slot[(size_t)u.e * CAP + s] : 0; return (unsigned)(asg >> 1) * (unsigned)K * 2u; }
        else return (unsigned)(u.pm * BM + r) * (unsigned)K * 2u;
    }
    __device__ __forceinline__ const char* b_base(const Unit& u) const { return Bt + (size_t)u.e * estride + (size_t)u.pn * BM * K * 2; }
};

struct EpiProj {
    static constexpr bool PERM = true;
    bf16_t* HB; bf16_t* AB; bf16_t* GB; const float* lb;
    template <int MODE> __device__ __forceinline__ void run(const f32x4 (&acc)[2][4][2], bf16_t* base, int ld, int row0, int col0, int lbcol) const {
#pragma unroll
        for (int bj = 0; bj < 2; ++bj) {
            float l8[8];
            if (MODE == 2) {
#pragma unroll
                for (int j = 0; j < 8; ++j) l8[j] = lb[lbcol + bj * HALF + j];
            }
#pragma unroll
            for (int m = 0; m < 4; ++m) {
                float v[8];
#pragma unroll
                for (int j = 0; j < 4; ++j) { v[j] = acc[bj][m][0][j]; v[4 + j] = acc[bj][m][1][j]; }
#pragma unroll
                for (int j = 0; j < 8; ++j) {
                    if (MODE == 1) v[j] = silu(v[j]);
                    else if (MODE == 2) v[j] = __logf(l8[j] + (1.f - l8[j]) * sigm(v[j]));
                    else if (MODE == 3) v[j] = v[j] * 0.125f;
                    else if (MODE == 4) v[j] = sigm(v[j]);
                }
                u32x4 w; w.x = pk2(v[0], v[1]); w.y = pk2(v[2], v[3]); w.z = pk2(v[4], v[5]); w.w = pk2(v[6], v[7]);
                *(u32x4*)(base + (size_t)(row0 + m * 16) * ld + col0 + bj * HALF) = w;
            }
        }
    }
    __device__ __forceinline__ void operator()(const f32x4 (&acc)[2][4][2], int ai, const Unit& u, int wr, int wc, int fr, int fq) const {
        const int pn = u.pn, row0 = u.pm * BM + ai * HALF + wr * 64 + fr, colg = pn * BM + wc * 32 + 8 * fq;
        if (pn < 2) run<1>(acc, HB, 2048, row0, colg, 0);
        else if (pn < 4) run<2>(acc, HB, 2048, row0, colg, colg - 512);
        else if (pn < 6) run<0>(acc, HB, 2048, row0, colg, 0);
        else if (pn < 8) run<1>(acc, HB, 2048, row0, colg, 0);
        else if (pn < 10) run<3>(acc, AB, 768, row0, colg - 2048, 0);
        else if (pn < 11) run<0>(acc, AB, 768, row0, colg - 2048, 0);
        else run<4>(acc, GB, 2048, row0, colg - 2816, 0);
    }
};
template <int PASS> struct EpiGate {
    static constexpr bool PERM = true;
    bf16_t* MG; const bf16_t* GB;
    __device__ __forceinline__ void operator()(const f32x4 (&acc)[2][4][2], int ai, const Unit& u, int wr, int wc, int fr, int fq) const {
        const int row0 = u.pm * BM + ai * HALF + wr * 64 + fr, col0 = u.pn * BM + wc * 32 + 8 * fq;
#pragma unroll
        for (int m = 0; m < 4; ++m) {
#pragma unroll
            for (int bj = 0; bj < 2; ++bj) {
                const size_t row = (size_t)(row0 + m * 16); const int col = col0 + bj * HALF;
                const u32x4 g = *(const u32x4*)(GB + row * 2048 + PASS * 1024 + col);
                float v[8];
#pragma unroll
                for (int j = 0; j < 4; ++j) { v[j] = acc[bj][m][0][j]; v[4 + j] = acc[bj][m][1][j]; }
                v[0] *= bflo(g.x); v[1] *= bfhi(g.x); v[2] *= bflo(g.y); v[3] *= bfhi(g.y); v[4] *= bflo(g.z); v[5] *= bfhi(g.z); v[6] *= bflo(g.w); v[7] *= bfhi(g.w);
                if (PASS == 1) { const u32x4 p = *(const u32x4*)(MG + row * 1024 + col);
                    v[0] += bflo(p.x); v[1] += bfhi(p.x); v[2] += bflo(p.y); v[3] += bfhi(p.y); v[4] += bflo(p.z); v[5] += bfhi(p.z); v[6] += bflo(p.w); v[7] += bfhi(p.w); }
                u32x4 w; w.x = pk2(v[0], v[1]); w.y = pk2(v[2], v[3]); w.z = pk2(v[4], v[5]); w.w = pk2(v[6], v[7]);
                *(u32x4*)(MG + row * 1024 + col) = w;
            }
            asm volatile("" ::: "memory");
        }
    }
};
struct EpiPre1 {
    static constexpr bool PERM = false;
    const float* x; float* out;
    __device__ __forceinline__ void operator()(const f32x4 (&acc)[2][4][2], int ai, const Unit& u, int wr, int wc, int fr, int fq) const {
        const unsigned base = ((unsigned)(u.pm * BM + ai * HALF + wr * 64 + fr) * DM + (unsigned)(u.pn * BM + wc * 32 + 4 * fq)) * 4u;
#pragma unroll
        for (int m = 0; m < 4; ++m) {
#pragma unroll
            for (int bj = 0; bj < 2; ++bj)
#pragma unroll
                for (int n = 0; n < 2; ++n) {
                    const unsigned off = base + (unsigned)(((m * 16) * DM + bj * HALF + n * 16) * 4);
                    const f32x4 xv = *(const f32x4*)((const char*)x + off);
                    *(f32x4*)((char*)out + off) = acc[bj][m][n] + xv * DN_ALPHA;
                }
            asm volatile("" ::: "memory");
        }
    }
};
struct EpiSwiGLU {
    static constexpr bool PERM = true;
    bf16_t* H;
    __device__ __forceinline__ void operator()(const f32x4 (&acc)[2][4][2], int ai, const Unit& u, int wr, int wc, int fr, int fq) const {
        const int row0 = u.pm * BM + ai * HALF + wr * 64 + fr, col0 = u.pn * 128 + wc * 16 + 4 * fq;
#pragma unroll
        for (int m = 0; m < 4; ++m)
#pragma unroll
            for (int bj = 0; bj < 2; ++bj) {
                const f32x4 g = acc[bj][m][0], up = acc[bj][m][1];
                u32x2 w; w.x = pk2(silu(g[0]) * up[0], silu(g[1]) * up[1]); w.y = pk2(silu(g[2]) * up[2], silu(g[3]) * up[3]);
                *(u32x2*)(H + (size_t)(row0 + m * 16) * DE + col0 + bj * 64) = w;
            }
    }
};
struct EpiDown {
    static constexpr bool PERM = true;
    bf16_t* Y; const int* slot; const float* asgw; const LAS int* cn;
    __device__ __forceinline__ void operator()(const f32x4 (&acc)[2][4][2], int ai, const Unit& u, int wr, int wc, int fr, int fq) const {
        const int col0 = u.pn * BM + wc * 32 + 8 * fq; const int cnt = cn[u.e];
#pragma unroll
        for (int m = 0; m < 4; ++m) {
            const int s = u.mt * BM + ai * HALF + wr * 64 + m * 16 + fr;
            if (s < cnt) {
                const int asg = slot[(size_t)u.e * CAP + s]; const float w = asgw[asg];
#pragma unroll
                for (int bj = 0; bj < 2; ++bj) {
                    const f32x4 a = acc[bj][m][0] * w, b = acc[bj][m][1] * w;
                    u32x4 o; o.x = pk2(a[0], a[1]); o.y = pk2(a[2], a[3]); o.z = pk2(b[0], b[1]); o.w = pk2(b[2], b[3]);
                    *(u32x4*)(Y + (size_t)asg * DM + col0 + bj * HALF) = o;
                }
            }
            asm volatile("" ::: "memory");
        }
    }
};

template <class Prob, class Epi>
__device__ __forceinline__ void gemm_phase_naive(const Prob& P, const Epi& E) {
    const int tid = threadIdx.x, wid = tid >> 6, lane = tid & 63, wr = wid >> 2, wc = wid & 3, fr = lane & 15, fq = lane >> 4;
    const int K = P.K;
    Unit u;
    for (int i = 0; P.next(i, u); ++i) {
        const char* bB = P.b_base(u);
        for (int ai = 0; ai < 2; ++ai) {
            f32x4 acc[2][4][2];
#pragma unroll
            for (int b = 0; b < 2; ++b)
#pragma unroll
                for (int m = 0; m < 4; ++m)
#pragma unroll
                    for (int n = 0; n < 2; ++n) acc[b][m][n] = (f32x4){0.f, 0.f, 0.f, 0.f};
            unsigned ro[4];
#pragma unroll
            for (int m = 0; m < 4; ++m) ro[m] = P.a_rowoff(u, ai * HALF + wr * 64 + m * 16 + fr);
#pragma unroll 1
            for (int k = 0; k < K; k += 4) {
                u32x2 ap[4];
#pragma unroll
                for (int m = 0; m < 4; ++m) ap[m] = *(const u32x2*)(P.Abase + (ro[m] + (unsigned)k * 2u));
#pragma unroll
                for (int bj = 0; bj < 2; ++bj)
#pragma unroll
                    for (int n = 0; n < 2; ++n)
#pragma unroll
                        for (int j = 0; j < 4; ++j) {
                            const unsigned col = (unsigned)(bj * HALF + wc * 32 + (Epi::PERM ? (8 * fq + 4 * n + j) : (16 * n + 4 * fq + j)));
                            const u32x2 b = *(const u32x2*)(bB + (col * (unsigned)K + (unsigned)k) * 2u);
                            const float b0 = bflo(b.x), b1 = bfhi(b.x), b2 = bflo(b.y), b3 = bfhi(b.y);
#pragma unroll
                            for (int m = 0; m < 4; ++m) {
                                const u32x2 a = ap[m];
                                float s = acc[bj][m][n][j];
                                s = fmaf(bflo(a.x), b0, s); s = fmaf(bfhi(a.x), b1, s); s = fmaf(bflo(a.y), b2, s); s = fmaf(bfhi(a.y), b3, s);
                                acc[bj][m][n][j] = s;
                            }
                        }
                asm volatile("" ::: "memory");
            }
            E(acc, ai, u, wr, wc, fr, fq);
        }
    }
}

template <class Prob, class Epi, bool ALIGN_EPI, bool SP2>
__device__ __forceinline__ void gemm_phase_mfma(LAS unsigned char* lds, const Prob& P, const Epi& E) {
    const int tid = threadIdx.x, wid = __builtin_amdgcn_readfirstlane(tid >> 6), lane = tid & 63, wr = wid >> 2, wc = wid & 3, fr = lane & 15, fq = lane >> 4;
    const int K = P.K, nt = K / BK;
    int Ra[2]; unsigned Ca[2], voffB[2];
#pragma unroll
    for (int i = 0; i < 2; ++i) { int R, C; stage_rc(tid * 16 + i * 8192, R, C); const int Rb = Epi::PERM ? ((R & ~31) + perm32(R & 31)) : R;
        Ra[i] = R; Ca[i] = (unsigned)C * 2u; voffB[i] = (unsigned)(Rb * K + C) * 2u; }
    const size_t kstep = (size_t)(BK * 2);
    const size_t hstep = (size_t)HALF * K * 2;
    const unsigned ldsw = (unsigned)wid * 1024u;
    const int aoff = lds_byte(wr * 64 + fr, fq * 8), boff = lds_byte(wc * 32 + fr, fq * 8);
#define PG8_SA(b, h) (((b) * 2 + (h)) * HTB)
#define PG8_SB(b, h) ((4 + (b) * 2 + (h)) * HTB)
#define PG8_STAGEB(bufoff, gbase) do { _Pragma("unroll") for (int _i = 0; _i < 2; ++_i) \
        __builtin_amdgcn_global_load_lds((const unsigned*)((const char*)(gbase) + voffB[_i]), (LAS unsigned*)(lds + (bufoff) + ldsw + _i * 8192), 16, 0, 0); } while (0)
#define PG8_STAGEA(bufoff, gbase, v0, v1) do { \
        __builtin_amdgcn_global_load_lds((const unsigned*)((const char*)(gbase) + (v0)), (LAS unsigned*)(lds + (bufoff) + ldsw), 16, 0, 0); \
        __builtin_amdgcn_global_load_lds((const unsigned*)((const char*)(gbase) + (v1)), (LAS unsigned*)(lds + (bufoff) + ldsw + 8192), 16, 0, 0); } while (0)
#define PG8_LDA(dst, b, h) do { _Pragma("unroll") for (int m = 0; m < 4; ++m) _Pragma("unroll") for (int k = 0; k < 2; ++k) dst[m][k] = *(const LAS bf16x8*)(lds + PG8_SA(b, h) + aoff + m * 2048 + k * 1024); } while (0)
#define PG8_LDB(dst, b, h) do { _Pragma("unroll") for (int n = 0; n < 2; ++n) _Pragma("unroll") for (int k = 0; k < 2; ++k) dst[n][k] = *(const LAS bf16x8*)(lds + PG8_SB(b, h) + boff + n * 2048 + k * 1024); } while (0)
#define PG8_MMA(ai, bj, At, Bt) do { __builtin_amdgcn_s_setprio(1); _Pragma("unroll") for (int m = 0; m < 4; ++m) _Pragma("unroll") for (int n = 0; n < 2; ++n) _Pragma("unroll") for (int k = 0; k < 2; ++k) \
        acc[ai][bj][m][n] = __builtin_amdgcn_mfma_f32_16x16x32_bf16(Bt[n][k], At[m][k], acc[ai][bj][m][n], 0, 0, 0); __builtin_amdgcn_s_setprio(0); } while (0)
#define PG8_WAIT_V(n) asm volatile("s_waitcnt vmcnt(" #n ")" ::: "memory")
#define PG8_WAIT_L(n) asm volatile("s_waitcnt lgkmcnt(" #n ")" ::: "memory")
#define PG8_BAR __builtin_amdgcn_s_barrier()
#define PG8_SCHED __builtin_amdgcn_sched_barrier(0)
    Unit cur, nxt; int ui = 0;
    if (!P.next(0, cur)) return;
    f32x4 acc[2][2][4][2];
#pragma unroll
    for (int a = 0; a < 2; ++a)
#pragma unroll
        for (int b = 0; b < 2; ++b)
#pragma unroll
            for (int m = 0; m < 4; ++m)
#pragma unroll
                for (int n = 0; n < 2; ++n) acc[a][b][m][n] = (f32x4){0.f, 0.f, 0.f, 0.f};
    bf16x8 At[4][2], B0[2][2], B1[2][2];
    const char* const cA = P.Abase;
    const char* cB = P.b_base(cur);
    unsigned va0, va1, va2, va3;
    va0 = P.a_rowoff(cur, Ra[0]) + Ca[0]; va1 = P.a_rowoff(cur, Ra[1]) + Ca[1]; va2 = P.a_rowoff(cur, HALF + Ra[0]) + Ca[0]; va3 = P.a_rowoff(cur, HALF + Ra[1]) + Ca[1];
    if constexpr (SP2) {
        PG8_STAGEB(PG8_SB(0, 0), cB); PG8_STAGEB(PG8_SB(0, 1), cB + hstep); PG8_STAGEA(PG8_SA(0, 0), cA, va0, va1); PG8_STAGEA(PG8_SA(0, 1), cA, va2, va3);
        if (wr == 1) PG8_BAR;
        PG8_WAIT_V(2); PG8_BAR;
        PG8_STAGEB(PG8_SB(1, 0), cB + kstep); PG8_STAGEA(PG8_SA(1, 0), cA + kstep, va0, va1); PG8_STAGEB(PG8_SB(1, 1), cB + hstep + kstep);
        PG8_WAIT_V(6); PG8_BAR;
    } else {
        PG8_STAGEB(PG8_SB(0, 0), cB); PG8_STAGEA(PG8_SA(0, 0), cA, va0, va1); PG8_STAGEB(PG8_SB(0, 1), cB + hstep); PG8_STAGEA(PG8_SA(0, 1), cA, va2, va3);
        if (wr == 1) PG8_BAR;
        PG8_WAIT_V(4); PG8_BAR;
        PG8_STAGEB(PG8_SB(1, 0), cB + kstep); PG8_STAGEA(PG8_SA(1, 0), cA + kstep, va0, va1); PG8_STAGEB(PG8_SB(1, 1), cB + hstep + kstep);
        PG8_WAIT_V(6); PG8_BAR;
    }
    for (;;) {
        const bool has_next = P.next(ui + 1, nxt);
        unsigned vn0 = va0, vn1 = va1, vn2 = va2, vn3 = va3; const char* nB = cB;
        if (has_next) { nB = P.b_base(nxt);
            vn0 = P.a_rowoff(nxt, Ra[0]) + Ca[0]; vn1 = P.a_rowoff(nxt, Ra[1]) + Ca[1]; vn2 = P.a_rowoff(nxt, HALF + Ra[0]) + Ca[0]; vn3 = P.a_rowoff(nxt, HALF + Ra[1]) + Ca[1]; }
        for (int t = 0; t < nt; t += 2) {
            const bool last = (t == nt - 2);
            const char* a1 = cA + (size_t)(t + 1) * kstep;
            const char* a2 = last ? cA : cA + (size_t)(t + 2) * kstep; const char* b2 = last ? nB : cB + (size_t)(t + 2) * kstep;
            const char* a3 = a2 + kstep; const char* b3 = b2 + kstep;
            const unsigned w0 = last ? vn0 : va0, w1 = last ? vn1 : va1, w2 = last ? vn2 : va2, w3 = last ? vn3 : va3;
            if constexpr (SP2) {
            PG8_LDB(B0, 0, 0); PG8_LDB(B1, 0, 1); PG8_SCHED; PG8_LDA(At, 0, 0); PG8_STAGEA(PG8_SA(1, 1), a1, va2, va3);
            PG8_WAIT_V(8); PG8_WAIT_L(0); PG8_BAR; PG8_MMA(0, 0, At, B0); PG8_MMA(0, 1, At, B1); PG8_BAR; PG8_SCHED;
            PG8_LDA(At, 0, 1); PG8_STAGEB(PG8_SB(0, 0), b2); PG8_STAGEB(PG8_SB(0, 1), b2 + hstep); PG8_STAGEA(PG8_SA(0, 0), a2, w0, w1);
            PG8_WAIT_V(8); PG8_WAIT_L(0); PG8_BAR; PG8_MMA(1, 0, At, B0); PG8_MMA(1, 1, At, B1); PG8_BAR; PG8_SCHED;
            PG8_LDB(B0, 1, 0); PG8_LDB(B1, 1, 1); PG8_SCHED; PG8_LDA(At, 1, 0); PG8_STAGEA(PG8_SA(0, 1), a2, w2, w3);
            PG8_WAIT_V(8); PG8_WAIT_L(0); PG8_BAR; PG8_MMA(0, 0, At, B0); PG8_MMA(0, 1, At, B1); PG8_BAR; PG8_SCHED;
            PG8_LDA(At, 1, 1); PG8_STAGEB(PG8_SB(1, 0), b3); PG8_STAGEB(PG8_SB(1, 1), b3 + hstep); PG8_STAGEA(PG8_SA(1, 0), a3, w0, w1);
            PG8_WAIT_V(8); PG8_WAIT_L(0); PG8_BAR; PG8_MMA(1, 0, At, B0); PG8_MMA(1, 1, At, B1); PG8_BAR; PG8_SCHED;
            } else {
            PG8_LDB(B0, 0, 0); PG8_SCHED; PG8_LDA(At, 0, 0); PG8_STAGEA(PG8_SA(1, 1), a1, va2, va3);
            PG8_WAIT_L(8); PG8_BAR; PG8_WAIT_L(0); PG8_MMA(0, 0, At, B0); PG8_BAR; PG8_SCHED;
            PG8_LDB(B1, 0, 1); PG8_STAGEB(PG8_SB(0, 0), b2);
            PG8_BAR; PG8_WAIT_L(0); PG8_MMA(0, 1, At, B1); PG8_BAR;
            PG8_LDA(At, 0, 1); PG8_STAGEA(PG8_SA(0, 0), a2, w0, w1);
            PG8_BAR; PG8_WAIT_L(0); PG8_MMA(1, 0, At, B0); PG8_BAR; PG8_SCHED;
            PG8_STAGEB(PG8_SB(0, 1), b2 + hstep);
            PG8_WAIT_V(6); PG8_BAR; PG8_MMA(1, 1, At, B1); PG8_BAR;
            PG8_LDB(B0, 1, 0); PG8_SCHED; PG8_LDA(At, 1, 0); PG8_STAGEA(PG8_SA(0, 1), a2, w2, w3);
            PG8_WAIT_L(8); PG8_BAR; PG8_WAIT_L(0); PG8_MMA(0, 0, At, B0); PG8_BAR; PG8_SCHED;
            PG8_LDB(B1, 1, 1); PG8_STAGEB(PG8_SB(1, 0), b3);
            PG8_BAR; PG8_WAIT_L(0); PG8_MMA(0, 1, At, B1); PG8_BAR;
            PG8_LDA(At, 1, 1); PG8_STAGEA(PG8_SA(1, 0), a3, w0, w1);
            PG8_BAR; PG8_WAIT_L(0); PG8_MMA(1, 0, At, B0); PG8_BAR; PG8_SCHED;
            PG8_STAGEB(PG8_SB(1, 1), b3 + hstep);
            PG8_WAIT_V(6); PG8_BAR; PG8_MMA(1, 1, At, B1); PG8_BAR;
            }
        }
        if constexpr (ALIGN_EPI) { if (wr == 0) PG8_BAR; }
        E(acc[0], 0, cur, wr, wc, fr, fq); E(acc[1], 1, cur, wr, wc, fr, fq);
        if (!has_next) break;
#pragma unroll
        for (int a = 0; a < 2; ++a)
#pragma unroll
            for (int b = 0; b < 2; ++b)
#pragma unroll
                for (int m = 0; m < 4; ++m)
#pragma unroll
                    for (int n = 0; n < 2; ++n) acc[a][b][m][n] = (f32x4){0.f, 0.f, 0.f, 0.f};
        cur = nxt; cB = nB; va0 = vn0; va1 = vn1; va2 = vn2; va3 = vn3; ++ui;
        if constexpr (ALIGN_EPI) { if (wr == 1) PG8_BAR; }
    }
    PG8_WAIT_V(0);
    if constexpr (!ALIGN_EPI) { if (wr == 0) PG8_BAR; }
    PG8_BAR;
#undef PG8_SA
#undef PG8_SB
#undef PG8_STAGEA
#undef PG8_STAGEB
#undef PG8_LDA
#undef PG8_LDB
#undef PG8_MMA
#undef PG8_WAIT_V
#undef PG8_WAIT_L
#undef PG8_BAR
#undef PG8_SCHED
}

template <class Prob, class Epi>
__device__ __forceinline__ void gemm_phase(LAS unsigned char* lds, const Prob& P, const Epi& E) {
#if NAIVE_GEMM
    gemm_phase_naive<Prob, Epi>(P, E);
#else
    gemm_phase_mfma<Prob, Epi, true, true>(lds, P, E);
#endif
}

struct Args {
    const float* in[19]; float* out; unsigned char* ws; int ph_lo, ph_hi, coop, pad;
};

template <int MAPMODE  >
__device__ __forceinline__ void p0_transpose_item(const float* W, int K, int N, bf16_t* WT, LAS float* scr, int item, int lane) {
    const int nblk = N / 32, kb = item / nblk, nb = item % nblk, k0 = 64 * kb, n0 = 32 * nb;
#pragma unroll 8
    for (int i = 0; i < 32; ++i) { const int kk = 2 * i + (lane >> 5); scr[kk * 33 + (lane & 31)] = W[(size_t)(k0 + kk) * N + n0 + (lane & 31)]; }
    LDS_WAIT();
    const int c = lane & 7;
#pragma unroll
    for (int j = 0; j < 4; ++j) { const int n = (lane >> 3) + 8 * j; const LAS float* s = scr + (8 * c) * 33 + n;
        u32x4 o; o.x = pk2(s[0 * 33], s[1 * 33]); o.y = pk2(s[2 * 33], s[3 * 33]); o.z = pk2(s[4 * 33], s[5 * 33]); o.w = pk2(s[6 * 33], s[7 * 33]);
        const int ng = n0 + n; const int row = (MAPMODE == 0) ? ng : ((ng >> 2) * 8 + (MAPMODE == 2 ? 4 : 0) + (ng & 3));
        *(u32x4*)(WT + (size_t)row * K + k0 + 8 * c) = o; }
    LDS_WAIT();
}
__device__ __forceinline__ void p0_prologue(const Args& a, LAS unsigned char* lds) {
    const int tid = threadIdx.x, lane = tid & 63, wave = tid >> 6;
    unsigned char* ws = a.ws;
    LAS float* scr = (LAS float*)(lds + wave * 16384);
    const int gw = blockIdx.x * NWAVES + wave, NGW = gridDim.x * NWAVES;
    constexpr int I_IN = (DM / 64) * (PW / 32), I_A = (512 / 64) * (DM / 32), I_O = (DM / 64) * (DM / 32), I_G = (DM / 64) * (DE / 32), I_D = (DE / 64) * (DM / 32);
    constexpr int NITEMS = I_IN + 2 * I_A + I_O + NE * (2 * I_G + I_D);
    for (int it = gw; it < NITEMS; it += NGW) {
        int r = it;
        if (r < I_IN) { p0_transpose_item<0>(a.in[2], DM, PW, (bf16_t*)(ws + WS_WIN), scr, r, lane); continue; } r -= I_IN;
        if (r < I_A) { p0_transpose_item<0>(a.in[5], 512, DM, (bf16_t*)(ws + WS_WA), scr, r, lane); continue; } r -= I_A;
        if (r < I_A) { p0_transpose_item<0>(a.in[6], 512, DM, (bf16_t*)(ws + WS_WB), scr, r, lane); continue; } r -= I_A;
        if (r < I_O) { p0_transpose_item<0>(a.in[7], DM, DM, (bf16_t*)(ws + WS_WO), scr, r, lane); continue; } r -= I_O;
        const int e = r / (2 * I_G + I_D); r -= e * (2 * I_G + I_D);
        if (r < I_G) { p0_transpose_item<1>(a.in[14] + (size_t)e * DM * DE, DM, DE, (bf16_t*)(ws + WS_WGU) + (size_t)e * DM * DM, scr, r, lane); continue; } r -= I_G;
        if (r < I_G) { p0_transpose_item<2>(a.in[15] + (size_t)e * DM * DE, DM, DE, (bf16_t*)(ws + WS_WGU) + (size_t)e * DM * DM, scr, r, lane); continue; } r -= I_G;
        p0_transpose_item<0>(a.in[16] + (size_t)e * DE * DM, DE, DM, (bf16_t*)(ws + WS_WD) + (size_t)e * DM * DE, scr, r, lane);
    }
    {
        const f32x4* x4 = (const f32x4*)a.in[0]; u32x4* o = (u32x4*)(ws + WS_RA);
        const size_t n8 = (size_t)T_ * DM / 8, stride = (size_t)gridDim.x * NTHREADS;
        for (size_t i = (size_t)blockIdx.x * NTHREADS + tid; i < n8; i += stride) {
            const f32x4 p = x4[2 * i], q = x4[2 * i + 1];
            u32x4 w; w.x = pk2(p[0], p[1]); w.y = pk2(p[2], p[3]); w.z = pk2(q[0], q[1]); w.w = pk2(q[2], q[3]);
            o[i] = w;
        }
    }
    if (blockIdx.x == 0) {
        float* lb = (float*)(ws + WS_LB); const float* lg = a.in[1];
        lb[tid] = 1.f / (1.f + __expf(lg[512 + tid] - lg[tid]));
        unsigned* ctl = (unsigned*)(ws + WS_CTL);
        if (tid < 32) ctl[CW_CNT + tid] = 0u;
        if (tid == 32) ctl[CW_ATTQ] = 0u;
    }
}

__device__ __forceinline__ void hgrn_naive(LAS unsigned char* lds, const bf16_t* HB, const float* normw, bf16_t* OH, int item) {
    const int tid = threadIdx.x, lane = tid & 63, wave = tid >> 6, v = tid & 127, kg = tid >> 7;
    const int b = item >> 2, h = item & 3;
    LAS float* sq = (LAS float*)lds;
    LAS float* sf = sq + 64 * 128;
    LAS float* sv = sf + 64 * 128;
    LAS float* so = sv + 64 * 128;
    LAS float* sp = so + 64 * 128;
    float S[32];
#pragma unroll
    for (int i = 0; i < 32; ++i) S[i] = 0.f;
    for (int c = 0; c < 32; ++c) {
        const size_t row0 = (size_t)b * SEQ + c * 64;
        for (int i = 0; i < 16; ++i) { const int idx = tid + 512 * i, r = idx >> 7, col = idx & 127; const bf16_t* p = HB + (row0 + r) * 2048 + h * 128 + col;
            sq[idx] = bf2f(p[0]); sf[idx] = __expf(bf2f(p[512])); sv[idx] = bf2f(p[1024]); }
        __syncthreads();
        for (int t = 0; t < 64; ++t) {
            const float vt = sv[t * 128 + v]; float part = 0.f;
#pragma unroll
            for (int i = 0; i < 32; ++i) { const float f = sf[t * 128 + kg * 32 + i]; S[i] = f * S[i] + (1.f - f) * vt; part += sq[t * 128 + kg * 32 + i] * S[i]; }
            sp[((t & 1) * 4 + kg) * 128 + v] = part;
            __syncthreads();
            if (kg == 0) { const LAS float* q = sp + (t & 1) * 4 * 128 + v; so[t * 128 + v] = (q[0] + q[128]) + (q[256] + q[384]); }
        }
        __syncthreads();
        for (int tt = 0; tt < 8; ++tt) { const int t = wave * 8 + tt; const float o0 = so[t * 128 + lane], o1 = so[t * 128 + 64 + lane];
            const float ss = wave_sum(o0 * o0 + o1 * o1); const float rstd = rsqrtf(ss * (1.f / 128.f) + RMS_EPS);
            const bf16_t* g = HB + (row0 + t) * 2048 + 1536 + h * 128; bf16_t* o = OH + (row0 + t) * 512 + h * 128;
            o[lane] = (bf16_t)f2bf(o0 * rstd * normw[lane] * bf2f(g[lane])); o[64 + lane] = (bf16_t)f2bf(o1 * rstd * normw[64 + lane] * bf2f(g[64 + lane])); }
        __syncthreads();
    }
}

__device__ __forceinline__ void attn_naive(LAS unsigned char* lds, const bf16_t* AB, const float* sinks, bf16_t* OA, int item) {
    const int tid = threadIdx.x, lane = tid & 63, wave = tid >> 6;
    const int hk = item & 1, n = (item >> 1) & 15, b = item >> 5;
    LAS bf16_t* Ks = (LAS bf16_t*)lds;
    LAS bf16_t* Vs = Ks + 256 * 64;
    LAS float* qs = (LAS float*)(lds + 65536) + wave * 192;
    LAS float* ps = qs + 64;
    __syncthreads();
    for (int i = 0; i < 8; ++i) { const int ch = tid + 512 * i; const int kv = ch >> 11, rr = (ch >> 3) & 255, c8 = ch & 7; const int kp = n * 128 - 128 + rr;
        u32x4 val = (u32x4){0u, 0u, 0u, 0u};
        if (kp >= 0) val = *(const u32x4*)(AB + ((size_t)b * SEQ + kp) * 768 + 512 + kv * 128 + hk * 64 + c8 * 8);
        *(LAS u32x4*)((kv ? Vs : Ks) + rr * 64 + c8 * 8) = val; }
    __syncthreads();
    const int g = wave >> 1, head = hk * 4 + g; const float slope = exp2f(-(float)(head + 1)); const float sink = sinks[head];
    for (int ii = 0; ii < 64; ++ii) {
        const int i = (wave & 1) * 64 + ii; const size_t row = (size_t)b * SEQ + n * 128 + i;
        qs[lane] = bf2f(AB[row * 768 + head * 64 + lane]);
        LDS_WAIT();
        float s0 = 0.f, s1 = 0.f; const int j0 = i + 1 + lane, j1 = i + 65 + lane;
#pragma unroll
        for (int d8 = 0; d8 < 8; ++d8) {
            const u32x4 k0 = *(const LAS u32x4*)(Ks + j0 * 64 + d8 * 8), k1 = *(const LAS u32x4*)(Ks + j1 * 64 + d8 * 8);
            const f32x4 qa = *(const LAS f32x4*)(qs + d8 * 8), qb = *(const LAS f32x4*)(qs + d8 * 8 + 4);
            s0 += qa[0] * bflo(k0.x) + qa[1] * bfhi(k0.x) + qa[2] * bflo(k0.y) + qa[3] * bfhi(k0.y) + qb[0] * bflo(k0.z) + qb[1] * bfhi(k0.z) + qb[2] * bflo(k0.w) + qb[3] * bfhi(k0.w);
            s1 += qa[0] * bflo(k1.x) + qa[1] * bfhi(k1.x) + qa[2] * bflo(k1.y) + qa[3] * bfhi(k1.y) + qb[0] * bflo(k1.z) + qb[1] * bfhi(k1.z) + qb[2] * bflo(k1.w) + qb[3] * bfhi(k1.w);
        }
        const bool v0 = (n * 128 - 128 + j0) >= 0, v1 = (n * 128 - 128 + j1) >= 0;
        const float l0 = v0 ? s0 - slope * (float)(127 - lane) : -1e30f, l1 = v1 ? s1 - slope * (float)(63 - lane) : -1e30f;
        const float mx = fmaxf(wave_max(fmaxf(l0, l1)), sink);
        const float e0 = __expf(l0 - mx), e1 = __expf(l1 - mx);
        const float den = wave_sum(e0 + e1) + __expf(sink - mx); const float inv = 1.f / den;
        ps[lane] = e0 * inv; ps[64 + lane] = e1 * inv;
        LDS_WAIT();
        float o = 0.f;
#pragma unroll 8
        for (int jj = 0; jj < 128; ++jj) o += ps[jj] * bf2f(Vs[(i + 1 + jj) * 64 + lane]);
        OA[row * 512 + head * 64 + lane] = (bf16_t)f2bf(o);
        LDS_WAIT();
    }
}

__device__ __forceinline__ void p5_ln_router(const Args& a, LAS unsigned char* lds) {
    const int tid = threadIdx.x, lane = tid & 63, wave = tid >> 6;
    unsigned char* ws = a.ws;
    const float* pre1 = a.out; bf16_t* X1B = (bf16_t*)(ws + WS_RA);
    const float* g1 = a.in[8]; const float* b1 = a.in[9];
    const float* rgw = a.in[10]; const float* rgb = a.in[11]; const float* rew = a.in[12]; const float* reb = a.in[13];
    unsigned* ctl = (unsigned*)(ws + WS_CTL); int* slot = (int*)(ws + WS_SLOT); float* asgw = (float*)(ws + WS_ASGW);
    LAS int* hist = (LAS int*)(lds);
    LAS int* base = hist + 32;
    LAS int* se = base + 32;
    LAS int* sr = se + 128;
    LAS float* sw = (LAS float*)(sr + 128);
    f32x4 gv[4], bv[4];
#pragma unroll
    for (int j = 0; j < 4; ++j) { gv[j] = *(const f32x4*)(g1 + 4 * lane + 256 * j); bv[j] = *(const f32x4*)(b1 + 4 * lane + 256 * j); }
    for (int it = blockIdx.x; it < T_ / 64; it += gridDim.x) {
        __syncthreads();
        if (tid < 32) hist[tid] = 0;
        __syncthreads();
        for (int rr = 0; rr < 8; ++rr) {
            const int rl = wave * 8 + rr; const size_t row = (size_t)it * 64 + rl;
            f32x4 v[4]; float s = 0.f;
#pragma unroll
            for (int j = 0; j < 4; ++j) { v[j] = *(const f32x4*)(pre1 + row * DM + 4 * lane + 256 * j); s += (v[j][0] + v[j][1]) + (v[j][2] + v[j][3]); }
            const float mean = wave_sum(s) * (1.f / DM); float s2 = 0.f;
#pragma unroll
            for (int j = 0; j < 4; ++j) { v[j] = v[j] - mean; s2 += (v[j][0] * v[j][0] + v[j][1] * v[j][1]) + (v[j][2] * v[j][2] + v[j][3] * v[j][3]); }
            const float rstd = rsqrtf(wave_sum(s2) * (1.f / DM) + LN_EPS);
#pragma unroll
            for (int j = 0; j < 4; ++j) { v[j] = v[j] * rstd * gv[j] + bv[j];
                u32x2 w; w.x = pk2(v[j][0], v[j][1]); w.y = pk2(v[j][2], v[j][3]); *(u32x2*)(X1B + row * DM + 4 * lane + 256 * j) = w; }
            float lg[36];
#pragma unroll
            for (int o = 0; o < 36; ++o) lg[o] = 0.f;
#pragma unroll
            for (int j = 0; j < 4; ++j)
#pragma unroll
                for (int c = 0; c < 4; ++c) { const int k = 4 * lane + 256 * j + c; const float xv = v[j][c];
                    const f32x4 wg = *(const f32x4*)(rgw + (size_t)k * 4);
#pragma unroll
                    for (int o = 0; o < 4; ++o) lg[o] += xv * wg[o];
#pragma unroll
                    for (int q = 0; q < 8; ++q) { const f32x4 we = *(const f32x4*)(rew + (size_t)k * 32 + 4 * q);
#pragma unroll
                        for (int o = 0; o < 4; ++o) lg[4 + 4 * q + o] += xv * we[o]; }
                    asm volatile("" ::: "memory"); }
#pragma unroll
            for (int o = 0; o < 36; ++o) lg[o] = wave_sum(lg[o]);
            if (lane == 0) {
                float gl[4]; int gs = 0; float gm;
#pragma unroll
                for (int o = 0; o < 4; ++o) gl[o] = lg[o] + rgb[o];
                gm = gl[0];
#pragma unroll
                for (int o = 1; o < 4; ++o) if (gl[o] > gm) { gm = gl[o]; gs = o; }
                float gsum = 0.f;
#pragma unroll
                for (int o = 0; o < 4; ++o) gsum += __expf(gl[o] - gm);
                const float gw = 1.f / gsum;
                float el[8];
#pragma unroll
                for (int o = 0; o < 8; ++o) { float t = 0.f;
#pragma unroll
                    for (int q = 0; q < 4; ++q) t = (gs == q) ? (lg[4 + 8 * q + o] + reb[8 * q + o]) : t;
                    el[o] = t; }
                int i1 = 0; float m1 = el[0];
#pragma unroll
                for (int o = 1; o < 8; ++o) if (el[o] > m1) { m1 = el[o]; i1 = o; }
                int i2 = -1; float m2 = -3.0e38f;
#pragma unroll
                for (int o = 0; o < 8; ++o) if (o != i1 && el[o] > m2) { m2 = el[o]; i2 = o; }
                const float e2 = __expf(m2 - m1); const float w1 = gw / (1.f + e2), w2 = gw * e2 / (1.f + e2);
                const int x1 = gs * 8 + i1, x2 = gs * 8 + i2;
                se[rl * 2] = x1; se[rl * 2 + 1] = x2; sw[rl * 2] = w1; sw[rl * 2 + 1] = w2;
                sr[rl * 2] = atomicAdd((int*)(hist + x1), 1); sr[rl * 2 + 1] = atomicAdd((int*)(hist + x2), 1);
            }
        }
        __syncthreads();
        if (tid < 32) { const int hcount = hist[tid]; base[tid] = hcount > 0 ? (int)atomicAdd(ctl + CW_CNT + tid, (unsigned)hcount) : 0; }
        __syncthreads();
        if (tid < 128) { const int e = se[tid]; const int pos = base[e] + sr[tid]; const int asg = (it * 64 + (tid >> 1)) * 2 + (tid & 1);
            slot[(size_t)e * CAP + pos] = asg; asgw[asg] = sw[tid]; }
    }
}

__device__ __forceinline__ void p7_final(const Args& a) {
    const int tid = threadIdx.x, lane = tid & 63, wave = tid >> 6;
    const bf16_t* X1B = (const bf16_t*)(a.ws + WS_RA); const bf16_t* Y = (const bf16_t*)(a.ws + WS_RB);
    const float* g2 = a.in[17]; const float* b2 = a.in[18];
    f32x4 gv[4], bv[4];
#pragma unroll
    for (int j = 0; j < 4; ++j) { gv[j] = *(const f32x4*)(g2 + 4 * lane + 256 * j); bv[j] = *(const f32x4*)(b2 + 4 * lane + 256 * j); }
    const int gw = blockIdx.x * NWAVES + wave, NGW = gridDim.x * NWAVES;
    for (int row = gw; row < T_; row += NGW) {
        f32x4 v[4]; float s = 0.f;
#pragma unroll
        for (int j = 0; j < 4; ++j) {
            const u32x2 xw = *(const u32x2*)(X1B + (size_t)row * DM + 4 * lane + 256 * j);
            const u32x2 y0 = *(const u32x2*)(Y + (size_t)(2 * row) * DM + 4 * lane + 256 * j);
            const u32x2 y1 = *(const u32x2*)(Y + (size_t)(2 * row + 1) * DM + 4 * lane + 256 * j);
            v[j][0] = DN_ALPHA * bflo(xw.x) + (bflo(y0.x) + bflo(y1.x)); v[j][1] = DN_ALPHA * bfhi(xw.x) + (bfhi(y0.x) + bfhi(y1.x));
            v[j][2] = DN_ALPHA * bflo(xw.y) + (bflo(y0.y) + bflo(y1.y)); v[j][3] = DN_ALPHA * bfhi(xw.y) + (bfhi(y0.y) + bfhi(y1.y));
            s += (v[j][0] + v[j][1]) + (v[j][2] + v[j][3]);
        }
        const float mean = wave_sum(s) * (1.f / DM); float s2 = 0.f;
#pragma unroll
        for (int j = 0; j < 4; ++j) { v[j] = v[j] - mean; s2 += (v[j][0] * v[j][0] + v[j][1] * v[j][1]) + (v[j][2] * v[j][2] + v[j][3] * v[j][3]); }
        const float rstd = rsqrtf(wave_sum(s2) * (1.f / DM) + LN_EPS);
#pragma unroll
        for (int j = 0; j < 4; ++j) *(f32x4*)(a.out + (size_t)row * DM + 4 * lane + 256 * j) = v[j] * rstd * gv[j] + bv[j];
    }
}

__device__ __forceinline__ void moe_tables(const Args& a, LAS unsigned char* lds) {
    LAS int* cn = (LAS int*)(lds + MISC_OFF); LAS int* tp = cn + 32;
    const unsigned* ctl = (const unsigned*)(a.ws + WS_CTL);
    __syncthreads();
    if (threadIdx.x < 32) cn[threadIdx.x] = (int)__hip_atomic_load(ctl + CW_CNT + threadIdx.x, __ATOMIC_RELAXED, __HIP_MEMORY_SCOPE_AGENT);
    __syncthreads();
    if (threadIdx.x == 0) { int s = 0; for (int e = 0; e < 32; ++e) { tp[e] = s; s += (cn[e] + BM - 1) / BM; } tp[32] = s; }
    __syncthreads();
}

constexpr int NPHASES = 10;
__global__ void __launch_bounds__(NTHREADS, 2) mk_fwd(Args a) {
    extern __shared__ __attribute__((aligned(16))) unsigned char lds_raw[];
    LAS unsigned char* lds = (LAS unsigned char*)lds_raw;
    unsigned char* ws = a.ws;
    const int lo = a.ph_lo, hi = a.ph_hi;
    const int G = gridDim.x, bid = blockIdx.x;
#ifndef PHASE_MASK
#define PHASE_MASK 0x3ff
#endif
#define IN(k) (((PHASE_MASK >> (k)) & 1) && lo <= (k) && (k) < hi)
#define SEAM(k) do { if (IN(k) && IN((k) + 1) && a.coop) { cg::this_grid().sync(); } } while (0)
    bf16_t* XB = (bf16_t*)(ws + WS_RA); bf16_t* MG = (bf16_t*)(ws + WS_RA); bf16_t* X1B = (bf16_t*)(ws + WS_RA);
    bf16_t* HB = (bf16_t*)(ws + WS_RB); bf16_t* Yb = (bf16_t*)(ws + WS_RB);
    bf16_t* AB = (bf16_t*)(ws + WS_RC); bf16_t* GB = (bf16_t*)(ws + WS_RD); bf16_t* HM = (bf16_t*)(ws + WS_RD);
    bf16_t* OH = (bf16_t*)(ws + WS_RE); bf16_t* OA = (bf16_t*)(ws + WS_RF);

    if (IN(0)) { p0_prologue(a, lds); }
    SEAM(0);
    if (IN(1)) {
        DenseProb P; P.init(XB, ws + WS_WIN, T_, PW, DM, G, bid);
        EpiProj E{HB, AB, GB, (const float*)(ws + WS_LB)};
        gemm_phase<DenseProb, EpiProj>(lds, P, E);
    }
    SEAM(1);
    if (IN(2)) {
        if (bid < 128) hgrn_naive(lds, HB, a.in[3], OH, bid);
        unsigned* ctl = (unsigned*)(ws + WS_CTL);
        LAS int* qi = (LAS int*)(lds + MISC_OFF + 1024);
        for (;;) {
            __syncthreads();
            if (threadIdx.x == 0) qi[0] = (int)atomicAdd(ctl + CW_ATTQ, 1u);
            __syncthreads();
            const int item = qi[0];
            if (item >= 1024) break;
            attn_naive(lds, AB, a.in[4], OA, item);
        }
    }
    SEAM(2);
    if (IN(3)) {
        DenseProb P; P.init(OH, ws + WS_WA, T_, DM, 512, G, bid);
        EpiGate<0> E{MG, GB};
        gemm_phase<DenseProb, EpiGate<0>>(lds, P, E);
    }
    SEAM(3);
    if (IN(4)) {
        DenseProb P; P.init(OA, ws + WS_WB, T_, DM, 512, G, bid);
        EpiGate<1> E{MG, GB};
        gemm_phase<DenseProb, EpiGate<1>>(lds, P, E);
    }
    SEAM(4);
    if (IN(5)) {
        DenseProb P; P.init(MG, ws + WS_WO, T_, DM, DM, G, bid);
        EpiPre1 E{a.in[0], a.out};
        gemm_phase<DenseProb, EpiPre1>(lds, P, E);
    }
    SEAM(5);
    if (IN(6)) { p5_ln_router(a, lds); }
    SEAM(6);
    if (IN(7)) {
        moe_tables(a, lds);
        MoeProb<true> P; P.Abase = (const char*)X1B; P.Bt = (const char*)(ws + WS_WGU); P.K = DM; P.G = G; P.c = bid;
        P.tp = (const LAS int*)(lds + MISC_OFF) + 32; P.cn = (const LAS int*)(lds + MISC_OFF); P.slot = (const int*)(ws + WS_SLOT); P.estride = (size_t)DM * DM * 2;
        EpiSwiGLU E{HM};
        gemm_phase<MoeProb<true>, EpiSwiGLU>(lds, P, E);
    }
    SEAM(7);
    if (IN(8)) {
        moe_tables(a, lds);
        MoeProb<false> P; P.Abase = (const char*)HM; P.Bt = (const char*)(ws + WS_WD); P.K = DE; P.G = G; P.c = bid;
        P.tp = (const LAS int*)(lds + MISC_OFF) + 32; P.cn = (const LAS int*)(lds + MISC_OFF); P.slot = (const int*)(ws + WS_SLOT); P.estride = (size_t)DM * DE * 2;
        EpiDown E{Yb, (const int*)(ws + WS_SLOT), (const float*)(ws + WS_ASGW), (const LAS int*)(lds + MISC_OFF)};
        gemm_phase<MoeProb<false>, EpiDown>(lds, P, E);
    }
    SEAM(8);
    if (IN(9)) { p7_final(a); }
#undef IN
#undef SEAM
}

extern "C" void kernel_launch(void* const* d_in, const int* in_sizes, int n_in, void* d_out, int out_size, void* d_ws, size_t ws_size, hipStream_t stream) {
    static int grid = 0;
    if (grid == 0) {
        if (n_in != 19 || out_size != T_ * DM || ws_size < WS_END) { fprintf(stderr, "kernel_launch: unexpected shapes (n_in %d out %d ws %zu)\n", n_in, out_size, ws_size); grid = -1; return; }
        int dev = 0, cus = 0, per_cu = 0;
        (void)hipGetDevice(&dev); (void)hipDeviceGetAttribute(&cus, hipDeviceAttributeMultiprocessorCount, dev);
        (void)hipFuncSetAttribute((const void*)mk_fwd, hipFuncAttributeMaxDynamicSharedMemorySize, LDS_BYTES);
        (void)hipOccupancyMaxActiveBlocksPerMultiprocessor(&per_cu, (const void*)mk_fwd, NTHREADS, LDS_BYTES);
        if (per_cu < 1) { fprintf(stderr, "kernel_launch: occupancy query says %d blocks/CU\n", per_cu); per_cu = 1; }
        (void)hipGetLastError();
        grid = cus * 1;
        fprintf(stderr, "kernel_launch: cus %d per_cu %d grid %d\n", cus, per_cu, grid);
    }
    if (grid < 0) return;
    (void)hipMemsetAsync((char*)d_ws + WS_CTL, 0, 65536, stream);
    Args a{};
    for (int i = 0; i < 19; ++i) a.in[i] = (const float*)d_in[i];
    a.out = (float*)d_out; a.ws = (unsigned char*)d_ws;
#if N_LAUNCH_MODE == 1
    a.ph_lo = 0; a.ph_hi = NPHASES; a.coop = 1;
    void* args[] = {&a};
    hipError_t e = hipLaunchCooperativeKernel((const void*)mk_fwd, dim3(grid), dim3(NTHREADS), args, LDS_BYTES, stream);
    if (e != hipSuccess) fprintf(stderr, "cooperative launch failed: %s (grid %d)\n", hipGetErrorString(e), grid);
#else
    for (int p = 0; p < NPHASES; ++p) {
        a.ph_lo = p; a.ph_hi = p + 1; a.coop = 0;
        hipLaunchKernelGGL(mk_fwd, dim3(grid), dim3(NTHREADS), LDS_BYTES, stream, a);
    }
#endif
}
```

```cpp
#include <hip/hip_runtime.h>
#include <hip/hip_cooperative_groups.h>
#include <cstdio>
#include <cstdint>
namespace cg = cooperative_groups;

#ifndef NAIVE_GEMM
#define NAIVE_GEMM 0
#endif
#ifndef N_LAUNCH_MODE
#define N_LAUNCH_MODE 1
#endif

#define LAS __attribute__((address_space(3)))
typedef unsigned short bf16_t;
typedef short bf16x8 __attribute__((ext_vector_type(8)));
typedef float f32x4 __attribute__((ext_vector_type(4)));
typedef float f32x2 __attribute__((ext_vector_type(2)));
typedef unsigned u32x4 __attribute__((ext_vector_type(4)));
typedef unsigned u32x2 __attribute__((ext_vector_type(2)));

constexpr int T_ = 65536, DM = 1024, SEQ = 2048, NBATCH = 32;
constexpr int PW = 4864;
constexpr int NE = 32, DE = 512;
constexpr int CAP = 131072;
constexpr float DN_ALPHA = 1.189207115002721f;
constexpr float LN_EPS = 1e-5f, RMS_EPS = 1e-6f;
constexpr int NWAVES = 8, NTHREADS = 512;

constexpr size_t MiB = 1u << 20;
constexpr size_t WS_CTL = 0;
constexpr size_t WS_LB = 1 * MiB;
constexpr size_t WS_WIN = 2 * MiB;
constexpr size_t WS_WA = 12 * MiB;
constexpr size_t WS_WB = 13 * MiB;
constexpr size_t WS_WO = 14 * MiB;
constexpr size_t WS_WGU = 16 * MiB;
constexpr size_t WS_WD = 80 * MiB;
constexpr size_t WS_SLOT = 112 * MiB;
constexpr size_t WS_ASGW = 128 * MiB;
constexpr size_t WS_RA = 132 * MiB;
constexpr size_t WS_RB = 260 * MiB;
constexpr size_t WS_RC = 516 * MiB;
constexpr size_t WS_RD = 612 * MiB;
constexpr size_t WS_RE = 868 * MiB;
constexpr size_t WS_RF = 932 * MiB;
constexpr size_t WS_END = 996 * MiB;
constexpr int CW_CNT = 64;
constexpr int CW_ATTQ = 128;

constexpr int RING_BYTES = 131072;
constexpr int MISC_OFF = RING_BYTES;
constexpr int LDS_BYTES = 147456;

__device__ __forceinline__ float bf2f(bf16_t v) { return __uint_as_float((unsigned)v << 16); }
__device__ __forceinline__ unsigned f2bf(float f) { unsigned u = __float_as_uint(f); return (u + 0x7fffu + ((u >> 16) & 1u)) >> 16; }
__device__ __forceinline__ unsigned pk2(float lo, float hi) { return f2bf(lo) | (f2bf(hi) << 16); }
__device__ __forceinline__ float bflo(unsigned w) { return __uint_as_float(w << 16); }
__device__ __forceinline__ float bfhi(unsigned w) { return __uint_as_float(w & 0xffff0000u); }
__device__ __forceinline__ float sigm(float x) { return 1.f / (1.f + __expf(-x)); }
__device__ __forceinline__ float silu(float x) { return x / (1.f + __expf(-x)); }
__device__ __forceinline__ float wave_sum(float v) {
#pragma unroll
    for (int o = 1; o < 64; o <<= 1) v += __shfl_xor(v, o);
    return v;
}
__device__ __forceinline__ float wave_max(float v) {
#pragma unroll
    for (int o = 1; o < 64; o <<= 1) v = fmaxf(v, __shfl_xor(v, o));
    return v;
}
#define LDS_WAIT() asm volatile("s_waitcnt lgkmcnt(0)" ::: "memory")

constexpr int BM = 256, BK = 64, HALF = 128, HTB = HALF * BK * 2, NXCD = 8, WGM = 8;
__host__ __device__ __forceinline__ int lds_byte(int r, int c) { const int st = (r >> 4) * 2 + (c >> 5), rr = r & 15, cc = c & 31, ob = rr * 64 + cc * 2; return st * 1024 + (ob ^ (((ob >> 9) & 1) << 5)); }
__host__ __device__ __forceinline__ void stage_rc(int b, int& R, int& C) { const int st = b / 1024, sb = b % 1024, swz = sb ^ (((sb >> 9) & 1) << 5); R = (st >> 1) * 16 + swz / 64; C = (st & 1) * 32 + (swz % 64) / 2; }
__host__ __device__ __forceinline__ int perm32(int rho) { const int n = rho >> 4, i = rho & 15; return 8 * (i >> 2) + 4 * n + (i & 3); }

struct Unit { int pm, pn, e, mt; };

struct DenseProb {
    const char* Abase; const char* Bt; int K; int nM, nN, nwg, G, c;
    __device__ __forceinline__ void init(const void* A, const void* B, int M, int N, int K_, int G_, int c_) { Abase = (const char*)A; Bt = (const char*)B; K = K_; nM = M / BM; nN = N / BM; nwg = nM * nN; G = G_; c = c_; }
    __device__ __forceinline__ bool next(int i, Unit& u) const {
        const long L = (long)i * G + c; if (L >= nwg) return false;
        int wgid = (int)L; { const int q = nwg / NXCD, r = nwg % NXCD, xcd = wgid % NXCD, off = wgid / NXCD; wgid = (xcd < r ? xcd * (q + 1) : r * (q + 1) + (xcd - r) * q) + off; }
        const int nig = WGM * nN, gid = wgid / nig, fm = gid * WGM, gsz = (nM - fm) < WGM ? (nM - fm) : WGM;
        u.pm = fm + ((wgid % nig) % gsz); u.pn = (wgid % nig) / gsz; u.e = 0; u.mt = 0; return true;
    }
    __device__ __forceinline__ unsigned a_rowoff(const Unit& u, int r) const { return (unsigned)(u.pm * BM + r) * (unsigned)K * 2u; }
    __device__ __forceinline__ const char* b_base(const Unit& u) const { return Bt + (size_t)u.pn * BM * K * 2; }
};

template <bool GATHER> struct MoeProb {
    const char* Abase; const char* Bt; int K; int G, c; const LAS int* tp; const LAS int* cn; const int* slot; size_t estride;
    __device__ __forceinline__ bool next(int i, Unit& u) const {
        const int L = i * G + c; const int total = tp[32] * 4; if (L >= total) return false;
        const int tau = L >> 2; int e = 0;
        for (int j = 1; j < 32; ++j) e = (tau >= tp[j]) ? j : e;
        u.pm = tau; u.pn = L & 3; u.e = __builtin_amdgcn_readfirstlane(e); u.mt = __builtin_amdgcn_readfirstlane(tau - tp[e]); return true;
    }
    __device__ __forceinline__ unsigned a_rowoff(const Unit& u, int r) const {
        if (GATHER) { const int s = u.mt * BM + r; const int asg = (s < cn[u.e]) ? slot[(size_t)u.e * CAP + s] : 0; return (unsigned)(asg >> 1) * (unsigned)K * 2u; }
        else return (unsigned)(u.pm * BM + r) * (unsigned)K * 2u;
    }
    __device__ __forceinline__ const char* b_base(const Unit& u) const { return Bt + (size_t)u.e * estride + (size_t)u.pn * BM * K * 2; }
};

struct EpiProj {
    static constexpr bool PERM = true;
    bf16_t* HB; bf16_t* AB; bf16_t* GB; const float* lb;
    template <int MODE> __device__ __forceinline__ void run(const f32x4 (&acc)[2][4][2], bf16_t* base, int ld, int row0, int col0, int lbcol) const {
#pragma unroll
        for (int bj = 0; bj < 2; ++bj) {
            float l8[8];
            if (MODE == 2) {
#pragma unroll
                for (int j = 0; j < 8; ++j) l8[j] = lb[lbcol + bj * HALF + j];
            }
#pragma unroll
            for (int m = 0; m < 4; ++m) {
                float v[8];
#pragma unroll
                for (int j = 0; j < 4; ++j) { v[j] = acc[bj][m][0][j]; v[4 + j] = acc[bj][m][1][j]; }
#pragma unroll
                for (int j = 0; j < 8; ++j) {
                    if (MODE == 1) v[j] = silu(v[j]);
                    else if (MODE == 2) v[j] = __logf(l8[j] + (1.f - l8[j]) * sigm(v[j]));
                    else if (MODE == 3) v[j] = v[j] * 0.125f;
                    else if (MODE == 4) v[j] = sigm(v[j]);
                }
                u32x4 w; w.x = pk2(v[0], v[1]); w.y = pk2(v[2], v[3]); w.z = pk2(v[4], v[5]); w.w = pk2(v[6], v[7]);
                *(u32x4*)(base + (size_t)(row0 + m * 16) * ld + col0 + bj * HALF) = w;
            }
        }
    }
    __device__ __forceinline__ void operator()(const f32x4 (&acc)[2][4][2], int ai, const Unit& u, int wr, int wc, int fr, int fq) const {
        const int pn = u.pn, row0 = u.pm * BM + ai * HALF + wr * 64 + fr, colg = pn * BM + wc * 32 + 8 * fq;
        if (pn < 2) run<1>(acc, HB, 2048, row0, colg, 0);
        else if (pn < 4) run<2>(acc, HB, 2048, row0, colg, colg - 512);
        else if (pn < 6) run<0>(acc, HB, 2048, row0, colg, 0);
        else if (pn < 8) run<1>(acc, HB, 2048, row0, colg, 0);
        else if (pn < 10) run<3>(acc, AB, 768, row0, colg - 2048, 0);
        else if (pn < 11) run<0>(acc, AB, 768, row0, colg - 2048, 0);
        else run<4>(acc, GB, 2048, row0, colg - 2816, 0);
    }
};
template <int PASS> struct EpiGate {
    static constexpr bool PERM = true;
    bf16_t* MG; const bf16_t* GB;
    __device__ __forceinline__ void operator()(const f32x4 (&acc)[2][4][2], int ai, const Unit& u, int wr, int wc, int fr, int fq) const {
        const int row0 = u.pm * BM + ai * HALF + wr * 64 + fr, col0 = u.pn * BM + wc * 32 + 8 * fq;
#pragma unroll
        for (int m = 0; m < 4; ++m) {
#pragma unroll
            for (int bj = 0; bj < 2; ++bj) {
                const size_t row = (size_t)(row0 + m * 16); const int col = col0 + bj * HALF;
                const u32x4 g = *(const u32x4*)(GB + row * 2048 + PASS * 1024 + col);
                float v[8];
#pragma unroll
                for (int j = 0; j < 4; ++j) { v[j] = acc[bj][m][0][j]; v[4 + j] = acc[bj][m][1][j]; }
                v[0] *= bflo(g.x); v[1] *= bfhi(g.x); v[2] *= bflo(g.y); v[3] *= bfhi(g.y); v[4] *= bflo(g.z); v[5] *= bfhi(g.z); v[6] *= bflo(g.w); v[7] *= bfhi(g.w);
                if (PASS == 1) { const u32x4 p = *(const u32x4*)(MG + row * 1024 + col);
                    v[0] += bflo(p.x); v[1] += bfhi(p.x); v[2] += bflo(p.y); v[3] += bfhi(p.y); v[4] += bflo(p.z); v[5] += bfhi(p.z); v[6] += bflo(p.w); v[7] += bfhi(p.w); }
                u32x4 w; w.x = pk2(v[0], v[1]); w.y = pk2(v[2], v[3]); w.z = pk2(v[4], v[5]); w.w = pk2(v[6], v[7]);
                *(u32x4*)(MG + row * 1024 + col) = w;
            }
            asm volatile("" ::: "memory");
        }
    }
};
struct EpiPre1 {
    static constexpr bool PERM = false;
    const float* x; float* out;
    __device__ __forceinline__ void operator()(const f32x4 (&acc)[2][4][2], int ai, const Unit& u, int wr, int wc, int fr, int fq) const {
        const unsigned base = ((unsigned)(u.pm * BM + ai * HALF + wr * 64 + fr) * DM + (unsigned)(u.pn * BM + wc * 32 + 4 * fq)) * 4u;
#pragma unroll
        for (int m = 0; m < 4; ++m) {
#pragma unroll
            for (int bj = 0; bj < 2; ++bj)
#pragma unroll
                for (int n = 0; n < 2; ++n) {
                    const unsigned off = base + (unsigned)(((m * 16) * DM + bj * HALF + n * 16) * 4);
                    const f32x4 xv = *(const f32x4*)((const char*)x + off);
                    *(f32x4*)((char*)out + off) = acc[bj][m][n] + xv * DN_ALPHA;
                }
            asm volatile("" ::: "memory");
        }
    }
};
struct EpiSwiGLU {
    static constexpr bool PERM = true;
    bf16_t* H;
    __device__ __forceinline__ void operator()(const f32x4 (&acc)[2][4][2], int ai, const Unit& u, int wr, int wc, int fr, int fq) const {
        const int row0 = u.pm * BM + ai * HALF + wr * 64 + fr, col0 = u.pn * 128 + wc * 16 + 4 * fq;
#pragma unroll
        for (int m = 0; m < 4; ++m)
#pragma unroll
            for (int bj = 0; bj < 2; ++bj) {
                const f32x4 g = acc[bj][m][0], up = acc[bj][m][1];
                u32x2 w; w.x = pk2(silu(g[0]) * up[0], silu(g[1]) * up[1]); w.y = pk2(silu(g[2]) * up[2], silu(g[3]) * up[3]);
                *(u32x2*)(H + (size_t)(row0 + m * 16) * DE + col0 + bj * 64) = w;
            }
    }
};
struct EpiDown {
    static constexpr bool PERM = true;
    bf16_t* Y; const int* slot; const float* asgw; const LAS int* cn;
    __device__ __forceinline__ void operator()(const f32x4 (&acc)[2][4][2], int ai, const Unit& u, int wr, int wc, int fr, int fq) const {
        const int col0 = u.pn * BM + wc * 32 + 8 * fq; const int cnt = cn[u.e];
#pragma unroll
        for (int m = 0; m < 4; ++m) {
            const int s = u.mt * BM + ai * HALF + wr * 64 + m * 16 + fr;
            if (s < cnt) {
                const int asg = slot[(size_t)u.e * CAP + s]; const float w = asgw[asg];
#pragma unroll
                for (int bj = 0; bj < 2; ++bj) {
                    const f32x4 a = acc[bj][m][0] * w, b = acc[bj][m][1] * w;
                    u32x4 o; o.x = pk2(a[0], a[1]); o.y = pk2(a[2], a[3]); o.z = pk2(b[0], b[1]); o.w = pk2(b[2], b[3]);
                    *(u32x4*)(Y + (size_t)asg * DM + col0 + bj * HALF) = o;
                }
            }
            asm volatile("" ::: "memory");
        }
    }
};

template <class Prob, class Epi>
__device__ __forceinline__ void gemm_phase_naive(const Prob& P, const Epi& E) {
    const int tid = threadIdx.x, wid = tid >> 6, lane = tid & 63, wr = wid >> 2, wc = wid & 3, fr = lane & 15, fq = lane >> 4;
    const int K = P.K;
    Unit u;
    for (int i = 0; P.next(i, u); ++i) {
        const char* bB = P.b_base(u);
        for (int ai = 0; ai < 2; ++ai) {
            f32x4 acc[2][4][2];
#pragma unroll
            for (int b = 0; b < 2; ++b)
#pragma unroll
                for (int m = 0; m < 4; ++m)
#pragma unroll
                    for (int n = 0; n < 2; ++n) acc[b][m][n] = (f32x4){0.f, 0.f, 0.f, 0.f};
            unsigned ro[4];
#pragma unroll
            for (int m = 0; m < 4; ++m) ro[m] = P.a_rowoff(u, ai * HALF + wr * 64 + m * 16 + fr);
#pragma unroll 1
            for (int k = 0; k < K; k += 4) {
                u32x2 ap[4];
#pragma unroll
                for (int m = 0; m < 4; ++m) ap[m] = *(const u32x2*)(P.Abase + (ro[m] + (unsigned)k * 2u));
#pragma unroll
                for (int bj = 0; bj < 2; ++bj)
#pragma unroll
                    for (int n = 0; n < 2; ++n)
#pragma unroll
                        for (int j = 0; j < 4; ++j) {
                            const unsigned col = (unsigned)(bj * HALF + wc * 32 + (Epi::PERM ? (8 * fq + 4 * n + j) : (16 * n + 4 * fq + j)));
                            const u32x2 b = *(const u32x2*)(bB + (col * (unsigned)K + (unsigned)k) * 2u);
                            const float b0 = bflo(b.x), b1 = bfhi(b.x), b2 = bflo(b.y), b3 = bfhi(b.y);
#pragma unroll
                            for (int m = 0; m < 4; ++m) {
                                const u32x2 a = ap[m];
                                float s = acc[bj][m][n][j];
                                s = fmaf(bflo(a.x), b0, s); s = fmaf(bfhi(a.x), b1, s); s = fmaf(bflo(a.y), b2, s); s = fmaf(bfhi(a.y), b3, s);
                                acc[bj][m][n][j] = s;
                            }
                        }
                asm volatile("" ::: "memory");
            }
            E(acc, ai, u, wr, wc, fr, fq);
        }
    }
}

template <class Prob, class Epi, bool ALIGN_EPI, bool SP2>
__device__ __forceinline__ void gemm_phase_mfma(LAS unsigned char* lds, const Prob& P, const Epi& E) {
    const int tid = threadIdx.x, wid = __builtin_amdgcn_readfirstlane(tid >> 6), lane = tid & 63, wr = wid >> 2, wc = wid & 3, fr = lane & 15, fq = lane >> 4;
    const int K = P.K, nt = K / BK;
    int Ra[2]; unsigned Ca[2], voffB[2];
#pragma unroll
    for (int i = 0; i < 2; ++i) { int R, C; stage_rc(tid * 16 + i * 8192, R, C); const int Rb = Epi::PERM ? ((R & ~31) + perm32(R & 31)) : R;
        Ra[i] = R; Ca[i] = (unsigned)C * 2u; voffB[i] = (unsigned)(Rb * K + C) * 2u; }
    const size_t kstep = (size_t)(BK * 2);
    const size_t hstep = (size_t)HALF * K * 2;
    const unsigned ldsw = (unsigned)wid * 1024u;
    const int aoff = lds_byte(wr * 64 + fr, fq * 8), boff = lds_byte(wc * 32 + fr, fq * 8);
#define PG8_SA(b, h) (((b) * 2 + (h)) * HTB)
#define PG8_SB(b, h) ((4 + (b) * 2 + (h)) * HTB)
#define PG8_STAGEB(bufoff, gbase) do { _Pragma("unroll") for (int _i = 0; _i < 2; ++_i) \
        __builtin_amdgcn_global_load_lds((const unsigned*)((const char*)(gbase) + voffB[_i]), (LAS unsigned*)(lds + (bufoff) + ldsw + _i * 8192), 16, 0, 0); } while (0)
#define PG8_STAGEA(bufoff, gbase, v0, v1) do { \
        __builtin_amdgcn_global_load_lds((const unsigned*)((const char*)(gbase) + (v0)), (LAS unsigned*)(lds + (bufoff) + ldsw), 16, 0, 0); \
        __builtin_amdgcn_global_load_lds((const unsigned*)((const char*)(gbase) + (v1)), (LAS unsigned*)(lds + (bufoff) + ldsw + 8192), 16, 0, 0); } while (0)
#define PG8_LDA(dst, b, h) do { _Pragma("unroll") for (int m = 0; m < 4; ++m) _Pragma("unroll") for (int k = 0; k < 2; ++k) dst[m][k] = *(const LAS bf16x8*)(lds + PG8_SA(b, h) + aoff + m * 2048 + k * 1024); } while (0)
#define PG8_LDB(dst, b, h) do { _Pragma("unroll") for (int n = 0; n < 2; ++n) _Pragma("unroll") for (int k = 0; k < 2; ++k) dst[n][k] = *(const LAS bf16x8*)(lds + PG8_SB(b, h) + boff + n * 2048 + k * 1024); } while (0)
#define PG8_MMA(ai, bj, At, Bt) do { __builtin_amdgcn_s_setprio(1); _Pragma("unroll") for (int m = 0; m < 4; ++m) _Pragma("unroll") for (int n = 0; n < 2; ++n) _Pragma("unroll") for (int k = 0; k < 2; ++k) \
        acc[ai][bj][m][n] = __builtin_amdgcn_mfma_f32_16x16x32_bf16(Bt[n][k], At[m][k], acc[ai][bj][m][n], 0, 0, 0); __builtin_amdgcn_s_setprio(0); } while (0)
#define PG8_WAIT_V(n) asm volatile("s_waitcnt vmcnt(" #n ")" ::: "memory")
#define PG8_WAIT_L(n) asm volatile("s_waitcnt lgkmcnt(" #n ")" ::: "memory")
#define PG8_BAR __builtin_amdgcn_s_barrier()
#define PG8_SCHED __builtin_amdgcn_sched_barrier(0)
    Unit cur, nxt; int ui = 0;
    if (!P.next(0, cur)) return;
    f32x4 acc[2][2][4][2];
#pragma unroll
    for (int a = 0; a < 2; ++a)
#pragma unroll
        for (int b = 0; b < 2; ++b)
#pragma unroll
            for (int m = 0; m < 4; ++m)
#pragma unroll
                for (int n = 0; n < 2; ++n) acc[a][b][m][n] = (f32x4){0.f, 0.f, 0.f, 0.f};
    bf16x8 At[4][2], B0[2][2], B1[2][2];
    const char* const cA = P.Abase;
    const char* cB = P.b_base(cur);
    unsigned va0, va1, va2, va3;
    va0 = P.a_rowoff(cur, Ra[0]) + Ca[0]; va1 = P.a_rowoff(cur, Ra[1]) + Ca[1]; va2 = P.a_rowoff(cur, HALF + Ra[0]) + Ca[0]; va3 = P.a_rowoff(cur, HALF + Ra[1]) + Ca[1];
    if constexpr (SP2) {
        PG8_STAGEB(PG8_SB(0, 0), cB); PG8_STAGEB(PG8_SB(0, 1), cB + hstep); PG8_STAGEA(PG8_SA(0, 0), cA, va0, va1); PG8_STAGEA(PG8_SA(0, 1), cA, va2, va3);
        if (wr == 1) PG8_BAR;
        PG8_WAIT_V(2); PG8_BAR;
        PG8_STAGEB(PG8_SB(1, 0), cB + kstep); PG8_STAGEA(PG8_SA(1, 0), cA + kstep, va0, va1); PG8_STAGEB(PG8_SB(1, 1), cB + hstep + kstep);
        PG8_WAIT_V(6); PG8_BAR;
    } else {
        PG8_STAGEB(PG8_SB(0, 0), cB); PG8_STAGEA(PG8_SA(0, 0), cA, va0, va1); PG8_STAGEB(PG8_SB(0, 1), cB + hstep); PG8_STAGEA(PG8_SA(0, 1), cA, va2, va3);
        if (wr == 1) PG8_BAR;
        PG8_WAIT_V(4); PG8_BAR;
        PG8_STAGEB(PG8_SB(1, 0), cB + kstep); PG8_STAGEA(PG8_SA(1, 0), cA + kstep, va0, va1); PG8_STAGEB(PG8_SB(1, 1), cB + hstep + kstep);
        PG8_WAIT_V(6); PG8_BAR;
    }
    for (;;) {
        const bool has_next = P.next(ui + 1, nxt);
        unsigned vn0 = va0, vn1 = va1, vn2 = va2, vn3 = va3; const char* nB = cB;
        if (has_next) { nB = P.b_base(nxt);
            vn0 = P.a_rowoff(nxt, Ra[0]) + Ca[0]; vn1 = P.a_rowoff(nxt, Ra[1]) + Ca[1]; vn2 = P.a_rowoff(nxt, HALF + Ra[0]) + Ca[0]; vn3 = P.a_rowoff(nxt, HALF + Ra[1]) + Ca[1]; }
        for (int t = 0; t < nt; t += 2) {
            const bool last = (t == nt - 2);
            const char* a1 = cA + (size_t)(t + 1) * kstep;
            const char* a2 = last ? cA : cA + (size_t)(t + 2) * kstep; const char* b2 = last ? nB : cB + (size_t)(t + 2) * kstep;
            const char* a3 = a2 + kstep; const char* b3 = b2 + kstep;
            const unsigned w0 = last ? vn0 : va0, w1 = last ? vn1 : va1, w2 = last ? vn2 : va2, w3 = last ? vn3 : va3;
            if constexpr (SP2) {
            PG8_LDB(B0, 0, 0); PG8_LDB(B1, 0, 1); PG8_SCHED; PG8_LDA(At, 0, 0); PG8_STAGEA(PG8_SA(1, 1), a1, va2, va3);
            PG8_WAIT_V(8); PG8_WAIT_L(0); PG8_BAR; PG8_MMA(0, 0, At, B0); PG8_MMA(0, 1, At, B1); PG8_BAR; PG8_SCHED;
            PG8_LDA(At, 0, 1); PG8_STAGEB(PG8_SB(0, 0), b2); PG8_STAGEB(PG8_SB(0, 1), b2 + hstep); PG8_STAGEA(PG8_SA(0, 0), a2, w0, w1);
            PG8_WAIT_V(8); PG8_WAIT_L(0); PG8_BAR; PG8_MMA(1, 0, At, B0); PG8_MMA(1, 1, At, B1); PG8_BAR; PG8_SCHED;
            PG8_LDB(B0, 1, 0); PG8_LDB(B1, 1, 1); PG8_SCHED; PG8_LDA(At, 1, 0); PG8_STAGEA(PG8_SA(0, 1), a2, w2, w3);
            PG8_WAIT_V(8); PG8_WAIT_L(0); PG8_BAR; PG8_MMA(0, 0, At, B0); PG8_MMA(0, 1, At, B1); PG8_BAR; PG8_SCHED;
            PG8_LDA(At, 1, 1); PG8_STAGEB(PG8_SB(1, 0), b3); PG8_STAGEB(PG8_SB(1, 1), b3 + hstep); PG8_STAGEA(PG8_SA(1, 0), a3, w0, w1);
            PG8_WAIT_V(8); PG8_WAIT_L(0); PG8_BAR; PG8_MMA(1, 0, At, B0); PG8_MMA(1, 1, At, B1); PG8_BAR; PG8_SCHED;
            } else {
            PG8_LDB(B0, 0, 0); PG8_SCHED; PG8_LDA(At, 0, 0); PG8_STAGEA(PG8_SA(1, 1), a1, va2, va3);
            PG8_WAIT_L(8); PG8_BAR; PG8_WAIT_L(0); PG8_MMA(0, 0, At, B0); PG8_BAR; PG8_SCHED;
            PG8_LDB(B1, 0, 1); PG8_STAGEB(PG8_SB(0, 0), b2);
            PG8_BAR; PG8_WAIT_L(0); PG8_MMA(0, 1, At, B1); PG8_BAR;
            PG8_LDA(At, 0, 1); PG8_STAGEA(PG8_SA(0, 0), a2, w0, w1);
            PG8_BAR; PG8_WAIT_L(0); PG8_MMA(1, 0, At, B0); PG8_BAR; PG8_SCHED;
            PG8_STAGEB(PG8_SB(0, 1), b2 + hstep);
            PG8_WAIT_V(6); PG8_BAR; PG8_MMA(1, 1, At, B1); PG8_BAR;
            PG8_LDB(B0, 1, 0); PG8_SCHED; PG8_LDA(At, 1, 0); PG8_STAGEA(PG8_SA(0, 1), a2, w2, w3);
            PG8_WAIT_L(8); PG8_BAR; PG8_WAIT_L(0); PG8_MMA(0, 0, At, B0); PG8_BAR; PG8_SCHED;
            PG8_LDB(B1, 1, 1); PG8_STAGEB(PG8_SB(1, 0), b3);
            PG8_BAR; PG8_WAIT_L(0); PG8_MMA(0, 1, At, B1); PG8_BAR;
            PG8_LDA(At, 1, 1); PG8_STAGEA(PG8_SA(1, 0), a3, w0, w1);
            PG8_BAR; PG8_WAIT_L(0); PG8_MMA(1, 0, At, B0); PG8_BAR; PG8_SCHED;
            PG8_STAGEB(PG8_SB(1, 1), b3 + hstep);
            PG8_WAIT_V(6); PG8_BAR; PG8_MMA(1, 1, At, B1); PG8_BAR;
            }
        }
        if constexpr (ALIGN_EPI) { if (wr == 0) PG8_BAR; }
        E(acc[0], 0, cur, wr, wc, fr, fq); E(acc[1], 1, cur, wr, wc, fr, fq);
        if (!has_next) break;
#pragma unroll
        for (int a = 0; a < 2; ++a)
#pragma unroll
            for (int b = 0; b < 2; ++b)
#pragma unroll
                for (int m = 0; m < 4; ++m)
#pragma unroll
                    for (int n = 0; n < 2; ++n) acc[a][b][m][n] = (f32x4){0.f, 0.f, 0.f, 0.f};
        cur = nxt; cB = nB; va0 = vn0; va1 = vn1; va2 = vn2; va3 = vn3; ++ui;
        if constexpr (ALIGN_EPI) { if (wr == 1) PG8_BAR; }
    }
    PG8_WAIT_V(0);
    if constexpr (!ALIGN_EPI) { if (wr == 0) PG8_BAR; }
    PG8_BAR;
#undef PG8_SA
#undef PG8_SB
#undef PG8_STAGEA
#undef PG8_STAGEB
#undef PG8_LDA
#undef PG8_LDB
#undef PG8_MMA
#undef PG8_WAIT_V
#undef PG8_WAIT_L
#undef PG8_BAR
#undef PG8_SCHED
}

template <class Prob, class Epi>
__device__ __forceinline__ void gemm_phase(LAS unsigned char* lds, const Prob& P, const Epi& E) {
#if NAIVE_GEMM
    gemm_phase_naive<Prob, Epi>(P, E);
#else
    gemm_phase_mfma<Prob, Epi, true, true>(lds, P, E);
#endif
}

struct Args {
    const float* in[19]; float* out; unsigned char* ws; int ph_lo, ph_hi, coop, pad;
};

template <int MAPMODE  >
__device__ __forceinline__ void p0_transpose_item(const float* W, int K, int N, bf16_t* WT, LAS float* scr, int item, int lane) {
    const int nblk = N / 32, kb = item / nblk, nb = item % nblk, k0 = 64 * kb, n0 = 32 * nb;
#pragma unroll 8
    for (int i = 0; i < 32; ++i) { const int kk = 2 * i + (lane >> 5); scr[kk * 33 + (lane & 31)] = W[(size_t)(k0 + kk) * N + n0 + (lane & 31)]; }
    LDS_WAIT();
    const int c = lane & 7;
#pragma unroll
    for (int j = 0; j < 4; ++j) { const int n = (lane >> 3) + 8 * j; const LAS float* s = scr + (8 * c) * 33 + n;
        u32x4 o; o.x = pk2(s[0 * 33], s[1 * 33]); o.y = pk2(s[2 * 33], s[3 * 33]); o.z = pk2(s[4 * 33], s[5 * 33]); o.w = pk2(s[6 * 33], s[7 * 33]);
        const int ng = n0 + n; const int row = (MAPMODE == 0) ? ng : ((ng >> 2) * 8 + (MAPMODE == 2 ? 4 : 0) + (ng & 3));
        *(u32x4*)(WT + (size_t)row * K + k0 + 8 * c) = o; }
    LDS_WAIT();
}
__device__ __forceinline__ void p0_prologue(const Args& a, LAS unsigned char* lds) {
    const int tid = threadIdx.x, lane = tid & 63, wave = tid >> 6;
    unsigned char* ws = a.ws;
    LAS float* scr = (LAS float*)(lds + wave * 16384);
    const int gw = blockIdx.x * NWAVES + wave, NGW = gridDim.x * NWAVES;
    constexpr int I_IN = (DM / 64) * (PW / 32), I_A = (512 / 64) * (DM / 32), I_O = (DM / 64) * (DM / 32), I_G = (DM / 64) * (DE / 32), I_D = (DE / 64) * (DM / 32);
    constexpr int NITEMS = I_IN + 2 * I_A + I_O + NE * (2 * I_G + I_D);
    for (int it = gw; it < NITEMS; it += NGW) {
        int r = it;
        if (r < I_IN) { p0_transpose_item<0>(a.in[2], DM, PW, (bf16_t*)(ws + WS_WIN), scr, r, lane); continue; } r -= I_IN;
        if (r < I_A) { p0_transpose_item<0>(a.in[5], 512, DM, (bf16_t*)(ws + WS_WA), scr, r, lane); continue; } r -= I_A;
        if (r < I_A) { p0_transpose_item<0>(a.in[6], 512, DM, (bf16_t*)(ws + WS_WB), scr, r, lane); continue; } r -= I_A;
        if (r < I_O) { p0_transpose_item<0>(a.in[7], DM, DM, (bf16_t*)(ws + WS_WO), scr, r, lane); continue; } r -= I_O;
        const int e = r / (2 * I_G + I_D); r -= e * (2 * I_G + I_D);
        if (r < I_G) { p0_transpose_item<1>(a.in[14] + (size_t)e * DM * DE, DM, DE, (bf16_t*)(ws + WS_WGU) + (size_t)e * DM * DM, scr, r, lane); continue; } r -= I_G;
        if (r < I_G) { p0_transpose_item<2>(a.in[15] + (size_t)e * DM * DE, DM, DE, (bf16_t*)(ws + WS_WGU) + (size_t)e * DM * DM, scr, r, lane); continue; } r -= I_G;
        p0_transpose_item<0>(a.in[16] + (size_t)e * DE * DM, DE, DM, (bf16_t*)(ws + WS_WD) + (size_t)e * DM * DE, scr, r, lane);
    }
    {
        const f32x4* x4 = (const f32x4*)a.in[0]; u32x4* o = (u32x4*)(ws + WS_RA);
        const size_t n8 = (size_t)T_ * DM / 8, stride = (size_t)gridDim.x * NTHREADS;
        for (size_t i = (size_t)blockIdx.x * NTHREADS + tid; i < n8; i += stride) {
            const f32x4 p = x4[2 * i], q = x4[2 * i + 1];
            u32x4 w; w.x = pk2(p[0], p[1]); w.y = pk2(p[2], p[3]); w.z = pk2(q[0], q[1]); w.w = pk2(q[2], q[3]);
            o[i] = w;
        }
    }
    if (blockIdx.x == 0) {
        float* lb = (float*)(ws + WS_LB); const float* lg = a.in[1];
        lb[tid] = 1.f / (1.f + __expf(lg[512 + tid] - lg[tid]));
        unsigned* ctl = (unsigned*)(ws + WS_CTL);
        if (tid < 32) ctl[CW_CNT + tid] = 0u;
        if (tid == 32) ctl[CW_ATTQ] = 0u;
    }
}

__device__ __forceinline__ void hgrn_naive(LAS unsigned char* lds, const bf16_t* HB, const float* normw, bf16_t* OH, int item) {
    const int tid = threadIdx.x, lane = tid & 63, wave = tid >> 6, v = tid & 127, kg = tid >> 7;
    const int b = item >> 2, h = item & 3;
    LAS float* sq = (LAS float*)lds;
    LAS float* sf = sq + 64 * 128;
    LAS float* sv = sf + 64 * 128;
    LAS float* so = sv + 64 * 128;
    LAS float* sp = so + 64 * 128;
    float S[32];
#pragma unroll
    for (int i = 0; i < 32; ++i) S[i] = 0.f;
    for (int c = 0; c < 32; ++c) {
        const size_t row0 = (size_t)b * SEQ + c * 64;
        for (int i = 0; i < 16; ++i) { const int idx = tid + 512 * i, r = idx >> 7, col = idx & 127; const bf16_t* p = HB + (row0 + r) * 2048 + h * 128 + col;
            sq[idx] = bf2f(p[0]); sf[idx] = __expf(bf2f(p[512])); sv[idx] = bf2f(p[1024]); }
        __syncthreads();
        for (int t = 0; t < 64; ++t) {
            const float vt = sv[t * 128 + v]; float part = 0.f;
#pragma unroll
            for (int i = 0; i < 32; ++i) { const float f = sf[t * 128 + kg * 32 + i]; S[i] = f * S[i] + (1.f - f) * vt; part += sq[t * 128 + kg * 32 + i] * S[i]; }
            sp[((t & 1) * 4 + kg) * 128 + v] = part;
            __syncthreads();
            if (kg == 0) { const LAS float* q = sp + (t & 1) * 4 * 128 + v; so[t * 128 + v] = (q[0] + q[128]) + (q[256] + q[384]); }
        }
        __syncthreads();
        for (int tt = 0; tt < 8; ++tt) { const int t = wave * 8 + tt; const float o0 = so[t * 128 + lane], o1 = so[t * 128 + 64 + lane];
            const float ss = wave_sum(o0 * o0 + o1 * o1); const float rstd = rsqrtf(ss * (1.f / 128.f) + RMS_EPS);
            const bf16_t* g = HB + (row0 + t) * 2048 + 1536 + h * 128; bf16_t* o = OH + (row0 + t) * 512 + h * 128;
            o[lane] = (bf16_t)f2bf(o0 * rstd * normw[lane] * bf2f(g[lane])); o[64 + lane] = (bf16_t)f2bf(o1 * rstd * normw[64 + lane] * bf2f(g[64 + lane])); }
        __syncthreads();
    }
}

__device__ __forceinline__ void attn_naive(LAS unsigned char* lds, const bf16_t* AB, const float* sinks, bf16_t* OA, int item) {
    const int tid = threadIdx.x, lane = tid & 63, wave = tid >> 6;
    const int hk = item & 1, n = (item >> 1) & 15, b = item >> 5;
    LAS bf16_t* Ks = (LAS bf16_t*)lds;
    LAS bf16_t* Vs = Ks + 256 * 64;
    LAS float* qs = (LAS float*)(lds + 65536) + wave * 192;
    LAS float* ps = qs + 64;
    __syncthreads();
    for (int i = 0; i < 8; ++i) { const int ch = tid + 512 * i; const int kv = ch >> 11, rr = (ch >> 3) & 255, c8 = ch & 7; const int kp = n * 128 - 128 + rr;
        u32x4 val = (u32x4){0u, 0u, 0u, 0u};
        if (kp >= 0) val = *(const u32x4*)(AB + ((size_t)b * SEQ + kp) * 768 + 512 + kv * 128 + hk * 64 + c8 * 8);
        *(LAS u32x4*)((kv ? Vs : Ks) + rr * 64 + c8 * 8) = val; }
    __syncthreads();
    const int g = wave >> 1, head = hk * 4 + g; const float slope = exp2f(-(float)(head + 1)); const float sink = sinks[head];
    for (int ii = 0; ii < 64; ++ii) {
        const int i = (wave & 1) * 64 + ii; const size_t row = (size_t)b * SEQ + n * 128 + i;
        qs[lane] = bf2f(AB[row * 768 + head * 64 + lane]);
        LDS_WAIT();
        float s0 = 0.f, s1 = 0.f; const int j0 = i + 1 + lane, j1 = i + 65 + lane;
#pragma unroll
        for (int d8 = 0; d8 < 8; ++d8) {
            const u32x4 k0 = *(const LAS u32x4*)(Ks + j0 * 64 + d8 * 8), k1 = *(const LAS u32x4*)(Ks + j1 * 64 + d8 * 8);
            const f32x4 qa = *(const LAS f32x4*)(qs + d8 * 8), qb = *(const LAS f32x4*)(qs + d8 * 8 + 4);
            s0 += qa[0] * bflo(k0.x) + qa[1] * bfhi(k0.x) + qa[2] * bflo(k0.y) + qa[3] * bfhi(k0.y) + qb[0] * bflo(k0.z) + qb[1] * bfhi(k0.z) + qb[2] * bflo(k0.w) + qb[3] * bfhi(k0.w);
            s1 += qa[0] * bflo(k1.x) + qa[1] * bfhi(k1.x) + qa[2] * bflo(k1.y) + qa[3] * bfhi(k1.y) + qb[0] * bflo(k1.z) + qb[1] * bfhi(k1.z) + qb[2] * bflo(k1.w) + qb[3] * bfhi(k1.w);
        }
        const bool v0 = (n * 128 - 128 + j0) >= 0, v1 = (n * 128 - 128 + j1) >= 0;
        const float l0 = v0 ? s0 - slope * (float)(127 - lane) : -1e30f, l1 = v1 ? s1 - slope * (float)(63 - lane) : -1e30f;
        const float mx = fmaxf(wave_max(fmaxf(l0, l1)), sink);
        const float e0 = __expf(l0 - mx), e1 = __expf(l1 - mx);
        const float den = wave_sum(e0 + e1) + __expf(sink - mx); const float inv = 1.f / den;
        ps[lane] = e0 * inv; ps[64 + lane] = e1 * inv;
        LDS_WAIT();
        float o = 0.f;
#pragma unroll 8
        for (int jj = 0; jj < 128; ++jj) o += ps[jj] * bf2f(Vs[(i + 1 + jj) * 64 + lane]);
        OA[row * 512 + head * 64 + lane] = (bf16_t)f2bf(o);
        LDS_WAIT();
    }
}

__device__ __forceinline__ void p5_ln_router(const Args& a, LAS unsigned char* lds) {
    const int tid = threadIdx.x, lane = tid & 63, wave = tid >> 6;
    unsigned char* ws = a.ws;
    const float* pre1 = a.out; bf16_t* X1B = (bf16_t*)(ws + WS_RA);
    const float* g1 = a.in[8]; const float* b1 = a.in[9];
    const float* rgw = a.in[10]; const float* rgb = a.in[11]; const float* rew = a.in[12]; const float* reb = a.in[13];
    unsigned* ctl = (unsigned*)(ws + WS_CTL); int* slot = (int*)(ws + WS_SLOT); float* asgw = (float*)(ws + WS_ASGW);
    LAS int* hist = (LAS int*)(lds);
    LAS int* base = hist + 32;
    LAS int* se = base + 32;
    LAS int* sr = se + 128;
    LAS float* sw = (LAS float*)(sr + 128);
    f32x4 gv[4], bv[4];
#pragma unroll
    for (int j = 0; j < 4; ++j) { gv[j] = *(const f32x4*)(g1 + 4 * lane + 256 * j); bv[j] = *(const f32x4*)(b1 + 4 * lane + 256 * j); }
    for (int it = blockIdx.x; it < T_ / 64; it += gridDim.x) {
        __syncthreads();
        if (tid < 32) hist[tid] = 0;
        __syncthreads();
        for (int rr = 0; rr < 8; ++rr) {
            const int rl = wave * 8 + rr; const size_t row = (size_t)it * 64 + rl;
            f32x4 v[4]; float s = 0.f;
#pragma unroll
            for (int j = 0; j < 4; ++j) { v[j] = *(const f32x4*)(pre1 + row * DM + 4 * lane + 256 * j); s += (v[j][0] + v[j][1]) + (v[j][2] + v[j][3]); }
            const float mean = wave_sum(s) * (1.f / DM); float s2 = 0.f;
#pragma unroll
            for (int j = 0; j < 4; ++j) { v[j] = v[j] - mean; s2 += (v[j][0] * v[j][0] + v[j][1] * v[j][1]) + (v[j][2] * v[j][2] + v[j][3] * v[j][3]); }
            const float rstd = rsqrtf(wave_sum(s2) * (1.f / DM) + LN_EPS);
#pragma unroll
            for (int j = 0; j < 4; ++j) { v[j] = v[j] * rstd * gv[j] + bv[j];
                u32x2 w; w.x = pk2(v[j][0], v[j][1]); w.y = pk2(v[j][2], v[j][3]); *(u32x2*)(X1B + row * DM + 4 * lane + 256 * j) = w; }
            float lg[36];
#pragma unroll
            for (int o = 0; o < 36; ++o) lg[o] = 0.f;
#pragma unroll
            for (int j = 0; j < 4; ++j)
#pragma unroll
                for (int c = 0; c < 4; ++c) { const int k = 4 * lane + 256 * j + c; const float xv = v[j][c];
                    const f32x4 wg = *(const f32x4*)(rgw + (size_t)k * 4);
#pragma unroll
                    for (int o = 0; o < 4; ++o) lg[o] += xv * wg[o];
#pragma unroll
                    for (int q = 0; q < 8; ++q) { const f32x4 we = *(const f32x4*)(rew + (size_t)k * 32 + 4 * q);
#pragma unroll
                        for (int o = 0; o < 4; ++o) lg[4 + 4 * q + o] += xv * we[o]; }
                    asm volatile("" ::: "memory"); }
#pragma unroll
            for (int o = 0; o < 36; ++o) lg[o] = wave_sum(lg[o]);
            if (lane == 0) {
                float gl[4]; int gs = 0; float gm;
#pragma unroll
                for (int o = 0; o < 4; ++o) gl[o] = lg[o] + rgb[o];
                gm = gl[0];
#pragma unroll
                for (int o = 1; o < 4; ++o) if (gl[o] > gm) { gm = gl[o]; gs = o; }
                float gsum = 0.f;
#pragma unroll
                for (int o = 0; o < 4; ++o) gsum += __expf(gl[o] - gm);
                const float gw = 1.f / gsum;
                float el[8];
#pragma unroll
                for (int o = 0; o < 8; ++o) { float t = 0.f;
#pragma unroll
                    for (int q = 0; q < 4; ++q) t = (gs == q) ? (lg[4 + 8 * q + o] + reb[8 * q + o]) : t;
                    el[o] = t; }
                int i1 = 0; float m1 = el[0];
#pragma unroll
                for (int o = 1; o < 8; ++o) if (el[o] > m1) { m1 = el[o]; i1 = o; }
                int i2 = -1; float m2 = -3.0e38f;
#pragma unroll
                for (int o = 0; o < 8; ++o) if (o != i1 && el[o] > m2) { m2 = el[o]; i2 = o; }
                const float e2 = __expf(m2 - m1); const float w1 = gw / (1.f + e2), w2 = gw * e2 / (1.f + e2);
                const int x1 = gs * 8 + i1, x2 = gs * 8 + i2;
                se[rl * 2] = x1; se[rl * 2 + 1] = x2; sw[rl * 2] = w1; sw[rl * 2 + 1] = w2;
                sr[rl * 2] = atomicAdd((int*)(hist + x1), 1); sr[rl * 2 + 1] = atomicAdd((int*)(hist + x2), 1);
            }
        }
        __syncthreads();
        if (tid < 32) { const int hcount = hist[tid]; base[tid] = hcount > 0 ? (int)atomicAdd(ctl + CW_CNT + tid, (unsigned)hcount) : 0; }
        __syncthreads();
        if (tid < 128) { const int e = se[tid]; const int pos = base[e] + sr[tid]; const int asg = (it * 64 + (tid >> 1)) * 2 + (tid & 1);
            slot[(size_t)e * CAP + pos] = asg; asgw[asg] = sw[tid]; }
    }
}

__device__ __forceinline__ void p7_final(const Args& a) {
    const int tid = threadIdx.x, lane = tid & 63, wave = tid >> 6;
    const bf16_t* X1B = (const bf16_t*)(a.ws + WS_RA); const bf16_t* Y = (const bf16_t*)(a.ws + WS_RB);
    const float* g2 = a.in[17]; const float* b2 = a.in[18];
    f32x4 gv[4], bv[4];
#pragma unroll
    for (int j = 0; j < 4; ++j) { gv[j] = *(const f32x4*)(g2 + 4 * lane + 256 * j); bv[j] = *(const f32x4*)(b2 + 4 * lane + 256 * j); }
    const int gw = blockIdx.x * NWAVES + wave, NGW = gridDim.x * NWAVES;
    for (int row = gw; row < T_; row += NGW) {
        f32x4 v[4]; float s = 0.f;
#pragma unroll
        for (int j = 0; j < 4; ++j) {
            const u32x2 xw = *(const u32x2*)(X1B + (size_t)row * DM + 4 * lane + 256 * j);
            const u32x2 y0 = *(const u32x2*)(Y + (size_t)(2 * row) * DM + 4 * lane + 256 * j);
            const u32x2 y1 = *(const u32x2*)(Y + (size_t)(2 * row + 1) * DM + 4 * lane + 256 * j);
            v[j][0] = DN_ALPHA * bflo(xw.x) + (bflo(y0.x) + bflo(y1.x)); v[j][1] = DN_ALPHA * bfhi(xw.x) + (bfhi(y0.x) + bfhi(y1.x));
            v[j][2] = DN_ALPHA * bflo(xw.y) + (bflo(y0.y) + bflo(y1.y)); v[j][3] = DN_ALPHA * bfhi(xw.y) + (bfhi(y0.y) + bfhi(y1.y));
            s += (v[j][0] + v[j][1]) + (v[j][2] + v[j][3]);
        }
        const float mean = wave_sum(s) * (1.f / DM); float s2 = 0.f;
#pragma unroll
        for (int j = 0; j < 4; ++j) { v[j] = v[j] - mean; s2 += (v[j][0] * v[j][0] + v[j][1] * v[j][1]) + (v[j][2] * v[j][2] + v[j][3] * v[j][3]); }
        const float rstd = rsqrtf(wave_sum(s2) * (1.f / DM) + LN_EPS);
#pragma unroll
        for (int j = 0; j < 4; ++j) *(f32x4*)(a.out + (size_t)row * DM + 4 * lane + 256 * j) = v[j] * rstd * gv[j] + bv[j];
    }
}

__device__ __forceinline__ void moe_tables(const Args& a, LAS unsigned char* lds) {
    LAS int* cn = (LAS int*)(lds + MISC_OFF); LAS int* tp = cn + 32;
    const unsigned* ctl = (const unsigned*)(a.ws + WS_CTL);
    __syncthreads();
    if (threadIdx.x < 32) cn[threadIdx.x] = (int)__hip_atomic_load(ctl + CW_CNT + threadIdx.x, __ATOMIC_RELAXED, __HIP_MEMORY_SCOPE_AGENT);
    __syncthreads();
    if (threadIdx.x == 0) { int s = 0; for (int e = 0; e < 32; ++e) { tp[e] = s; s += (cn[e] + BM - 1) / BM; } tp[32] = s; }
    __syncthreads();
}

constexpr int NPHASES = 10;
__global__ void __launch_bounds__(NTHREADS, 2) mk_fwd(Args a) {
    extern __shared__ __attribute__((aligned(16))) unsigned char lds_raw[];
    LAS unsigned char* lds = (LAS unsigned char*)lds_raw;
    unsigned char* ws = a.ws;
    const int lo = a.ph_lo, hi = a.ph_hi;
    const int G = gridDim.x, bid = blockIdx.x;
#ifndef PHASE_MASK
#define PHASE_MASK 0x3ff
#endif
#define IN(k) (((PHASE_MASK >> (k)) & 1) && lo <= (k) && (k) < hi)
#define SEAM(k) do { if (IN(k) && IN((k) + 1) && a.coop) { cg::this_grid().sync(); } } while (0)
    bf16_t* XB = (bf16_t*)(ws + WS_RA); bf16_t* MG = (bf16_t*)(ws + WS_RA); bf16_t* X1B = (bf16_t*)(ws + WS_RA);
    bf16_t* HB = (bf16_t*)(ws + WS_RB); bf16_t* Yb = (bf16_t*)(ws + WS_RB);
    bf16_t* AB = (bf16_t*)(ws + WS_RC); bf16_t* GB = (bf16_t*)(ws + WS_RD); bf16_t* HM = (bf16_t*)(ws + WS_RD);
    bf16_t* OH = (bf16_t*)(ws + WS_RE); bf16_t* OA = (bf16_t*)(ws + WS_RF);

    if (IN(0)) { p0_prologue(a, lds); }
    SEAM(0);
    if (IN(1)) {
        DenseProb P; P.init(XB, ws + WS_WIN, T_, PW, DM, G, bid);
        EpiProj E{HB, AB, GB, (const float*)(ws + WS_LB)};
        gemm_phase<DenseProb, EpiProj>(lds, P, E);
    }
    SEAM(1);
    if (IN(2)) {
        if (bid < 128) hgrn_naive(lds, HB, a.in[3], OH, bid);
        unsigned* ctl = (unsigned*)(ws + WS_CTL);
        LAS int* qi = (LAS int*)(lds + MISC_OFF + 1024);
        for (;;) {
            __syncthreads();
            if (threadIdx.x == 0) qi[0] = (int)atomicAdd(ctl + CW_ATTQ, 1u);
            __syncthreads();
            const int item = qi[0];
            if (item >= 1024) break;
            attn_naive(lds, AB, a.in[4], OA, item);
        }
    }
    SEAM(2);
    if (IN(3)) {
        DenseProb P; P.init(OH, ws + WS_WA, T_, DM, 512, G, bid);
        EpiGate<0> E{MG, GB};
        gemm_phase<DenseProb, EpiGate<0>>(lds, P, E);
    }
    SEAM(3);
    if (IN(4)) {
        DenseProb P; P.init(OA, ws + WS_WB, T_, DM, 512, G, bid);
        EpiGate<1> E{MG, GB};
        gemm_phase<DenseProb, EpiGate<1>>(lds, P, E);
    }
    SEAM(4);
    if (IN(5)) {
        DenseProb P; P.init(MG, ws + WS_WO, T_, DM, DM, G, bid);
        EpiPre1 E{a.in[0], a.out};
        gemm_phase<DenseProb, EpiPre1>(lds, P, E);
    }
    SEAM(5);
    if (IN(6)) { p5_ln_router(a, lds); }
    SEAM(6);
    if (IN(7)) {
        moe_tables(a, lds);
        MoeProb<true> P; P.Abase = (const char*)X1B; P.Bt = (const char*)(ws + WS_WGU); P.K = DM; P.G = G; P.c = bid;
        P.tp = (const LAS int*)(lds + MISC_OFF) + 32; P.cn = (const LAS int*)(lds + MISC_OFF); P.slot = (const int*)(ws + WS_SLOT); P.estride = (size_t)DM * DM * 2;
        EpiSwiGLU E{HM};
        gemm_phase<MoeProb<true>, EpiSwiGLU>(lds, P, E);
    }
    SEAM(7);
    if (IN(8)) {
        moe_tables(a, lds);
        MoeProb<false> P; P.Abase = (const char*)HM; P.Bt = (const char*)(ws + WS_WD); P.K = DE; P.G = G; P.c = bid;
        P.tp = (const LAS int*)(lds + MISC_OFF) + 32; P.cn = (const LAS int*)(lds + MISC_OFF); P.slot = (const int*)(ws + WS_SLOT); P.estride = (size_t)DM * DE * 2;
        EpiDown E{Yb, (const int*)(ws + WS_SLOT), (const float*)(ws + WS_ASGW), (const LAS int*)(lds + MISC_OFF)};
        gemm_phase<MoeProb<false>, EpiDown>(lds, P, E);
    }
    SEAM(8);
    if (IN(9)) { p7_final(a); }
#undef IN
#undef SEAM
}

extern "C" void kernel_launch(void* const* d_in, const int* in_sizes, int n_in, void* d_out, int out_size, void* d_ws, size_t ws_size, hipStream_t stream) {
    static int grid = 0;
    if (grid == 0) {
        if (n_in != 19 || out_size != T_ * DM || ws_size < WS_END) { fprintf(stderr, "kernel_launch: unexpected shapes (n_in %d out %d ws %zu)\n", n_in, out_size, ws_size); grid = -1; return; }
        int dev = 0, cus = 0, per_cu = 0;
        (void)hipGetDevice(&dev); (void)hipDeviceGetAttribute(&cus, hipDeviceAttributeMultiprocessorCount, dev);
        (void)hipFuncSetAttribute((const void*)mk_fwd, hipFuncAttributeMaxDynamicSharedMemorySize, LDS_BYTES);
        (void)hipOccupancyMaxActiveBlocksPerMultiprocessor(&per_cu, (const void*)mk_fwd, NTHREADS, LDS_BYTES);
        if (per_cu < 1) { fprintf(stderr, "kernel_launch: occupancy query says %d blocks/CU\n", per_cu); per_cu = 1; }
        (void)hipGetLastError();
        grid = cus * 1;
        fprintf(stderr, "kernel_launch: cus %d per_cu %d grid %d\n", cus, per_cu, grid);
    }
    if (grid < 0) return;
    (void)hipMemsetAsync((char*)d_ws + WS_CTL, 0, 65536, stream);
    Args a{};
    for (int i = 0; i < 19; ++i) a.in[i] = (const float*)d_in[i];
    a.out = (float*)d_out; a.ws = (unsigned char*)d_ws;
#if N_LAUNCH_MODE == 1
    a.ph_lo = 0; a.ph_hi = NPHASES; a.coop = 1;
    void* args[] = {&a};
    hipError_t e = hipLaunchCooperativeKernel((const void*)mk_fwd, dim3(grid), dim3(NTHREADS), args, LDS_BYTES, stream);
    if (e != hipSuccess) fprintf(stderr, "cooperative launch failed: %s (grid %d)\n", hipGetErrorString(e), grid);
#else
    for (int p = 0; p < NPHASES; ++p) {
        a.ph_lo = p; a.ph_hi = p + 1; a.coop = 0;
        hipLaunchKernelGGL(mk_fwd, dim3(grid), dim3(NTHREADS), LDS_BYTES, stream, a);
    }
#endif
}
```

```cpp
#include <hip/hip_runtime.h>
#include <hip/hip_cooperative_groups.h>
#include <cstdio>
#include <cstdint>
namespace cg = cooperative_groups;

#ifndef NAIVE_GEMM
#define NAIVE_GEMM 0
#endif
#ifndef ROUTER_MFMA
#define ROUTER_MFMA 1
#endif
#ifndef ATTN_MFMA
#define ATTN_MFMA 1
#endif
#ifndef HGRN_MFMA
#define HGRN_MFMA 1
#endif
#ifndef XCD_BARRIER
#define XCD_BARRIER 1
#endif
#ifndef N_LAUNCH_MODE
#define N_LAUNCH_MODE 1
#endif

#ifndef PROBE_PHASE
#define PROBE_PHASE -1
#endif
#ifndef PROBE_MULT
#define PROBE_MULT 4
#endif
#ifndef PROBE_SECTION
#define PROBE_SECTION -1
#endif
#define LAS __attribute__((address_space(3)))
typedef unsigned short bf16_t;
typedef short bf16x8 __attribute__((ext_vector_type(8)));
typedef float f32x4 __attribute__((ext_vector_type(4)));
typedef float f32x2 __attribute__((ext_vector_type(2)));
typedef unsigned u32x4 __attribute__((ext_vector_type(4)));
typedef unsigned u32x2 __attribute__((ext_vector_type(2)));

constexpr int T_ = 65536, DM = 1024, SEQ = 2048, NBATCH = 32;
constexpr int PW = 4864;
constexpr int NE = 32, DE = 512;
constexpr int CAP = 131072;
constexpr float DN_ALPHA = 1.189207115002721f;
constexpr float LN_EPS = 1e-5f, RMS_EPS = 1e-6f;
constexpr int NWAVES = 8, NTHREADS = 512;

constexpr size_t MiB = 1u << 20;
constexpr size_t WS_CTL = 0;
constexpr size_t WS_LB = 1 * MiB;
constexpr size_t WS_WIN = 2 * MiB;
constexpr size_t WS_WA = 12 * MiB;
constexpr size_t WS_WB = 13 * MiB;
constexpr size_t WS_WO = 14 * MiB;
constexpr size_t WS_WGU = 16 * MiB;
constexpr size_t WS_WD = 80 * MiB;
constexpr size_t WS_SLOT = 112 * MiB;
constexpr size_t WS_ASGW = 128 * MiB;
constexpr size_t WS_ASGEP = 129 * MiB;
constexpr size_t WS_RA = 132 * MiB;
constexpr size_t WS_RB = 260 * MiB;
constexpr size_t WS_RC = 516 * MiB;
constexpr size_t WS_RD = 612 * MiB;
constexpr size_t WS_RE = 868 * MiB;
constexpr size_t WS_RF = 932 * MiB;
constexpr size_t WS_END = 996 * MiB;
constexpr int CW_CNT = 64;
constexpr int CW_ATTQ = 128;
constexpr int CW_BAR = 4096;

constexpr int RING_BYTES = 131072;
constexpr int MISC_OFF = RING_BYTES;
constexpr int LDS_BYTES = 147456;

__device__ __forceinline__ float bf2f(bf16_t v) { return __uint_as_float((unsigned)v << 16); }
__device__ __forceinline__ unsigned f2bf(float f) { unsigned u = __float_as_uint(f); return (u + 0x7fffu + ((u >> 16) & 1u)) >> 16; }
typedef __bf16 hwbf16x2 __attribute__((ext_vector_type(2)));
__device__ __forceinline__ unsigned pk2(float lo, float hi) { f32x2 v = {lo, hi}; hwbf16x2 b = __builtin_convertvector(v, hwbf16x2); return __builtin_bit_cast(unsigned, b); }
__device__ __forceinline__ float bflo(unsigned w) { return __uint_as_float(w << 16); }
__device__ __forceinline__ float bfhi(unsigned w) { return __uint_as_float(w & 0xffff0000u); }
__device__ __forceinline__ float sigm(float x) { return __builtin_amdgcn_rcpf(1.f + __builtin_amdgcn_exp2f(x * -1.4426950408889634f)); }
__device__ __forceinline__ float silu(float x) { return x * sigm(x); }
__device__ __forceinline__ float wave_sum(float v) {
#pragma unroll
    for (int o = 1; o < 64; o <<= 1) v += __shfl_xor(v, o);
    return v;
}
__device__ __forceinline__ float wave_max(float v) {
#pragma unroll
    for (int o = 1; o < 64; o <<= 1) v = fmaxf(v, __shfl_xor(v, o));
    return v;
}
#define LDS_WAIT() asm volatile("s_waitcnt lgkmcnt(0)" ::: "memory")
#if PROBE_SECTION >= 0
#define SEC_DECL unsigned long long sec_t = 0, sec_acc = 0
#define SEC_MARK(id) do { const unsigned long long _n = __builtin_amdgcn_s_memrealtime(); if ((id) == PROBE_SECTION + 1) sec_acc += _n - sec_t; sec_t = _n; } while (0)
#define SEC_STORE(lds) do { if (blockIdx.x == 0 && threadIdx.x == 0) *(LAS unsigned long long*)((lds) + LDS_BYTES - 32) = sec_acc; } while (0)
#else
#define SEC_DECL do { } while (0)
#define SEC_MARK(id) do { } while (0)
#define SEC_STORE(lds) do { } while (0)
#endif

constexpr int BM = 256, BK = 64, HALF = 128, HTB = HALF * BK * 2, NXCD = 8, WGM = 8;
__host__ __device__ __forceinline__ int lds_byte(int r, int c) { const int st = (r >> 4) * 2 + (c >> 5), rr = r & 15, cc = c & 31, ob = rr * 64 + cc * 2; return st * 1024 + (ob ^ (((ob >> 9) & 1) << 5)); }
__host__ __device__ __forceinline__ void stage_rc(int b, int& R, int& C) { const int st = b / 1024, sb = b % 1024, swz = sb ^ (((sb >> 9) & 1) << 5); R = (st >> 1) * 16 + swz / 64; C = (st & 1) * 32 + (swz % 64) / 2; }
__host__ __device__ __forceinline__ int perm32(int rho) { const int n = rho >> 4, i = rho & 15; return 8 * (i >> 2) + 4 * n + (i & 3); }

struct Unit { int pm, pn, e, mt; };

struct DenseProb {
    const char* Abase; const char* Bt; int K; int nM, nN, nwg, G, c;
    __device__ __forceinline__ void init(const void* A, const void* B, int M, int N, int K_, int G_, int c_) { Abase = (const char*)A; Bt = (const char*)B; K = K_; nM = M / BM; nN = N / BM; nwg = nM * nN; G = G_; c = c_; }
    __device__ __forceinline__ bool next(int i, Unit& u) const {
        const long L = (long)i * G + c; if (L >= nwg) return false;
        int wgid = (int)L; { const int q = nwg / NXCD, r = nwg % NXCD, xcd = wgid % NXCD, off = wgid / NXCD; wgid = (xcd < r ? xcd * (q + 1) : r * (q + 1) + (xcd - r) * q) + off; }
        const int nig = WGM * nN, gid = wgid / nig, fm = gid * WGM, gsz = (nM - fm) < WGM ? (nM - fm) : WGM;
        u.pm = fm + ((wgid % nig) % gsz); u.pn = (wgid % nig) / gsz; u.e = 0; u.mt = 0; return true;
    }
    __device__ __forceinline__ unsigned a_rowoff(const Unit& u, int r) const { return (unsigned)(u.pm * BM + r) * (unsigned)K * 2u; }
    __device__ __forceinline__ const char* b_base(const Unit& u) const { return Bt + (size_t)u.pn * BM * K * 2; }
};

template <bool GATHER> struct MoeProb {
    const char* Abase; const char* Bt; int K; int G, c; const LAS int* tp; const LAS int* cn; const int* slot; size_t estride;
    __device__ __forceinline__ bool next(int i, Unit& u) const {
        const int L = i * G + c; const int total = tp[32] * 4; if (L >= total) return false;
        const int tau = L >> 2; int e = 0;
        for (int j = 1; j < 32; ++j) e = (tau >= tp[j]) ? j : e;
        u.pm = tau; u.pn = L & 3; u.e = __builtin_amdgcn_readfirstlane(e); u.mt = __builtin_amdgcn_readfirstlane(tau - tp[e]); return true;
    }
    __device__ __forceinline__ unsigned a_rowoff(const Unit& u, int r) const {
        if (GATHER) { const int s = u.mt * BM + r; const int asg = (s < cn[u.e]) ? slot[(size_t)u.e * CAP + s] : 0; return (unsigned)(asg >> 1) * (unsigned)K * 2u; }
        else return (unsigned)(u.pm * BM + r) * (unsigned)K * 2u;
    }
    __device__ __forceinline__ const char* b_base(const Unit& u) const { return Bt + (size_t)u.e * estride + (size_t)u.pn * BM * K * 2; }
};

struct EpiProj {
    static constexpr bool PERM = true;
    bf16_t* HB; bf16_t* AB; bf16_t* GB; const float* lb;
    template <int MODE> __device__ __forceinline__ void run(const f32x4 (&acc)[2][4][2], bf16_t* base, int ld, int row0, int col0, int lbcol) const {
#pragma unroll
        for (int bj = 0; bj < 2; ++bj) {
            float l8[8];
            if (MODE == 2) {
#pragma unroll
                for (int j = 0; j < 8; ++j) l8[j] = lb[lbcol + bj * HALF + j];
            }
#pragma unroll
            for (int m = 0; m < 4; ++m) {
                float v[8];
#pragma unroll
                for (int j = 0; j < 4; ++j) { v[j] = acc[bj][m][0][j]; v[4 + j] = acc[bj][m][1][j]; }
#pragma unroll
                for (int j = 0; j < 8; ++j) {
                    if (MODE == 1) v[j] = silu(v[j]);
                    else if (MODE == 2) v[j] = __logf(l8[j] + (1.f - l8[j]) * sigm(v[j]));
                    else if (MODE == 3) v[j] = v[j] * 0.18033688011112042f;
                    else if (MODE == 4) v[j] = sigm(v[j]);
                }
                u32x4 w; w.x = pk2(v[0], v[1]); w.y = pk2(v[2], v[3]); w.z = pk2(v[4], v[5]); w.w = pk2(v[6], v[7]);
                *(u32x4*)(base + (size_t)(row0 + m * 16) * ld + col0 + bj * HALF) = w;
            }
        }
    }
    __device__ __forceinline__ void operator()(const f32x4 (&acc)[2][4][2], int ai, const Unit& u, int wr, int wc, int fr, int fq) const {
        const int pn = u.pn, row0 = u.pm * BM + ai * HALF + wr * 64 + fr, colg = pn * BM + wc * 32 + 8 * fq;
        if (pn < 2) run<1>(acc, HB, 2048, row0, colg, 0);
        else if (pn < 4) run<2>(acc, HB, 2048, row0, colg, colg - 512);
        else if (pn < 6) run<0>(acc, HB, 2048, row0, colg, 0);
        else if (pn < 8) run<1>(acc, HB, 2048, row0, colg, 0);
        else if (pn < 10) run<3>(acc, AB, 768, row0, colg - 2048, 0);
        else if (pn < 11) run<0>(acc, AB, 768, row0, colg - 2048, 0);
        else run<0>(acc, GB, 2048, row0, colg - 2816, 0);
    }
};
template <int PASS> struct EpiGate {
    static constexpr bool PERM = true;
    bf16_t* MG; const bf16_t* GB;
    __device__ __forceinline__ void operator()(const f32x4 (&acc)[2][4][2], int ai, const Unit& u, int wr, int wc, int fr, int fq) const {
        const unsigned gbase = ((unsigned)(u.pm * BM + ai * HALF + wr * 64 + fr) * 2048u + (unsigned)(PASS * 1024 + u.pn * BM + wc * 32 + 8 * fq)) * 2u;
        const unsigned mbase = ((unsigned)(u.pm * BM + ai * HALF + wr * 64 + fr) * 1024u + (unsigned)(u.pn * BM + wc * 32 + 8 * fq)) * 2u;
#pragma unroll
        for (int mh = 0; mh < 2; ++mh) {
            u32x4 gt[2][2], pt[2][2];
#pragma unroll
            for (int mm = 0; mm < 2; ++mm)
#pragma unroll
                for (int bj = 0; bj < 2; ++bj) {
                    const int m = mh * 2 + mm;
                    gt[mm][bj] = *(const u32x4*)((const char*)GB + (gbase + (unsigned)((m * 16 * 2048 + bj * HALF) * 2)));
                    if (PASS == 1) pt[mm][bj] = *(const u32x4*)((const char*)MG + (mbase + (unsigned)((m * 16 * 1024 + bj * HALF) * 2)));
                }
#pragma unroll
            for (int mm = 0; mm < 2; ++mm)
#pragma unroll
                for (int bj = 0; bj < 2; ++bj) {
                    const int m = mh * 2 + mm; const u32x4 g = gt[mm][bj];
                    float v[8];
#pragma unroll
                    for (int j = 0; j < 4; ++j) { v[j] = acc[bj][m][0][j]; v[4 + j] = acc[bj][m][1][j]; }
                    v[0] *= sigm(bflo(g.x)); v[1] *= sigm(bfhi(g.x)); v[2] *= sigm(bflo(g.y)); v[3] *= sigm(bfhi(g.y)); v[4] *= sigm(bflo(g.z)); v[5] *= sigm(bfhi(g.z)); v[6] *= sigm(bflo(g.w)); v[7] *= sigm(bfhi(g.w));
                    if (PASS == 1) { const u32x4 p = pt[mm][bj];
                        v[0] += bflo(p.x); v[1] += bfhi(p.x); v[2] += bflo(p.y); v[3] += bfhi(p.y); v[4] += bflo(p.z); v[5] += bfhi(p.z); v[6] += bflo(p.w); v[7] += bfhi(p.w); }
                    u32x4 w; w.x = pk2(v[0], v[1]); w.y = pk2(v[2], v[3]); w.z = pk2(v[4], v[5]); w.w = pk2(v[6], v[7]);
                    *(u32x4*)((char*)MG + (mbase + (unsigned)((m * 16 * 1024 + bj * HALF) * 2))) = w;
                }
            asm volatile("" ::: "memory");
        }
    }
};
struct EpiPre1 {
    static constexpr bool PERM = false;
    const float* x; float* out;
    __device__ __forceinline__ void operator()(const f32x4 (&acc)[2][4][2], int ai, const Unit& u, int wr, int wc, int fr, int fq) const {
        const unsigned base = ((unsigned)(u.pm * BM + ai * HALF + wr * 64 + fr) * DM + (unsigned)(u.pn * BM + wc * 32 + 4 * fq)) * 4u;
#pragma unroll
        for (int mh = 0; mh < 2; ++mh) {
            f32x4 xv[2][2][2];
#pragma unroll
            for (int mm = 0; mm < 2; ++mm)
#pragma unroll
                for (int bj = 0; bj < 2; ++bj)
#pragma unroll
                    for (int n = 0; n < 2; ++n)
                        xv[mm][bj][n] = *(const f32x4*)((const char*)x + (base + (unsigned)((((mh * 2 + mm) * 16) * DM + bj * HALF + n * 16) * 4)));
#pragma unroll
            for (int mm = 0; mm < 2; ++mm)
#pragma unroll
                for (int bj = 0; bj < 2; ++bj)
#pragma unroll
                    for (int n = 0; n < 2; ++n)
                        *(f32x4*)((char*)out + (base + (unsigned)((((mh * 2 + mm) * 16) * DM + bj * HALF + n * 16) * 4))) = acc[bj][mh * 2 + mm][n] + xv[mm][bj][n] * DN_ALPHA;
            asm volatile("" ::: "memory");
        }
    }
};
struct EpiSwiGLU {
    static constexpr bool PERM = true;
    bf16_t* H;
    __device__ __forceinline__ void operator()(const f32x4 (&acc)[2][4][2], int ai, const Unit& u, int wr, int wc, int fr, int fq) const {
        const int row0 = u.pm * BM + ai * HALF + wr * 64 + fr, col0 = u.pn * 128 + wc * 16 + 4 * fq;
#pragma unroll
        for (int m = 0; m < 4; ++m)
#pragma unroll
            for (int bj = 0; bj < 2; ++bj) {
                const f32x4 g = acc[bj][m][0], up = acc[bj][m][1];
                u32x2 w; w.x = pk2(silu(g[0]) * up[0], silu(g[1]) * up[1]); w.y = pk2(silu(g[2]) * up[2], silu(g[3]) * up[3]);
                *(u32x2*)(H + (size_t)(row0 + m * 16) * DE + col0 + bj * 64) = w;
            }
    }
};
struct EpiDown {
    static constexpr bool PERM = true;
    bf16_t* Y;
    __device__ __forceinline__ void operator()(const f32x4 (&acc)[2][4][2], int ai, const Unit& u, int wr, int wc, int fr, int fq) const {
        const unsigned base = ((unsigned)(u.pm * BM + ai * HALF + wr * 64 + fr) * DM + (unsigned)(u.pn * BM + wc * 32 + 8 * fq)) * 2u;
#pragma unroll
        for (int m = 0; m < 4; ++m)
#pragma unroll
            for (int bj = 0; bj < 2; ++bj) {
                const f32x4 a = acc[bj][m][0], b = acc[bj][m][1];
                u32x4 o; o.x = pk2(a[0], a[1]); o.y = pk2(a[2], a[3]); o.z = pk2(b[0], b[1]); o.w = pk2(b[2], b[3]);
                *(u32x4*)((char*)Y + (base + (unsigned)((m * 16 * DM + bj * HALF) * 2))) = o;
            }
    }
};

template <class Prob, class Epi>
__device__ __forceinline__ void gemm_phase_naive(const Prob& P, const Epi& E) {
    const int tid = threadIdx.x, wid = tid >> 6, lane = tid & 63, wr = wid >> 2, wc = wid & 3, fr = lane & 15, fq = lane >> 4;
    const int K = P.K;
    Unit u;
    for (int i = 0; P.next(i, u); ++i) {
        const char* bB = P.b_base(u);
        for (int ai = 0; ai < 2; ++ai) {
            f32x4 acc[2][4][2];
#pragma unroll
            for (int b = 0; b < 2; ++b)
#pragma unroll
                for (int m = 0; m < 4; ++m)
#pragma unroll
                    for (int n = 0; n < 2; ++n) acc[b][m][n] = (f32x4){0.f, 0.f, 0.f, 0.f};
            unsigned ro[4];
#pragma unroll
            for (int m = 0; m < 4; ++m) ro[m] = P.a_rowoff(u, ai * HALF + wr * 64 + m * 16 + fr);
#pragma unroll 1
            for (int k = 0; k < K; k += 4) {
                u32x2 ap[4];
#pragma unroll
                for (int m = 0; m < 4; ++m) ap[m] = *(const u32x2*)(P.Abase + (ro[m] + (unsigned)k * 2u));
#pragma unroll
                for (int bj = 0; bj < 2; ++bj)
#pragma unroll
                    for (int n = 0; n < 2; ++n)
#pragma unroll
                        for (int j = 0; j < 4; ++j) {
                            const unsigned col = (unsigned)(bj * HALF + wc * 32 + (Epi::PERM ? (8 * fq + 4 * n + j) : (16 * n + 4 * fq + j)));
                            const u32x2 b = *(const u32x2*)(bB + (col * (unsigned)K + (unsigned)k) * 2u);
                            const float b0 = bflo(b.x), b1 = bfhi(b.x), b2 = bflo(b.y), b3 = bfhi(b.y);
#pragma unroll
                            for (int m = 0; m < 4; ++m) {
                                const u32x2 a = ap[m];
                                float s = acc[bj][m][n][j];
                                s = fmaf(bflo(a.x), b0, s); s = fmaf(bfhi(a.x), b1, s); s = fmaf(bflo(a.y), b2, s); s = fmaf(bfhi(a.y), b3, s);
                                acc[bj][m][n][j] = s;
                            }
                        }
                asm volatile("" ::: "memory");
            }
            E(acc, ai, u, wr, wc, fr, fq);
        }
    }
}

template <class Prob, class Epi, bool ALIGN_EPI, bool SP2>
__device__ __forceinline__ void gemm_phase_mfma(LAS unsigned char* lds, const Prob& P, const Epi& E) {
    const int tid = threadIdx.x, wid = __builtin_amdgcn_readfirstlane(tid >> 6), lane = tid & 63, wr = wid >> 2, wc = wid & 3, fr = lane & 15, fq = lane >> 4;
    const int K = P.K, nt = K / BK;
    int Ra[2]; unsigned Ca[2], voffB[2];
#pragma unroll
    for (int i = 0; i < 2; ++i) { int R, C; stage_rc(tid * 16 + i * 8192, R, C); const int Rb = Epi::PERM ? ((R & ~31) + perm32(R & 31)) : R;
        Ra[i] = R; Ca[i] = (unsigned)C * 2u; voffB[i] = (unsigned)(Rb * K + C) * 2u; }
    const size_t kstep = (size_t)(BK * 2);
    const size_t hstep = (size_t)HALF * K * 2;
    const unsigned ldsw = (unsigned)wid * 1024u;
    const int aoff = lds_byte(wr * 64 + fr, fq * 8), boff = lds_byte(wc * 32 + fr, fq * 8);
#define PG8_SA(b, h) (((b) * 2 + (h)) * HTB)
#define PG8_SB(b, h) ((4 + (b) * 2 + (h)) * HTB)
#define PG8_STAGEB(bufoff, gbase) do { _Pragma("unroll") for (int _i = 0; _i < 2; ++_i) \
        __builtin_amdgcn_global_load_lds((const unsigned*)((const char*)(gbase) + voffB[_i]), (LAS unsigned*)(lds + (bufoff) + ldsw + _i * 8192), 16, 0, 0); } while (0)
#define PG8_STAGEA(bufoff, gbase, v0, v1) do { \
        __builtin_amdgcn_global_load_lds((const unsigned*)((const char*)(gbase) + (v0)), (LAS unsigned*)(lds + (bufoff) + ldsw), 16, 0, 0); \
        __builtin_amdgcn_global_load_lds((const unsigned*)((const char*)(gbase) + (v1)), (LAS unsigned*)(lds + (bufoff) + ldsw + 8192), 16, 0, 0); } while (0)
#define PG8_LDA(dst, b, h) do { _Pragma("unroll") for (int m = 0; m < 4; ++m) _Pragma("unroll") for (int k = 0; k < 2; ++k) dst[m][k] = *(const LAS bf16x8*)(lds + PG8_SA(b, h) + aoff + m * 2048 + k * 1024); } while (0)
#define PG8_LDB(dst, b, h) do { _Pragma("unroll") for (int n = 0; n < 2; ++n) _Pragma("unroll") for (int k = 0; k < 2; ++k) dst[n][k] = *(const LAS bf16x8*)(lds + PG8_SB(b, h) + boff + n * 2048 + k * 1024); } while (0)
#define PG8_MMA(ai, bj, At, Bt) do { __builtin_amdgcn_s_setprio(1); _Pragma("unroll") for (int m = 0; m < 4; ++m) _Pragma("unroll") for (int n = 0; n < 2; ++n) _Pragma("unroll") for (int k = 0; k < 2; ++k) \
        acc[ai][bj][m][n] = __builtin_amdgcn_mfma_f32_16x16x32_bf16(Bt[n][k], At[m][k], acc[ai][bj][m][n], 0, 0, 0); __builtin_amdgcn_s_setprio(0); } while (0)
#define PG8_WAIT_V(n) asm volatile("s_waitcnt vmcnt(" #n ")" ::: "memory")
#define PG8_WAIT_L(n) asm volatile("s_waitcnt lgkmcnt(" #n ")" ::: "memory")
#define PG8_BAR __builtin_amdgcn_s_barrier()
#define PG8_SCHED __builtin_amdgcn_sched_barrier(0)
    Unit cur, nxt; int ui = 0;
    if (!P.next(0, cur)) return;
    f32x4 acc[2][2][4][2];
#pragma unroll
    for (int a = 0; a < 2; ++a)
#pragma unroll
        for (int b = 0; b < 2; ++b)
#pragma unroll
            for (int m = 0; m < 4; ++m)
#pragma unroll
                for (int n = 0; n < 2; ++n) acc[a][b][m][n] = (f32x4){0.f, 0.f, 0.f, 0.f};
    bf16x8 At[4][2], B0[2][2], B1[2][2];
    const char* const cA = P.Abase;
    const char* cB = P.b_base(cur);
    unsigned va0, va1, va2, va3;
    va0 = P.a_rowoff(cur, Ra[0]) + Ca[0]; va1 = P.a_rowoff(cur, Ra[1]) + Ca[1]; va2 = P.a_rowoff(cur, HALF + Ra[0]) + Ca[0]; va3 = P.a_rowoff(cur, HALF + Ra[1]) + Ca[1];
    if constexpr (SP2) {
        PG8_STAGEB(PG8_SB(0, 0), cB); PG8_STAGEB(PG8_SB(0, 1), cB + hstep); PG8_STAGEA(PG8_SA(0, 0), cA, va0, va1); PG8_STAGEA(PG8_SA(0, 1), cA, va2, va3);
        if (wr == 1) PG8_BAR;
        PG8_WAIT_V(2); PG8_BAR;
        PG8_STAGEB(PG8_SB(1, 0), cB + kstep); PG8_STAGEA(PG8_SA(1, 0), cA + kstep, va0, va1); PG8_STAGEB(PG8_SB(1, 1), cB + hstep + kstep);
        PG8_WAIT_V(6); PG8_BAR;
    } else {
        PG8_STAGEB(PG8_SB(0, 0), cB); PG8_STAGEA(PG8_SA(0, 0), cA, va0, va1); PG8_STAGEB(PG8_SB(0, 1), cB + hstep); PG8_STAGEA(PG8_SA(0, 1), cA, va2, va3);
        if (wr == 1) PG8_BAR;
        PG8_WAIT_V(4); PG8_BAR;
        PG8_STAGEB(PG8_SB(1, 0), cB + kstep); PG8_STAGEA(PG8_SA(1, 0), cA + kstep, va0, va1); PG8_STAGEB(PG8_SB(1, 1), cB + hstep + kstep);
        PG8_WAIT_V(6); PG8_BAR;
    }
    for (;;) {
        const bool has_next = P.next(ui + 1, nxt);
        unsigned vn0 = va0, vn1 = va1, vn2 = va2, vn3 = va3; const char* nB = cB;
        if (has_next) { nB = P.b_base(nxt);
            vn0 = P.a_rowoff(nxt, Ra[0]) + Ca[0]; vn1 = P.a_rowoff(nxt, Ra[1]) + Ca[1]; vn2 = P.a_rowoff(nxt, HALF + Ra[0]) + Ca[0]; vn3 = P.a_rowoff(nxt, HALF + Ra[1]) + Ca[1]; }
        for (int t = 0; t < nt; t += 2) {
            const bool last = (t == nt - 2);
            const char* a1 = cA + (size_t)(t + 1) * kstep;
            const char* a2 = last ? cA : cA + (size_t)(t + 2) * kstep; const char* b2 = last ? nB : cB + (size_t)(t + 2) * kstep;
            const char* a3 = a2 + kstep; const char* b3 = b2 + kstep;
            const unsigned w0 = last ? vn0 : va0, w1 = last ? vn1 : va1, w2 = last ? vn2 : va2, w3 = last ? vn3 : va3;
            if constexpr (SP2) {
            PG8_LDB(B0, 0, 0); PG8_LDB(B1, 0, 1); PG8_SCHED; PG8_LDA(At, 0, 0); PG8_STAGEA(PG8_SA(1, 1), a1, va2, va3);
            PG8_WAIT_V(8); PG8_WAIT_L(0); PG8_BAR; PG8_MMA(0, 0, At, B0); PG8_MMA(0, 1, At, B1); PG8_BAR; PG8_SCHED;
            PG8_LDA(At, 0, 1); PG8_STAGEB(PG8_SB(0, 0), b2); PG8_STAGEB(PG8_SB(0, 1), b2 + hstep); PG8_STAGEA(PG8_SA(0, 0), a2, w0, w1);
            PG8_WAIT_V(8); PG8_WAIT_L(0); PG8_BAR; PG8_MMA(1, 0, At, B0); PG8_MMA(1, 1, At, B1); PG8_BAR; PG8_SCHED;
            PG8_LDB(B0, 1, 0); PG8_LDB(B1, 1, 1); PG8_SCHED; PG8_LDA(At, 1, 0); PG8_STAGEA(PG8_SA(0, 1), a2, w2, w3);
            PG8_WAIT_V(8); PG8_WAIT_L(0); PG8_BAR; PG8_MMA(0, 0, At, B0); PG8_MMA(0, 1, At, B1); PG8_BAR; PG8_SCHED;
            PG8_LDA(At, 1, 1); PG8_STAGEB(PG8_SB(1, 0), b3); PG8_STAGEB(PG8_SB(1, 1), b3 + hstep); PG8_STAGEA(PG8_SA(1, 0), a3, w0, w1);
            PG8_WAIT_V(8); PG8_WAIT_L(0); PG8_BAR; PG8_MMA(1, 0, At, B0); PG8_MMA(1, 1, At, B1); PG8_BAR; PG8_SCHED;
            } else {
            PG8_LDB(B0, 0, 0); PG8_SCHED; PG8_LDA(At, 0, 0); PG8_STAGEA(PG8_SA(1, 1), a1, va2, va3);
            PG8_WAIT_L(8); PG8_BAR; PG8_WAIT_L(0); PG8_MMA(0, 0, At, B0); PG8_BAR; PG8_SCHED;
            PG8_LDB(B1, 0, 1); PG8_STAGEB(PG8_SB(0, 0), b2);
            PG8_BAR; PG8_WAIT_L(0); PG8_MMA(0, 1, At, B1); PG8_BAR;
            PG8_LDA(At, 0, 1); PG8_STAGEA(PG8_SA(0, 0), a2, w0, w1);
            PG8_BAR; PG8_WAIT_L(0); PG8_MMA(1, 0, At, B0); PG8_BAR; PG8_SCHED;
            PG8_STAGEB(PG8_SB(0, 1), b2 + hstep);
            PG8_WAIT_V(6); PG8_BAR; PG8_MMA(1, 1, At, B1); PG8_BAR;
            PG8_LDB(B0, 1, 0); PG8_SCHED; PG8_LDA(At, 1, 0); PG8_STAGEA(PG8_SA(0, 1), a2, w2, w3);
            PG8_WAIT_L(8); PG8_BAR; PG8_WAIT_L(0); PG8_MMA(0, 0, At, B0); PG8_BAR; PG8_SCHED;
            PG8_LDB(B1, 1, 1); PG8_STAGEB(PG8_SB(1, 0), b3);
            PG8_BAR; PG8_WAIT_L(0); PG8_MMA(0, 1, At, B1); PG8_BAR;
            PG8_LDA(At, 1, 1); PG8_STAGEA(PG8_SA(1, 0), a3, w0, w1);
            PG8_BAR; PG8_WAIT_L(0); PG8_MMA(1, 0, At, B0); PG8_BAR; PG8_SCHED;
            PG8_STAGEB(PG8_SB(1, 1), b3 + hstep);
            PG8_WAIT_V(6); PG8_BAR; PG8_MMA(1, 1, At, B1); PG8_BAR;
            }
        }
        if constexpr (ALIGN_EPI) { if (wr == 0) PG8_BAR; }
        E(acc[0], 0, cur, wr, wc, fr, fq); E(acc[1], 1, cur, wr, wc, fr, fq);
        if (!has_next) break;
#pragma unroll
        for (int a = 0; a < 2; ++a)
#pragma unroll
            for (int b = 0; b < 2; ++b)
#pragma unroll
                for (int m = 0; m < 4; ++m)
#pragma unroll
                    for (int n = 0; n < 2; ++n) acc[a][b][m][n] = (f32x4){0.f, 0.f, 0.f, 0.f};
        cur = nxt; cB = nB; va0 = vn0; va1 = vn1; va2 = vn2; va3 = vn3; ++ui;
        if constexpr (ALIGN_EPI) { if (wr == 1) PG8_BAR; }
    }
    PG8_WAIT_V(0);
    if constexpr (!ALIGN_EPI) { if (wr == 0) PG8_BAR; }
    PG8_BAR;
#undef PG8_SA
#undef PG8_SB
#undef PG8_STAGEA
#undef PG8_STAGEB
#undef PG8_LDA
#undef PG8_LDB
#undef PG8_MMA
#undef PG8_WAIT_V
#undef PG8_WAIT_L
#undef PG8_BAR
#undef PG8_SCHED
}

template <class Prob, class Epi>
__device__ __forceinline__ void gemm_phase(LAS unsigned char* lds, const Prob& P, const Epi& E) {
#if NAIVE_GEMM
    gemm_phase_naive<Prob, Epi>(P, E);
#else
    gemm_phase_mfma<Prob, Epi, true, true>(lds, P, E);
#endif
}

#define XB_TMO      128
#define XB_XCNT(j)  (256  + 64 * (j))
#define XB_XSUB(j)  (1280 + 64 * (j))
#define XB_XGEN(j)  (2304 + 64 * (j))
#define XB_TOP      3328
#define XB_TOPGEN   3392
#define XCD_BAR_WORDS 3456
#define XB_SPIN_CAP (1u << 18)
__device__ __forceinline__ unsigned xb_ld(unsigned* p)              { return __hip_atomic_load(p, __ATOMIC_RELAXED, __HIP_MEMORY_SCOPE_AGENT); }
__device__ __forceinline__ unsigned xb_add(unsigned* p, unsigned v) { return __hip_atomic_fetch_add(p, v, __ATOMIC_RELAXED, __HIP_MEMORY_SCOPE_AGENT); }
__device__ __forceinline__ unsigned xb_xcc_id() { return (unsigned)__builtin_amdgcn_s_getreg((3 << 11) | 20) & 0xFu; }
#define XB_SPIN(cond, bar) do { unsigned _sp = 0; while (cond) { __builtin_amdgcn_s_sleep(1); \
    if ((++_sp & 255u) == 0u) { if (xb_ld(&(bar)[XB_TMO])) break; if (_sp > XB_SPIN_CAP) { atomicAdd(&(bar)[XB_TMO], 1u); break; } } } } while (0)
struct XcdBarrier { unsigned* bar; unsigned x; volatile LAS unsigned* st; };
__device__ __forceinline__ XcdBarrier xcd_barrier_post(unsigned* bar, volatile LAS unsigned* st) {
    XcdBarrier b; b.bar = bar; b.x = xb_xcc_id(); b.st = st;
    if (threadIdx.x == 0) (void)xb_add(&bar[XB_XCNT(b.x)], 1u);
    return b;
}
__device__ __forceinline__ void xcd_barrier_complete(unsigned* bar, unsigned x, unsigned& nloc, unsigned& nx) {
    const unsigned G = gridDim.x * gridDim.y * gridDim.z;
    unsigned sum, cnt, mine, sp = 0u;
    for (;;) {
        sum = 0u; cnt = 0u; mine = 0u;
#pragma unroll
        for (unsigned j = 0; j < 16; ++j) { const unsigned c = xb_ld(&bar[XB_XCNT(j)]); sum += c; cnt += (c > 0u) ? 1u : 0u; mine = (j == x) ? c : mine; }
        if (sum == G) break;
        __builtin_amdgcn_s_sleep(1);
        if ((++sp & 255u) == 0u) { if (xb_ld(&bar[XB_TMO])) break; if (sp > XB_SPIN_CAP) { atomicAdd(&bar[XB_TMO], 1u); break; } }
    }
    nloc = mine > 0u ? mine : 1u; nx = cnt > 0u ? cnt : 1u;
}
__device__ __forceinline__ void xcd_barrier(const XcdBarrier& b) {
    asm volatile("s_waitcnt vmcnt(0)" ::: "memory");
    __syncthreads();
    if (threadIdx.x == 0) {
        unsigned* bar = b.bar;
        __builtin_amdgcn_s_waitcnt(0);
        unsigned nloc = b.st[0], nx = b.st[1];
        if (nloc == 0u) { xcd_barrier_complete(bar, b.x, nloc, nx); b.st[0] = nloc; b.st[1] = nx; }
        const unsigned old = xb_add(&bar[XB_XSUB(b.x)], 1u);
        const unsigned gen = old / nloc;
        if (old + 1u == (gen + 1u) * nloc) {
            __builtin_amdgcn_fence(__ATOMIC_RELEASE, "agent");
            asm volatile("s_waitcnt vmcnt(0)" ::: "memory");
            const unsigned og = xb_add(&bar[XB_TOP], 1u);
            const unsigned tg = og / nx;
            if (og + 1u == (tg + 1u) * nx) xb_add(&bar[XB_TOPGEN], 1u);
            else XB_SPIN(xb_ld(&bar[XB_TOPGEN]) == tg, bar);
            __builtin_amdgcn_fence(__ATOMIC_ACQUIRE, "agent");
            xb_add(&bar[XB_XGEN(b.x)], 1u);
            asm volatile("s_waitcnt vmcnt(0)" ::: "memory");
        } else {
            XB_SPIN(xb_ld(&bar[XB_XGEN(b.x)]) == gen, bar);
            __builtin_amdgcn_fence(__ATOMIC_ACQUIRE, "agent");
            asm volatile("s_waitcnt vmcnt(0)" ::: "memory");
        }
    }
    __syncthreads();
}

struct Args {
    const float* in[19]; float* out; unsigned char* ws; int ph_lo, ph_hi, coop, pad;
};

struct TDesc { const float* W; bf16_t* WT; int K, N, mode, item; };
__device__ __forceinline__ void t_load(const TDesc& d, f32x4 (&v)[8], int lane) {
    const int nblk = d.N / 32, kb = d.item / nblk, nb = d.item % nblk, k0 = 64 * kb, n0 = 32 * nb;
#pragma unroll
    for (int i = 0; i < 8; ++i) { const int idx = lane + 64 * i, kk = idx >> 3, n4 = idx & 7; v[i] = *(const f32x4*)(d.W + (size_t)(k0 + kk) * d.N + n0 + 4 * n4); }
}
__device__ __forceinline__ void t_finish(const TDesc& d, const f32x4 (&v)[8], LAS float* scr, int lane) {
    const int nblk = d.N / 32, kb = d.item / nblk, nb = d.item % nblk, k0 = 64 * kb, n0 = 32 * nb;
#pragma unroll
    for (int i = 0; i < 8; ++i) { const int idx = lane + 64 * i, kk = idx >> 3, n4 = idx & 7; LAS float* p = scr + kk * 33 + 4 * n4; p[0] = v[i][0]; p[1] = v[i][1]; p[2] = v[i][2]; p[3] = v[i][3]; }
    LDS_WAIT();
    const int c = lane & 7;
#pragma unroll
    for (int j = 0; j < 4; ++j) { const int n = (lane >> 3) + 8 * j; const LAS float* sp = scr + (8 * c) * 33 + n;
        u32x4 o; o.x = pk2(sp[0 * 33], sp[1 * 33]); o.y = pk2(sp[2 * 33], sp[3 * 33]); o.z = pk2(sp[4 * 33], sp[5 * 33]); o.w = pk2(sp[6 * 33], sp[7 * 33]);
        const int ng = n0 + n; const int row = (d.mode == 0) ? ng : ((ng >> 2) * 8 + (d.mode == 2 ? 4 : 0) + (ng & 3));
        *(u32x4*)(d.WT + (size_t)row * d.K + k0 + 8 * c) = o; }
    LDS_WAIT();
}
constexpr int TI_A = (512 / 64) * (DM / 32), TI_O = (DM / 64) * (DM / 32), TI_G = (DM / 64) * (DE / 32), TI_D = (DE / 64) * (DM / 32), TI_IN = (DM / 64) * (PW / 32);
constexpr int TI_REST = 2 * TI_A + TI_O + NE * (2 * TI_G + TI_D);
__device__ __forceinline__ TDesc t_decode_rest(const Args& a, int it) {
    unsigned char* ws = a.ws; TDesc d; int r = it;
    if (r < TI_A) { d = TDesc{a.in[5], (bf16_t*)(ws + WS_WA), 512, DM, 0, r}; return d; } r -= TI_A;
    if (r < TI_A) { d = TDesc{a.in[6], (bf16_t*)(ws + WS_WB), 512, DM, 0, r}; return d; } r -= TI_A;
    if (r < TI_O) { d = TDesc{a.in[7], (bf16_t*)(ws + WS_WO), DM, DM, 0, r}; return d; } r -= TI_O;
    const int e = r / (2 * TI_G + TI_D); r -= e * (2 * TI_G + TI_D);
    if (r < TI_G) { d = TDesc{a.in[14] + (size_t)e * DM * DE, (bf16_t*)(ws + WS_WGU) + (size_t)e * DM * DM, DM, DE, 1, r}; return d; } r -= TI_G;
    if (r < TI_G) { d = TDesc{a.in[15] + (size_t)e * DM * DE, (bf16_t*)(ws + WS_WGU) + (size_t)e * DM * DM, DM, DE, 2, r}; return d; } r -= TI_G;
    d = TDesc{a.in[16] + (size_t)e * DE * DM, (bf16_t*)(ws + WS_WD) + (size_t)e * DM * DE, DE, DM, 0, r}; return d;
}
__device__ __forceinline__ void p0_rest(const Args& a, LAS unsigned char* lds, int gw, int NGW) {
    const int tid = threadIdx.x, lane = tid & 63, wave = tid >> 6;
    LAS float* scr = (LAS float*)(lds + wave * 16384);
    f32x4 va[8], vb[8];
    int it = gw;
    if (it >= TI_REST) return;
    TDesc dc = t_decode_rest(a, it); t_load(dc, va, lane);
    for (;;) {
        const int itn = it + NGW; const bool more = itn < TI_REST;
        TDesc dn = dc; if (more) { dn = t_decode_rest(a, itn); t_load(dn, vb, lane); }
        t_finish(dc, va, scr, lane);
        if (!more) break;
        const int itn2 = itn + NGW; const bool more2 = itn2 < TI_REST;
        if (more2) { dc = t_decode_rest(a, itn2); t_load(dc, va, lane); }
        t_finish(dn, vb, scr, lane);
        if (!more2) break;
        it = itn2;
    }
}
__device__ __forceinline__ void p0_prologue(const Args& a, LAS unsigned char* lds) {
    const int tid = threadIdx.x, lane = tid & 63, wave = tid >> 6;
    unsigned char* ws = a.ws;
    LAS float* scr = (LAS float*)(lds + wave * 16384);
    const int gw = blockIdx.x * NWAVES + wave, NGW = gridDim.x * NWAVES;
    for (int it = gw; it < TI_IN; it += NGW) { TDesc d{a.in[2], (bf16_t*)(ws + WS_WIN), DM, PW, 0, it}; f32x4 v[8]; t_load(d, v, lane); t_finish(d, v, scr, lane); }
    {
        const f32x4* x4 = (const f32x4*)a.in[0]; u32x4* o = (u32x4*)(ws + WS_RA);
        const size_t n8 = (size_t)T_ * DM / 8, stride = (size_t)gridDim.x * NTHREADS;
        for (size_t i = (size_t)blockIdx.x * NTHREADS + tid; i < n8; i += 4 * stride) {
            f32x4 p[4], q[4];
#pragma unroll
            for (int j = 0; j < 4; ++j) { const size_t ii = i + j * stride; if (ii < n8) { p[j] = x4[2 * ii]; q[j] = x4[2 * ii + 1]; } }
#pragma unroll
            for (int j = 0; j < 4; ++j) { const size_t ii = i + j * stride; if (ii < n8) {
                u32x4 w; w.x = pk2(p[j][0], p[j][1]); w.y = pk2(p[j][2], p[j][3]); w.z = pk2(q[j][0], q[j][1]); w.w = pk2(q[j][2], q[j][3]);
                o[ii] = w; } }
        }
    }
    if (blockIdx.x == 0) {
        float* lb = (float*)(ws + WS_LB); const float* lg = a.in[1];
        lb[tid] = 1.f / (1.f + __expf(lg[512 + tid] - lg[tid]));
        unsigned* ctl = (unsigned*)(ws + WS_CTL);
        if (tid < 32) ctl[CW_CNT + tid] = 0u;
        if (tid == 32) ctl[CW_ATTQ] = 0u;
    }
}

__device__ __forceinline__ void hgrn_naive(LAS unsigned char* lds, const bf16_t* HB, const float* normw, bf16_t* OH, int item) {
    const int tid = threadIdx.x, lane = tid & 63, wave = tid >> 6, v = tid & 127, kg = tid >> 7;
    const int b = item >> 2, h = item & 3;
    LAS float* sq = (LAS float*)lds;
    LAS float* sf = sq + 64 * 128;
    LAS float* sv = sf + 64 * 128;
    LAS float* so = sv + 64 * 128;
    LAS float* sp = so + 64 * 128;
    float S[32];
#pragma unroll
    for (int i = 0; i < 32; ++i) S[i] = 0.f;
    for (int c = 0; c < 32; ++c) {
        const size_t row0 = (size_t)b * SEQ + c * 64;
        for (int i = 0; i < 16; ++i) { const int idx = tid + 512 * i, r = idx >> 7, col = idx & 127; const bf16_t* p = HB + (row0 + r) * 2048 + h * 128 + col;
            sq[idx] = bf2f(p[0]); sf[idx] = __expf(bf2f(p[512])); sv[idx] = bf2f(p[1024]); }
        __syncthreads();
        for (int t = 0; t < 64; ++t) {
            const float vt = sv[t * 128 + v]; float part = 0.f;
#pragma unroll
            for (int i = 0; i < 32; ++i) { const float f = sf[t * 128 + kg * 32 + i]; S[i] = f * S[i] + (1.f - f) * vt; part += sq[t * 128 + kg * 32 + i] * S[i]; }
            sp[((t & 1) * 4 + kg) * 128 + v] = part;
            __syncthreads();
            if (kg == 0) { const LAS float* q = sp + (t & 1) * 4 * 128 + v; so[t * 128 + v] = (q[0] + q[128]) + (q[256] + q[384]); }
        }
        __syncthreads();
        for (int tt = 0; tt < 8; ++tt) { const int t = wave * 8 + tt; const float o0 = so[t * 128 + lane], o1 = so[t * 128 + 64 + lane];
            const float ss = wave_sum(o0 * o0 + o1 * o1); const float rstd = rsqrtf(ss * (1.f / 128.f) + RMS_EPS);
            const bf16_t* g = HB + (row0 + t) * 2048 + 1536 + h * 128; bf16_t* o = OH + (row0 + t) * 512 + h * 128;
            o[lane] = (bf16_t)f2bf(o0 * rstd * normw[lane] * bf2f(g[lane])); o[64 + lane] = (bf16_t)f2bf(o1 * rstd * normw[64 + lane] * bf2f(g[64 + lane])); }
        __syncthreads();
    }
}

constexpr int HG_QS = 136, HG_TS = 72;
__device__ __forceinline__ void hgrn_mfma(LAS unsigned char* lds, const bf16_t* HB, const float* normw, bf16_t* OH, int item) {
    const int tid = threadIdx.x, lane = tid & 63, wave = __builtin_amdgcn_readfirstlane(tid >> 6), r16 = lane & 15, g = lane >> 4;
    const int b = item >> 2, h = item & 3;
    const int cpi = lane & 7, rg = lane >> 3;
    const int k0 = 16 * wave + 2 * cpi;
    LAS bf16_t* Qp = (LAS bf16_t*)lds;
    LAS bf16_t* Kp = Qp + 64 * HG_QS;
    LAS bf16_t* KppT = Kp + 64 * HG_QS;
    LAS bf16_t* VT = KppT + 128 * HG_TS;
    LAS bf16_t* Pm = VT + 128 * HG_TS;
    LAS bf16_t* Gs0 = Pm + 64 * HG_TS;
    LAS float* dl = (LAS float*)(Gs0 + 2 * 64 * HG_QS);
    LAS float* rs = dl + 128;
    SEC_DECL;
    f32x4 st[8];
#pragma unroll
    for (int kt = 0; kt < 8; ++kt) st[kt] = (f32x4){0.f, 0.f, 0.f, 0.f};
    const f32x4 nw4 = *(const f32x4*)(normw + 16 * wave + 4 * g);
    unsigned rqA[8], rfA[8], rvA[8], rgA[8], rqB[8], rfB[8], rvB[8], rgB[8];
    {
        const unsigned* p32 = (const unsigned*)(HB + ((size_t)b * SEQ + 8 * rg) * 2048 + h * 128 + k0);
#pragma unroll
        for (int i = 0; i < 8; ++i) { rqA[i] = p32[(size_t)i * 1024]; rfA[i] = p32[(size_t)i * 1024 + 256]; rvA[i] = p32[(size_t)i * 1024 + 512]; rgA[i] = p32[(size_t)i * 1024 + 768]; }
        p32 += (size_t)64 * 1024;
#pragma unroll
        for (int i = 0; i < 8; ++i) { rqB[i] = p32[(size_t)i * 1024]; rfB[i] = p32[(size_t)i * 1024 + 256]; rvB[i] = p32[(size_t)i * 1024 + 512]; rgB[i] = p32[(size_t)i * 1024 + 768]; }
    }
    __syncthreads();
#define HG_BODY(cc, rq, rf, rv, rg_) do { const int c = (cc); \
        const size_t row0 = (size_t)b * SEQ + c * 64; \
        LAS bf16_t* Gs = Gs0 + (c & 1) * 64 * HG_QS; \
        SEC_MARK(0); \
        { \
            float f0[8], f1[8], c0[8], c1[8]; float run0 = 1.f, run1 = 1.f; \
_Pragma("unroll") \
            for (int i = 0; i < 8; ++i) { f0[i] = __builtin_amdgcn_exp2f(bflo(rf[i]) * 1.4426950408889634f); f1[i] = __builtin_amdgcn_exp2f(bfhi(rf[i]) * 1.4426950408889634f); run0 *= f0[i]; run1 *= f1[i]; c0[i] = run0; c1[i] = run1; } \
            float inc0 = run0, inc1 = run1; \
_Pragma("unroll") \
            for (int d = 8; d < 64; d <<= 1) { const float y0 = __shfl_up(inc0, d), y1 = __shfl_up(inc1, d); if (lane >= d) { inc0 *= y0; inc1 *= y1; } } \
            float off0 = __shfl_up(inc0, 8), off1 = __shfl_up(inc1, 8); if (rg == 0) { off0 = 1.f; off1 = 1.f; } \
            const float dl0 = __shfl(inc0, 56 + cpi), dl1 = __shfl(inc1, 56 + cpi); \
            if (rg == 0) *(LAS f32x2*)(dl + k0) = (f32x2){dl0, dl1}; \
            float kq0[8], kq1[8]; \
_Pragma("unroll") \
            for (int i = 0; i < 8; ++i) { \
                const float eb0 = off0 * c0[i], eb1 = off1 * c1[i], rb0 = __builtin_amdgcn_rcpf(eb0), rb1 = __builtin_amdgcn_rcpf(eb1); \
                const float kp0 = (1.f - f0[i]) * rb0, kp1 = (1.f - f1[i]) * rb1; \
                const int t = 8 * rg + i; \
                *(LAS unsigned*)(Qp + t * HG_QS + k0) = pk2(bflo(rq[i]) * eb0, bfhi(rq[i]) * eb1); \
                *(LAS unsigned*)(Kp + t * HG_QS + k0) = pk2(kp0, kp1); \
                *(LAS unsigned*)(Gs + t * HG_QS + k0) = rg_[i]; \
                kq0[i] = kp0 * dl0; kq1[i] = kp1 * dl1; \
            } \
            u32x4 w0; \
            w0.x = pk2(kq0[0], kq0[1]); w0.y = pk2(kq0[2], kq0[3]); w0.z = pk2(kq0[4], kq0[5]); w0.w = pk2(kq0[6], kq0[7]); \
            *(LAS u32x4*)(KppT + k0 * HG_TS + 8 * rg) = w0; \
            w0.x = pk2(kq1[0], kq1[1]); w0.y = pk2(kq1[2], kq1[3]); w0.z = pk2(kq1[4], kq1[5]); w0.w = pk2(kq1[6], kq1[7]); \
            *(LAS u32x4*)(KppT + (k0 + 1) * HG_TS + 8 * rg) = w0; \
            w0.x = (rv[0] & 0xffffu) | (rv[1] << 16); w0.y = (rv[2] & 0xffffu) | (rv[3] << 16); w0.z = (rv[4] & 0xffffu) | (rv[5] << 16); w0.w = (rv[6] & 0xffffu) | (rv[7] << 16); \
            *(LAS u32x4*)(VT + k0 * HG_TS + 8 * rg) = w0; \
            w0.x = (rv[0] >> 16) | (rv[1] & 0xffff0000u); w0.y = (rv[2] >> 16) | (rv[3] & 0xffff0000u); w0.z = (rv[4] >> 16) | (rv[5] & 0xffff0000u); w0.w = (rv[6] >> 16) | (rv[7] & 0xffff0000u); \
            *(LAS u32x4*)(VT + (k0 + 1) * HG_TS + 8 * rg) = w0; \
            if (c + 2 < 32) {                                                \
                const unsigned* p32 = (const unsigned*)(HB + (row0 + 128 + 8 * rg) * 2048 + h * 128 + k0); \
_Pragma("unroll") \
                for (int i = 0; i < 8; ++i) { rq[i] = p32[(size_t)i * 1024]; rf[i] = p32[(size_t)i * 1024 + 256]; rv[i] = p32[(size_t)i * 1024 + 512]; rg_[i] = p32[(size_t)i * 1024 + 768]; } \
            } \
        } \
        SEC_MARK(1); \
        __syncthreads(); \
        SEC_MARK(2); \
_Pragma("unroll") \
        for (int u = 0; u < 2; ++u) { \
            const int ti = 2 * wave + u, sti = ti >> 2, tti = ti & 3; \
            f32x4 d = (f32x4){0.f, 0.f, 0.f, 0.f}; \
            if (sti <= tti) { \
_Pragma("unroll") \
                for (int ks = 0; ks < 4; ++ks) { \
                    const bf16x8 ka = *(const LAS bf16x8*)(Kp + (16 * sti + r16) * HG_QS + 32 * ks + 8 * g); \
                    const bf16x8 qb = *(const LAS bf16x8*)(Qp + (16 * tti + r16) * HG_QS + 32 * ks + 8 * g); \
                    d = __builtin_amdgcn_mfma_f32_16x16x32_bf16(ka, qb, d, 0, 0, 0); \
                } \
            } \
            const int t = 16 * tti + r16, s0 = 16 * sti + 4 * g; \
            float pv[4]; \
_Pragma("unroll") \
            for (int r = 0; r < 4; ++r) pv[r] = (sti <= tti && s0 + r <= t) ? d[r] : 0.f; \
            u32x2 w; w.x = pk2(pv[0], pv[1]); w.y = pk2(pv[2], pv[3]); \
            *(LAS u32x2*)(Pm + t * HG_TS + s0) = w; \
        } \
        SEC_MARK(3); \
        __syncthreads(); \
        SEC_MARK(4); \
        bf16x8 vtf[2], sa[4]; \
_Pragma("unroll") \
        for (int ks = 0; ks < 2; ++ks) vtf[ks] = *(const LAS bf16x8*)(VT + (16 * wave + r16) * HG_TS + 32 * ks + 8 * g); \
_Pragma("unroll") \
        for (int q = 0; q < 4; ++q) { u32x4 w; w.x = pk2(st[2 * q][0], st[2 * q][1]); w.y = pk2(st[2 * q][2], st[2 * q][3]); w.z = pk2(st[2 * q + 1][0], st[2 * q + 1][1]); w.w = pk2(st[2 * q + 1][2], st[2 * q + 1][3]); \
            sa[q] = __builtin_bit_cast(bf16x8, w); } \
        f32x4 o[4]; \
_Pragma("unroll") \
        for (int tt = 0; tt < 4; ++tt) { \
            f32x4 d = (f32x4){0.f, 0.f, 0.f, 0.f}; \
            const int t = 16 * tt + r16; \
_Pragma("unroll") \
            for (int ks = 0; ks < 2; ++ks) { \
                const bf16x8 pb = *(const LAS bf16x8*)(Pm + t * HG_TS + 32 * ks + 8 * g); \
                d = __builtin_amdgcn_mfma_f32_16x16x32_bf16(vtf[ks], pb, d, 0, 0, 0); \
            } \
_Pragma("unroll") \
            for (int q = 0; q < 4; ++q) { \
                const u32x2 lo = *(const LAS u32x2*)(Qp + t * HG_QS + 32 * q + 4 * g), hi = *(const LAS u32x2*)(Qp + t * HG_QS + 32 * q + 16 + 4 * g); \
                u32x4 w; w.x = lo.x; w.y = lo.y; w.z = hi.x; w.w = hi.y; \
                d = __builtin_amdgcn_mfma_f32_16x16x32_bf16(sa[q], __builtin_bit_cast(bf16x8, w), d, 0, 0, 0); \
            } \
            o[tt] = d; \
            float ss = d[0] * d[0] + d[1] * d[1] + d[2] * d[2] + d[3] * d[3]; \
            ss += __shfl_xor(ss, 16); ss += __shfl_xor(ss, 32); \
            if (g == 0) rs[t * 8 + wave] = ss; \
        } \
_Pragma("unroll") \
        for (int kt = 0; kt < 8; ++kt) { \
            const f32x4 d4 = *(const LAS f32x4*)(dl + 16 * kt + 4 * g); \
            f32x4 d = st[kt] * d4; \
_Pragma("unroll") \
            for (int ks = 0; ks < 2; ++ks) { \
                const bf16x8 ka = *(const LAS bf16x8*)(KppT + (16 * kt + r16) * HG_TS + 32 * ks + 8 * g); \
                d = __builtin_amdgcn_mfma_f32_16x16x32_bf16(ka, vtf[ks], d, 0, 0, 0); \
            } \
            st[kt] = d; \
        } \
        SEC_MARK(5); \
        __syncthreads(); \
        SEC_MARK(6); \
_Pragma("unroll") \
        for (int tt = 0; tt < 4; ++tt) { \
            const int t = 16 * tt + r16; \
            const f32x4 a0 = *(const LAS f32x4*)(rs + t * 8), a1 = *(const LAS f32x4*)(rs + t * 8 + 4); \
            const float tot = ((a0[0] + a0[1]) + (a0[2] + a0[3])) + ((a1[0] + a1[1]) + (a1[2] + a1[3])); \
            const float rstd = rsqrtf(tot * (1.f / 128.f) + RMS_EPS); \
            const u32x2 gg = *(const LAS u32x2*)(Gs + t * HG_QS + 16 * wave + 4 * g); \
            u32x2 w; w.x = pk2(o[tt][0] * rstd * nw4[0] * bflo(gg.x), o[tt][1] * rstd * nw4[1] * bfhi(gg.x)); w.y = pk2(o[tt][2] * rstd * nw4[2] * bflo(gg.y), o[tt][3] * rstd * nw4[3] * bfhi(gg.y)); \
            *(u32x2*)(OH + (row0 + t) * 512 + h * 128 + 16 * wave + 4 * g) = w; \
        } \
        SEC_MARK(7); \
          \
    } while (0)
    for (int c2 = 0; c2 < 32; c2 += 2) { HG_BODY(c2, rqA, rfA, rvA, rgA); HG_BODY(c2 + 1, rqB, rfB, rvB, rgB); }
#undef HG_BODY
    SEC_STORE(lds);
}

__device__ __forceinline__ void attn_naive(LAS unsigned char* lds, const bf16_t* AB, const float* sinks, bf16_t* OA, int item) {
    const int tid = threadIdx.x, lane = tid & 63, wave = tid >> 6;
    const int hk = item & 1, n = (item >> 1) & 15, b = item >> 5;
    LAS bf16_t* Ks = (LAS bf16_t*)lds;
    LAS bf16_t* Vs = Ks + 256 * 64;
    LAS float* qs = (LAS float*)(lds + 65536) + wave * 192;
    LAS float* ps = qs + 64;
    __syncthreads();
    for (int i = 0; i < 8; ++i) { const int ch = tid + 512 * i; const int kv = ch >> 11, rr = (ch >> 3) & 255, c8 = ch & 7; const int kp = n * 128 - 128 + rr;
        u32x4 val = (u32x4){0u, 0u, 0u, 0u};
        if (kp >= 0) val = *(const u32x4*)(AB + ((size_t)b * SEQ + kp) * 768 + 512 + kv * 128 + hk * 64 + c8 * 8);
        *(LAS u32x4*)((kv ? Vs : Ks) + rr * 64 + c8 * 8) = val; }
    __syncthreads();
    const int g = wave >> 1, head = hk * 4 + g; const float slope = exp2f(-(float)(head + 1)); const float sink = sinks[head];
    for (int ii = 0; ii < 64; ++ii) {
        const int i = (wave & 1) * 64 + ii; const size_t row = (size_t)b * SEQ + n * 128 + i;
        qs[lane] = bf2f(AB[row * 768 + head * 64 + lane]) * 0.6931471805599453f;
        LDS_WAIT();
        float s0 = 0.f, s1 = 0.f; const int j0 = i + 1 + lane, j1 = i + 65 + lane;
#pragma unroll
        for (int d8 = 0; d8 < 8; ++d8) {
            const u32x4 k0 = *(const LAS u32x4*)(Ks + j0 * 64 + d8 * 8), k1 = *(const LAS u32x4*)(Ks + j1 * 64 + d8 * 8);
            const f32x4 qa = *(const LAS f32x4*)(qs + d8 * 8), qb = *(const LAS f32x4*)(qs + d8 * 8 + 4);
            s0 += qa[0] * bflo(k0.x) + qa[1] * bfhi(k0.x) + qa[2] * bflo(k0.y) + qa[3] * bfhi(k0.y) + qb[0] * bflo(k0.z) + qb[1] * bfhi(k0.z) + qb[2] * bflo(k0.w) + qb[3] * bfhi(k0.w);
            s1 += qa[0] * bflo(k1.x) + qa[1] * bfhi(k1.x) + qa[2] * bflo(k1.y) + qa[3] * bfhi(k1.y) + qb[0] * bflo(k1.z) + qb[1] * bfhi(k1.z) + qb[2] * bflo(k1.w) + qb[3] * bfhi(k1.w);
        }
        const bool v0 = (n * 128 - 128 + j0) >= 0, v1 = (n * 128 - 128 + j1) >= 0;
        const float l0 = v0 ? s0 - slope * (float)(127 - lane) : -1e30f, l1 = v1 ? s1 - slope * (float)(63 - lane) : -1e30f;
        const float mx = fmaxf(wave_max(fmaxf(l0, l1)), sink);
        const float e0 = __expf(l0 - mx), e1 = __expf(l1 - mx);
        const float den = wave_sum(e0 + e1) + __expf(sink - mx); const float inv = 1.f / den;
        ps[lane] = e0 * inv; ps[64 + lane] = e1 * inv;
        LDS_WAIT();
        float o = 0.f;
#pragma unroll 8
        for (int jj = 0; jj < 128; ++jj) o += ps[jj] * bf2f(Vs[(i + 1 + jj) * 64 + lane]);
        OA[row * 512 + head * 64 + lane] = (bf16_t)f2bf(o);
        LDS_WAIT();
    }
}

constexpr int ATT_KS = 72, ATT_VS = 280;
struct AttnStage { u32x4 kv[4], vv[4]; };
__device__ __forceinline__ void attn_stage_load(AttnStage& st, const bf16_t* AB, int item) {
    const int tid = threadIdx.x; const int hk = item & 1, n = (item >> 1) & 15, b = item >> 5;
#pragma unroll
    for (int i = 0; i < 4; ++i) { const int ch = tid + 512 * i, rr = ch >> 3, c8 = ch & 7; const int kp = n * 128 - 128 + rr;
        st.kv[i] = (u32x4){0u, 0u, 0u, 0u}; st.vv[i] = (u32x4){0u, 0u, 0u, 0u};
        if (kp >= 0) { const bf16_t* p = AB + ((size_t)b * SEQ + kp) * 768 + 512 + hk * 64 + c8 * 8; st.kv[i] = *(const u32x4*)p; st.vv[i] = *(const u32x4*)(p + 128); } }
}
__device__ __forceinline__ void attn_mfma(LAS unsigned char* lds, const bf16_t* AB, const float* sinks, bf16_t* OA, int item, AttnStage& st, int nitem) {
    const int tid = threadIdx.x, lane = tid & 63, wave = __builtin_amdgcn_readfirstlane(tid >> 6), r16 = lane & 15, g = lane >> 4;
    const int hk = item & 1, n = (item >> 1) & 15, b = item >> 5;
    LAS bf16_t* Ks = (LAS bf16_t*)lds;
    LAS bf16_t* VT = Ks + 256 * ATT_KS;
    __syncthreads();
#pragma unroll
    for (int i = 0; i < 4; ++i) { const int ch = tid + 512 * i, rr = ch >> 3, c8 = ch & 7;
        const u32x4 kv = st.kv[i], vv = st.vv[i];
        *(LAS u32x4*)(Ks + rr * ATT_KS + c8 * 8) = kv;
        LAS bf16_t* vt = VT + (c8 * 8) * ATT_VS + rr;
        vt[0 * ATT_VS] = (bf16_t)(vv.x & 0xffffu); vt[1 * ATT_VS] = (bf16_t)(vv.x >> 16); vt[2 * ATT_VS] = (bf16_t)(vv.y & 0xffffu); vt[3 * ATT_VS] = (bf16_t)(vv.y >> 16);
        vt[4 * ATT_VS] = (bf16_t)(vv.z & 0xffffu); vt[5 * ATT_VS] = (bf16_t)(vv.z >> 16); vt[6 * ATT_VS] = (bf16_t)(vv.w & 0xffffu); vt[7 * ATT_VS] = (bf16_t)(vv.w >> 16); }
    *(LAS unsigned*)(VT + (tid >> 3) * ATT_VS + 256 + (tid & 7) * 2) = 0u;
    if (nitem >= 0) attn_stage_load(st, AB, nitem);
    __syncthreads();
    const int g4 = wave >> 1, qh = wave & 1, head = hk * 4 + g4;
    const float L2E = 1.4426950408889634f;
    const float slope = exp2f(-(float)(head + 1)) * L2E, sink = sinks[head] * L2E;
    const float c0 = slope * (float)(128 + r16 - 4 * g);
    bf16x8 QF[4][2];
#pragma unroll
    for (int qt = 0; qt < 4; ++qt) { const size_t qr = (size_t)b * SEQ + n * 128 + qh * 64 + qt * 16 + r16;
        QF[qt][0] = *(const bf16x8*)(AB + qr * 768 + head * 64 + 8 * g); QF[qt][1] = *(const bf16x8*)(AB + qr * 768 + head * 64 + 32 + 8 * g); }
#pragma unroll
    for (int qt = 0; qt < 4; ++qt) {
        const int q0 = qh * 64 + qt * 16;
        const size_t qrow = (size_t)b * SEQ + n * 128 + q0 + r16;
        const bf16x8 Q0 = QF[qt][0], Q1 = QF[qt][1];
        f32x4 sc[9];
#pragma unroll
        for (int t9 = 0; t9 < 9; ++t9) {
            const LAS bf16_t* kp = Ks + (q0 + t9 * 16 + r16) * ATT_KS + 8 * g;
            const bf16x8 K0 = *(const LAS bf16x8*)kp, K1 = *(const LAS bf16x8*)(kp + 32);
            f32x4 z;
#pragma unroll
            for (int r = 0; r < 4; ++r) z[r] = fmaf(slope, (float)(16 * t9 + r), -c0);
            z = __builtin_amdgcn_mfma_f32_16x16x32_bf16(K0, Q0, z, 0, 0, 0);
            sc[t9] = __builtin_amdgcn_mfma_f32_16x16x32_bf16(K1, Q1, z, 0, 0, 0);
        }
        { const int d0 = r16 - 4 * g;
#pragma unroll
          for (int r = 0; r < 4; ++r) { if (d0 - r >= 0) sc[0][r] = -1e30f; if (d0 - r < 0) sc[8][r] = -1e30f; } }
        if (n == 0) {
#pragma unroll
            for (int t9 = 0; t9 < 9; ++t9)
#pragma unroll
                for (int r = 0; r < 4; ++r) if (q0 + 16 * t9 + 4 * g + r < 128) sc[t9][r] = -1e30f;
        }
        float mx = sink;
#pragma unroll
        for (int t9 = 0; t9 < 9; ++t9)
#pragma unroll
            for (int r = 0; r < 4; ++r) mx = fmaxf(mx, sc[t9][r]);
        mx = fmaxf(mx, __shfl_xor(mx, 16)); mx = fmaxf(mx, __shfl_xor(mx, 32));
        float sum = 0.f;
#pragma unroll
        for (int t9 = 0; t9 < 9; ++t9)
#pragma unroll
            for (int r = 0; r < 4; ++r) { const float e = __builtin_amdgcn_exp2f(sc[t9][r] - mx); sc[t9][r] = e; sum += e; }
        sum += __shfl_xor(sum, 16); sum += __shfl_xor(sum, 32);
        const float inv = __builtin_amdgcn_rcpf(sum + __builtin_amdgcn_exp2f(sink - mx));
        bf16x8 PB[5];
#pragma unroll
        for (int sl = 0; sl < 5; ++sl) {
            u32x4 w; w.x = pk2(sc[2 * sl][0], sc[2 * sl][1]); w.y = pk2(sc[2 * sl][2], sc[2 * sl][3]);
            if (sl < 4) { w.z = pk2(sc[2 * sl + 1][0], sc[2 * sl + 1][1]); w.w = pk2(sc[2 * sl + 1][2], sc[2 * sl + 1][3]); } else { w.z = 0u; w.w = 0u; }
            PB[sl] = __builtin_bit_cast(bf16x8, w);
        }
        f32x4 o[4];
#pragma unroll
        for (int dt = 0; dt < 4; ++dt) {
            o[dt] = (f32x4){0.f, 0.f, 0.f, 0.f};
#pragma unroll
            for (int sl = 0; sl < 5; ++sl) {
                const LAS bf16_t* vp = VT + (dt * 16 + r16) * ATT_VS + q0 + 32 * sl + 4 * g;
                const u32x2 lo = *(const LAS u32x2*)vp, hi = *(const LAS u32x2*)(vp + 16);
                u32x4 a; a.x = lo.x; a.y = lo.y; a.z = hi.x; a.w = hi.y;
                o[dt] = __builtin_amdgcn_mfma_f32_16x16x32_bf16(__builtin_bit_cast(bf16x8, a), PB[sl], o[dt], 0, 0, 0);
            }
        }
#pragma unroll
        for (int dt = 0; dt < 4; ++dt) { u32x2 w; w.x = pk2(o[dt][0] * inv, o[dt][1] * inv); w.y = pk2(o[dt][2] * inv, o[dt][3] * inv);
            *(u32x2*)(OA + qrow * 512 + head * 64 + dt * 16 + 4 * g) = w; }
        __builtin_amdgcn_sched_barrier(0);
    }
}

__device__ __forceinline__ void p5_ln_router(const Args& a, LAS unsigned char* lds) {
    const int tid = threadIdx.x, lane = tid & 63, wave = tid >> 6;
    unsigned char* ws = a.ws;
    const float* pre1 = a.out; bf16_t* X1B = (bf16_t*)(ws + WS_RA);
    const float* g1 = a.in[8]; const float* b1 = a.in[9];
    const float* rgw = a.in[10]; const float* rgb = a.in[11]; const float* rew = a.in[12]; const float* reb = a.in[13];
    unsigned* ctl = (unsigned*)(ws + WS_CTL); int* slot = (int*)(ws + WS_SLOT); float* asgw = (float*)(ws + WS_ASGW);
    LAS int* hist = (LAS int*)(lds);
    LAS int* base = hist + 32;
    LAS int* se = base + 32;
    LAS int* sr = se + 128;
    LAS float* sw = (LAS float*)(sr + 128);
    f32x4 gv[4], bv[4];
#pragma unroll
    for (int j = 0; j < 4; ++j) { gv[j] = *(const f32x4*)(g1 + 4 * lane + 256 * j); bv[j] = *(const f32x4*)(b1 + 4 * lane + 256 * j); }
    for (int it = blockIdx.x; it < T_ / 64; it += gridDim.x) {
        __syncthreads();
        if (tid < 32) hist[tid] = 0;
        __syncthreads();
        for (int rr = 0; rr < 8; ++rr) {
            const int rl = wave * 8 + rr; const size_t row = (size_t)it * 64 + rl;
            f32x4 v[4]; float s = 0.f;
#pragma unroll
            for (int j = 0; j < 4; ++j) { v[j] = *(const f32x4*)(pre1 + row * DM + 4 * lane + 256 * j); s += (v[j][0] + v[j][1]) + (v[j][2] + v[j][3]); }
            const float mean = wave_sum(s) * (1.f / DM); float s2 = 0.f;
#pragma unroll
            for (int j = 0; j < 4; ++j) { v[j] = v[j] - mean; s2 += (v[j][0] * v[j][0] + v[j][1] * v[j][1]) + (v[j][2] * v[j][2] + v[j][3] * v[j][3]); }
            const float rstd = rsqrtf(wave_sum(s2) * (1.f / DM) + LN_EPS);
#pragma unroll
            for (int j = 0; j < 4; ++j) { v[j] = v[j] * rstd * gv[j] + bv[j];
                u32x2 w; w.x = pk2(v[j][0], v[j][1]); w.y = pk2(v[j][2], v[j][3]); *(u32x2*)(X1B + row * DM + 4 * lane + 256 * j) = w; }
            float lg[36];
#pragma unroll
            for (int o = 0; o < 36; ++o) lg[o] = 0.f;
#pragma unroll
            for (int j = 0; j < 4; ++j)
#pragma unroll
                for (int c = 0; c < 4; ++c) { const int k = 4 * lane + 256 * j + c; const float xv = v[j][c];
                    const f32x4 wg = *(const f32x4*)(rgw + (size_t)k * 4);
#pragma unroll
                    for (int o = 0; o < 4; ++o) lg[o] += xv * wg[o];
#pragma unroll
                    for (int q = 0; q < 8; ++q) { const f32x4 we = *(const f32x4*)(rew + (size_t)k * 32 + 4 * q);
#pragma unroll
                        for (int o = 0; o < 4; ++o) lg[4 + 4 * q + o] += xv * we[o]; }
                    asm volatile("" ::: "memory"); }
#pragma unroll
            for (int o = 0; o < 36; ++o) lg[o] = wave_sum(lg[o]);
            if (lane == 0) {
                float gl[4]; int gs = 0; float gm;
#pragma unroll
                for (int o = 0; o < 4; ++o) gl[o] = lg[o] + rgb[o];
                gm = gl[0];
#pragma unroll
                for (int o = 1; o < 4; ++o) if (gl[o] > gm) { gm = gl[o]; gs = o; }
                float gsum = 0.f;
#pragma unroll
                for (int o = 0; o < 4; ++o) gsum += __expf(gl[o] - gm);
                const float gw = 1.f / gsum;
                float el[8];
#pragma unroll
                for (int o = 0; o < 8; ++o) { float t = 0.f;
#pragma unroll
                    for (int q = 0; q < 4; ++q) t = (gs == q) ? (lg[4 + 8 * q + o] + reb[8 * q + o]) : t;
                    el[o] = t; }
                int i1 = 0; float m1 = el[0];
#pragma unroll
                for (int o = 1; o < 8; ++o) if (el[o] > m1) { m1 = el[o]; i1 = o; }
                int i2 = -1; float m2 = -3.0e38f;
#pragma unroll
                for (int o = 0; o < 8; ++o) if (o != i1 && el[o] > m2) { m2 = el[o]; i2 = o; }
                const float e2 = __expf(m2 - m1); const float w1 = gw / (1.f + e2), w2 = gw * e2 / (1.f + e2);
                const int x1 = gs * 8 + i1, x2 = gs * 8 + i2;
                se[rl * 2] = x1; se[rl * 2 + 1] = x2; sw[rl * 2] = w1; sw[rl * 2 + 1] = w2;
                sr[rl * 2] = atomicAdd((int*)(hist + x1), 1); sr[rl * 2 + 1] = atomicAdd((int*)(hist + x2), 1);
            }
        }
        __syncthreads();
        if (tid < 32) { const int hcount = hist[tid]; base[tid] = hcount > 0 ? (int)atomicAdd(ctl + CW_CNT + tid, (unsigned)hcount) : 0; }
        __syncthreads();
        if (tid < 128) { const int e = se[tid]; const int pos = base[e] + sr[tid]; const int asg = (it * 64 + (tid >> 1)) * 2 + (tid & 1);
            slot[(size_t)e * CAP + pos] = asg; asgw[asg] = sw[tid]; }
    }
}

__device__ __forceinline__ unsigned hi16(float f) { return f2bf(f); }
__device__ __forceinline__ void p5_ln_router_mfma(const Args& a, LAS unsigned char* lds) {
    const int tid = threadIdx.x, lane = tid & 63, wave = __builtin_amdgcn_readfirstlane(tid >> 6), r16 = lane & 15, g = lane >> 4;
    unsigned char* ws = a.ws;
    const float* pre1 = a.out; bf16_t* X1B = (bf16_t*)(ws + WS_RA);
    const float* rgw = a.in[10]; const float* rgb = a.in[11]; const float* rew = a.in[12]; const float* reb = a.in[13];
    unsigned* ctl = (unsigned*)(ws + WS_CTL); int* slot = (int*)(ws + WS_SLOT); float* asgw = (float*)(ws + WS_ASGW); int* asgep = (int*)(ws + WS_ASGEP);
    LAS float* sgam = (LAS float*)lds;
    LAS float* sbet = sgam + 1024;
    LAS f32x2* red = (LAS f32x2*)(lds + 8192);
    LAS float* part = (LAS float*)(lds + 9216);
    LAS float* lgs = (LAS float*)(lds + 33792);
    LAS int* hist = (LAS int*)(lds + 36096);
    LAS int* base = hist + 32;
    LAS int* sel_e = (LAS int*)(lds + 36608);
    LAS int* sel_r = sel_e + 2048;
    LAS float* sel_w = (LAS float*)(sel_r + 2048);
    __syncthreads();
    for (int i = tid; i < 1024; i += NTHREADS) { sgam[i] = a.in[8][i]; sbet[i] = a.in[9][i]; }
    if (tid < 32) hist[tid] = 0;
    const int kb = 128 * wave + 8 * g;
    bf16x8 WH[4][3], WL[4][3];
#pragma unroll
    for (int ks = 0; ks < 4; ++ks)
#pragma unroll
        for (int nt = 0; nt < 3; ++nt) {
            const int o = 16 * nt + r16;
            unsigned h[8], l[8];
#pragma unroll
            for (int j = 0; j < 8; ++j) { const int k = kb + 32 * ks + j;
                float w = 0.f; if (o < 4) w = rgw[(size_t)k * 4 + o]; else if (o < 36) w = rew[(size_t)k * 32 + (o - 4)];
                h[j] = f2bf(w); l[j] = f2bf(w - __uint_as_float(h[j] << 16)); }
            u32x4 ph, pl; ph.x = h[0] | (h[1] << 16); ph.y = h[2] | (h[3] << 16); ph.z = h[4] | (h[5] << 16); ph.w = h[6] | (h[7] << 16);
            pl.x = l[0] | (l[1] << 16); pl.y = l[2] | (l[3] << 16); pl.z = l[4] | (l[5] << 16); pl.w = l[6] | (l[7] << 16);
            WH[ks][nt] = __builtin_bit_cast(bf16x8, ph); WL[ks][nt] = __builtin_bit_cast(bf16x8, pl);
        }
    __syncthreads();
    const int NIT = T_ / 16;
    f32x4 xc[4][2], xn[4][2];
    int it = blockIdx.x, jj = 0;
    if (it < NIT) {
#pragma unroll
        for (int ks = 0; ks < 4; ++ks) { const float* p = pre1 + (size_t)(it * 16 + r16) * DM + kb + 32 * ks; xn[ks][0] = *(const f32x4*)p; xn[ks][1] = *(const f32x4*)(p + 4); }
    }
    for (; it < NIT; it += gridDim.x, ++jj) {
#pragma unroll
        for (int ks = 0; ks < 4; ++ks) { xc[ks][0] = xn[ks][0]; xc[ks][1] = xn[ks][1]; }
        const int itn = it + gridDim.x;
        if (itn < NIT) {
#pragma unroll
            for (int ks = 0; ks < 4; ++ks) { const float* p = pre1 + (size_t)(itn * 16 + r16) * DM + kb + 32 * ks; xn[ks][0] = *(const f32x4*)p; xn[ks][1] = *(const f32x4*)(p + 4); }
        }
        float s = 0.f, s2 = 0.f;
#pragma unroll
        for (int ks = 0; ks < 4; ++ks)
#pragma unroll
            for (int q = 0; q < 2; ++q)
#pragma unroll
                for (int c = 0; c < 4; ++c) { const float v = xc[ks][q][c]; s += v; s2 = fmaf(v, v, s2); }
        s += __shfl_xor(s, 16); s2 += __shfl_xor(s2, 16); s += __shfl_xor(s, 32); s2 += __shfl_xor(s2, 32);
        if (g == 0) red[wave * 16 + r16] = (f32x2){s, s2};
        __syncthreads();
        float S = 0.f, S2 = 0.f;
#pragma unroll
        for (int w = 0; w < 8; ++w) { const f32x2 t = red[w * 16 + r16]; S += t.x; S2 += t.y; }
        const float mean = S * (1.f / DM); const float rstd = rsqrtf(fmaxf(S2 * (1.f / DM) - mean * mean, 0.f) + LN_EPS);
        f32x4 acc[3];
#pragma unroll
        for (int nt = 0; nt < 3; ++nt) acc[nt] = (f32x4){0.f, 0.f, 0.f, 0.f};
#pragma unroll
        for (int ks = 0; ks < 4; ++ks) {
            float y[8];
#pragma unroll
            for (int q = 0; q < 2; ++q) { const f32x4 gm = *(const LAS f32x4*)(sgam + kb + 32 * ks + 4 * q), bt = *(const LAS f32x4*)(sbet + kb + 32 * ks + 4 * q);
#pragma unroll
                for (int c = 0; c < 4; ++c) y[4 * q + c] = (xc[ks][q][c] - mean) * rstd * gm[c] + bt[c]; }
            unsigned h[8], l[8];
#pragma unroll
            for (int j = 0; j < 8; ++j) { h[j] = f2bf(y[j]); l[j] = f2bf(y[j] - __uint_as_float(h[j] << 16)); }
            u32x4 ph, pl; ph.x = h[0] | (h[1] << 16); ph.y = h[2] | (h[3] << 16); ph.z = h[4] | (h[5] << 16); ph.w = h[6] | (h[7] << 16);
            pl.x = l[0] | (l[1] << 16); pl.y = l[2] | (l[3] << 16); pl.z = l[4] | (l[5] << 16); pl.w = l[6] | (l[7] << 16);
            *(u32x4*)(X1B + (size_t)(it * 16 + r16) * DM + kb + 32 * ks) = ph;
            const bf16x8 AH = __builtin_bit_cast(bf16x8, ph), AL = __builtin_bit_cast(bf16x8, pl);
#pragma unroll
            for (int nt = 0; nt < 3; ++nt) {
                acc[nt] = __builtin_amdgcn_mfma_f32_16x16x32_bf16(AH, WH[ks][nt], acc[nt], 0, 0, 0);
                acc[nt] = __builtin_amdgcn_mfma_f32_16x16x32_bf16(AL, WH[ks][nt], acc[nt], 0, 0, 0);
                acc[nt] = __builtin_amdgcn_mfma_f32_16x16x32_bf16(AH, WL[ks][nt], acc[nt], 0, 0, 0);
            }
        }
#pragma unroll
        for (int nt = 0; nt < 3; ++nt)
#pragma unroll
            for (int r = 0; r < 4; ++r) part[(wave * 16 + 4 * g + r) * 48 + 16 * nt + r16] = acc[nt][r];
        __syncthreads();
        { const int row = tid >> 5, c = tid & 31; float t = 0.f, t2 = 0.f;
#pragma unroll
          for (int w = 0; w < 8; ++w) { t += part[(w * 16 + row) * 48 + 4 + c]; if (c < 4) t2 += part[(w * 16 + row) * 48 + c]; }
          lgs[row * 36 + 4 + c] = t; if (c < 4) lgs[row * 36 + c] = t2; }
        __syncthreads();
        if (tid < 16) {
            const LAS float* lg = lgs + tid * 36;
            float gl[4]; int gs = 0;
#pragma unroll
            for (int o = 0; o < 4; ++o) gl[o] = lg[o] + rgb[o];
            float gm = gl[0];
#pragma unroll
            for (int o = 1; o < 4; ++o) if (gl[o] > gm) { gm = gl[o]; gs = o; }
            float gsum = 0.f;
#pragma unroll
            for (int o = 0; o < 4; ++o) gsum += __expf(gl[o] - gm);
            const float gw = 1.f / gsum;
            float el[8];
#pragma unroll
            for (int o = 0; o < 8; ++o) el[o] = lg[4 + gs * 8 + o] + reb[gs * 8 + o];
            int i1 = 0; float m1 = el[0];
#pragma unroll
            for (int o = 1; o < 8; ++o) if (el[o] > m1) { m1 = el[o]; i1 = o; }
            int i2 = -1; float m2 = -3.0e38f;
#pragma unroll
            for (int o = 0; o < 8; ++o) if (o != i1 && el[o] > m2) { m2 = el[o]; i2 = o; }
            const float e2 = __expf(m2 - m1); const float w1 = gw / (1.f + e2), w2 = gw * e2 / (1.f + e2);
            const int x1 = gs * 8 + i1, x2 = gs * 8 + i2; const int si = (jj * 16 + tid) * 2;
            sel_e[si] = x1; sel_e[si + 1] = x2; sel_w[si] = w1; sel_w[si + 1] = w2;
            sel_r[si] = atomicAdd((int*)(hist + x1), 1); sel_r[si + 1] = atomicAdd((int*)(hist + x2), 1);
        }
    }
    __syncthreads();
    if (tid < 32) { const int hcount = hist[tid]; base[tid] = hcount > 0 ? (int)atomicAdd(ctl + CW_CNT + tid, (unsigned)hcount) : 0; }
    __syncthreads();
    for (int idx = tid; idx < jj * 32; idx += NTHREADS) {
        const int j2 = idx >> 5, rem = idx & 31; const int token = (blockIdx.x + j2 * gridDim.x) * 16 + (rem >> 1); const int asg = token * 2 + (rem & 1);
        const int e = sel_e[idx]; const int pos = base[e] + sel_r[idx];
        slot[(size_t)e * CAP + pos] = asg; asgw[asg] = sel_w[idx]; asgep[asg] = e | (pos << 5);
    }
}

__device__ __forceinline__ void p7_final(const Args& a, const LAS int* tp) {
    const int tid = threadIdx.x, lane = tid & 63, wave = tid >> 6;
    const bf16_t* X1B = (const bf16_t*)(a.ws + WS_RA); const bf16_t* Y = (const bf16_t*)(a.ws + WS_RB);
    const float* asgw = (const float*)(a.ws + WS_ASGW); const int* asgep = (const int*)(a.ws + WS_ASGEP);
    const float* g2 = a.in[17]; const float* b2 = a.in[18];
    f32x4 gv[4], bv[4];
#pragma unroll
    for (int j = 0; j < 4; ++j) { gv[j] = *(const f32x4*)(g2 + 4 * lane + 256 * j); bv[j] = *(const f32x4*)(b2 + 4 * lane + 256 * j); }
    const int gw = blockIdx.x * NWAVES + wave, NGW = gridDim.x * NWAVES;
    const int per = (T_ + NGW - 1) / NGW;
    for (int r0 = gw * per; r0 < min(T_, (gw + 1) * per); r0 += 32) {
        int yr0 = 0, yr1 = 0; float w0 = 0.f, w1 = 0.f;
        if (lane < 32 && r0 + lane < T_) { const int t = r0 + lane; const int p0 = asgep[2 * t], p1 = asgep[2 * t + 1];
            yr0 = tp[p0 & 31] * BM + (p0 >> 5); yr1 = tp[p1 & 31] * BM + (p1 >> 5); w0 = asgw[2 * t]; w1 = asgw[2 * t + 1]; }
        const int nr = min(32, min(T_, (gw + 1) * per) - r0);
        for (int jj = 0; jj < nr; ++jj) {
            const int row = r0 + jj;
            const int ya = __shfl(yr0, jj), yb = __shfl(yr1, jj); const float wa = __shfl(w0, jj), wb = __shfl(w1, jj);
            f32x4 v[4]; float s = 0.f;
#pragma unroll
            for (int j = 0; j < 4; ++j) {
                const u32x2 xw = *(const u32x2*)(X1B + (size_t)row * DM + 4 * lane + 256 * j);
                const u32x2 y0 = *(const u32x2*)(Y + (size_t)ya * DM + 4 * lane + 256 * j);
                const u32x2 y1 = *(const u32x2*)(Y + (size_t)yb * DM + 4 * lane + 256 * j);
                v[j][0] = DN_ALPHA * bflo(xw.x) + (wa * bflo(y0.x) + wb * bflo(y1.x)); v[j][1] = DN_ALPHA * bfhi(xw.x) + (wa * bfhi(y0.x) + wb * bfhi(y1.x));
                v[j][2] = DN_ALPHA * bflo(xw.y) + (wa * bflo(y0.y) + wb * bflo(y1.y)); v[j][3] = DN_ALPHA * bfhi(xw.y) + (wa * bfhi(y0.y) + wb * bfhi(y1.y));
                s += (v[j][0] + v[j][1]) + (v[j][2] + v[j][3]);
            }
            const float mean = wave_sum(s) * (1.f / DM); float s2 = 0.f;
#pragma unroll
            for (int j = 0; j < 4; ++j) { v[j] = v[j] - mean; s2 += (v[j][0] * v[j][0] + v[j][1] * v[j][1]) + (v[j][2] * v[j][2] + v[j][3] * v[j][3]); }
            const float rstd = rsqrtf(wave_sum(s2) * (1.f / DM) + LN_EPS);
#pragma unroll
            for (int j = 0; j < 4; ++j) *(f32x4*)(a.out + (size_t)row * DM + 4 * lane + 256 * j) = v[j] * rstd * gv[j] + bv[j];
        }
    }
}

__device__ __forceinline__ void moe_tables(const Args& a, LAS unsigned char* lds) {
    LAS int* cn = (LAS int*)(lds + MISC_OFF); LAS int* tp = cn + 32;
    const unsigned* ctl = (const unsigned*)(a.ws + WS_CTL);
    __syncthreads();
    if (threadIdx.x < 32) cn[threadIdx.x] = (int)__hip_atomic_load(ctl + CW_CNT + threadIdx.x, __ATOMIC_RELAXED, __HIP_MEMORY_SCOPE_AGENT);
    __syncthreads();
    if (threadIdx.x == 0) { int s = 0; for (int e = 0; e < 32; ++e) { tp[e] = s; s += (cn[e] + BM - 1) / BM; } tp[32] = s; }
    __syncthreads();
}

constexpr int NPHASES = 10;
__global__ void __launch_bounds__(NTHREADS, 2) mk_fwd(Args a) {
    extern __shared__ __attribute__((aligned(16))) unsigned char lds_raw[];
    LAS unsigned char* lds = (LAS unsigned char*)lds_raw;
    unsigned char* ws = a.ws;
    const int lo = a.ph_lo, hi = a.ph_hi;
    const int G = gridDim.x, bid = blockIdx.x;
#ifndef PHASE_MASK
#define PHASE_MASK 0x3ff
#endif
#define IN(k) (((PHASE_MASK >> (k)) & 1) && lo <= (k) && (k) < hi)
#if PROBE_PHASE >= 0
    unsigned long long t_lo = 0, t_hi = 0;
#define STAMP(k) do { if ((k) == PROBE_PHASE) t_lo = __builtin_amdgcn_s_memrealtime(); if ((k) == PROBE_PHASE + 1) t_hi = __builtin_amdgcn_s_memrealtime(); } while (0)
#else
#define STAMP(k) do { } while (0)
#endif
#if XCD_BARRIER
#define SEAM(k) do { if (IN(k) && IN((k) + 1) && a.coop) { if ((k) == 0) cg::this_grid().sync(); else xcd_barrier(xbar); } STAMP((k) + 1); } while (0)
#else
#define SEAM(k) do { if (IN(k) && IN((k) + 1) && a.coop) { cg::this_grid().sync(); } STAMP((k) + 1); } while (0)
#endif
    bf16_t* XB = (bf16_t*)(ws + WS_RA); bf16_t* MG = (bf16_t*)(ws + WS_RA); bf16_t* X1B = (bf16_t*)(ws + WS_RA);
    bf16_t* HB = (bf16_t*)(ws + WS_RB); bf16_t* Yb = (bf16_t*)(ws + WS_RB);
    bf16_t* AB = (bf16_t*)(ws + WS_RC); bf16_t* GB = (bf16_t*)(ws + WS_RD); bf16_t* HM = (bf16_t*)(ws + WS_RD);
    bf16_t* OH = (bf16_t*)(ws + WS_RE); bf16_t* OA = (bf16_t*)(ws + WS_RF);

    volatile LAS unsigned* xst = (volatile LAS unsigned*)(lds + LDS_BYTES - 16);
    if (threadIdx.x == 0) { xst[0] = 0u; xst[1] = 0u; }
    __syncthreads();
    XcdBarrier xbar; xbar.bar = (unsigned*)(ws + WS_CTL) + CW_BAR; xbar.x = 0; xbar.st = xst;
    if (a.coop) xbar = xcd_barrier_post((unsigned*)(ws + WS_CTL) + CW_BAR, xst);
    STAMP(0);
    if (IN(0)) { p0_prologue(a, lds); }
    SEAM(0);
    if (IN(1)) {
        DenseProb P; P.init(XB, ws + WS_WIN, T_, PW, DM, G, bid);
        EpiProj E{HB, AB, GB, (const float*)(ws + WS_LB)};
        gemm_phase<DenseProb, EpiProj>(lds, P, E);
    }
    SEAM(1);
    if (IN(2)) {
        if (bid >= 128) { __syncthreads(); p0_rest(a, lds, (bid - 128) * NWAVES + (int)(threadIdx.x >> 6), (G - 128) * NWAVES); }
#if HGRN_MFMA
        if (bid < 128) hgrn_mfma(lds, HB, a.in[3], OH, bid);
#else
        if (bid < 128) hgrn_naive(lds, HB, a.in[3], OH, bid);
#endif
        unsigned* ctl = (unsigned*)(ws + WS_CTL);
        LAS int* qi = (LAS int*)(lds + MISC_OFF + 1024);
#if ATTN_MFMA
        {
            __syncthreads();
            if (threadIdx.x == 0) { qi[0] = (int)atomicAdd(ctl + CW_ATTQ, 1u); qi[1] = (int)atomicAdd(ctl + CW_ATTQ, 1u); }
            __syncthreads();
            int item = qi[0], nitem = qi[1], par = 0;
            AttnStage stg;
            if (item < 1024) attn_stage_load(stg, AB, item);
            while (item < 1024) {
                if (threadIdx.x == 0) qi[2 + par] = (int)atomicAdd(ctl + CW_ATTQ, 1u);
                attn_mfma(lds, AB, a.in[4], OA, item, stg, nitem < 1024 ? nitem : -1);
                item = nitem; nitem = qi[2 + par]; par ^= 1;
            }
        }
#else
        for (;;) {
            __syncthreads();
            if (threadIdx.x == 0) qi[0] = (int)atomicAdd(ctl + CW_ATTQ, 1u);
            __syncthreads();
            const int item = qi[0];
            if (item >= 1024) break;
            attn_naive(lds, AB, a.in[4], OA, item);
        }
#endif
    }
    SEAM(2);
    if (IN(3)) {
        DenseProb P; P.init(OH, ws + WS_WA, T_, DM, 512, G, bid);
        EpiGate<0> E{MG, GB};
        gemm_phase<DenseProb, EpiGate<0>>(lds, P, E);
    }
    SEAM(3);
    if (IN(4)) {
        DenseProb P; P.init(OA, ws + WS_WB, T_, DM, 512, G, bid);
        EpiGate<1> E{MG, GB};
        gemm_phase<DenseProb, EpiGate<1>>(lds, P, E);
    }
    SEAM(4);
    if (IN(5)) {
        DenseProb P; P.init(MG, ws + WS_WO, T_, DM, DM, G, bid);
        EpiPre1 E{a.in[0], a.out};
        gemm_phase<DenseProb, EpiPre1>(lds, P, E);
    }
    SEAM(5);
#if ROUTER_MFMA
    if (IN(6)) { p5_ln_router_mfma(a, lds); }
#else
    if (IN(6)) { p5_ln_router(a, lds); }
#endif
    SEAM(6);
    if (IN(7)) {
        moe_tables(a, lds);
        MoeProb<true> P; P.Abase = (const char*)X1B; P.Bt = (const char*)(ws + WS_WGU); P.K = DM; P.G = G; P.c = bid;
        P.tp = (const LAS int*)(lds + MISC_OFF) + 32; P.cn = (const LAS int*)(lds + MISC_OFF); P.slot = (const int*)(ws + WS_SLOT); P.estride = (size_t)DM * DM * 2;
        EpiSwiGLU E{HM};
        gemm_phase<MoeProb<true>, EpiSwiGLU>(lds, P, E);
    }
    SEAM(7);
    if (IN(8)) {
        moe_tables(a, lds);
        MoeProb<false> P; P.Abase = (const char*)HM; P.Bt = (const char*)(ws + WS_WD); P.K = DE; P.G = G; P.c = bid;
        P.tp = (const LAS int*)(lds + MISC_OFF) + 32; P.cn = (const LAS int*)(lds + MISC_OFF); P.slot = (const int*)(ws + WS_SLOT); P.estride = (size_t)DM * DE * 2;
        EpiDown E{Yb};
        gemm_phase<MoeProb<false>, EpiDown>(lds, P, E);
    }
    SEAM(8);
    if (IN(9)) { moe_tables(a, lds); p7_final(a, (const LAS int*)(lds + MISC_OFF) + 32); }
#if PROBE_SECTION >= 0
    if (bid == 0 && threadIdx.x == 0) { const unsigned long long dt = *(LAS unsigned long long*)(lds + LDS_BYTES - 32);
        const unsigned long long target = __builtin_amdgcn_s_memrealtime() + (unsigned long long)PROBE_MULT * dt;
        while (__builtin_amdgcn_s_memrealtime() < target) __builtin_amdgcn_s_sleep(8); }
#endif
#if PROBE_PHASE >= 0
    STAMP(10);
    if (bid == 0 && threadIdx.x == 0) { const unsigned long long target = __builtin_amdgcn_s_memrealtime() + (unsigned long long)PROBE_MULT * (t_hi - t_lo);
        while (__builtin_amdgcn_s_memrealtime() < target) __builtin_amdgcn_s_sleep(8); }
#endif
#undef IN
#undef SEAM
}

extern "C" void kernel_launch(void* const* d_in, const int* in_sizes, int n_in, void* d_out, int out_size, void* d_ws, size_t ws_size, hipStream_t stream) {
    static int grid = 0;
    if (grid == 0) {
        if (n_in != 19 || out_size != T_ * DM || ws_size < WS_END) { fprintf(stderr, "kernel_launch: unexpected shapes (n_in %d out %d ws %zu)\n", n_in, out_size, ws_size); grid = -1; return; }
        int dev = 0, cus = 0, per_cu = 0;
        (void)hipGetDevice(&dev); (void)hipDeviceGetAttribute(&cus, hipDeviceAttributeMultiprocessorCount, dev);
        (void)hipFuncSetAttribute((const void*)mk_fwd, hipFuncAttributeMaxDynamicSharedMemorySize, LDS_BYTES);
        (void)hipOccupancyMaxActiveBlocksPerMultiprocessor(&per_cu, (const void*)mk_fwd, NTHREADS, LDS_BYTES);
        if (per_cu < 1) { fprintf(stderr, "kernel_launch: occupancy query says %d blocks/CU\n", per_cu); per_cu = 1; }
        (void)hipGetLastError();
        grid = cus * 1;
        fprintf(stderr, "kernel_launch: cus %d per_cu %d grid %d\n", cus, per_cu, grid);
    }
    if (grid < 0) return;
    (void)hipMemsetAsync((char*)d_ws + WS_CTL, 0, 65536, stream);
    Args a{};
    for (int i = 0; i < 19; ++i) a.in[i] = (const float*)d_in[i];
    a.out = (float*)d_out; a.ws = (unsigned char*)d_ws;
#if N_LAUNCH_MODE == 1
    a.ph_lo = 0; a.ph_hi = NPHASES; a.coop = 1;
    void* args[] = {&a};
    hipError_t e = hipLaunchCooperativeKernel((const void*)mk_fwd, dim3(grid), dim3(NTHREADS), args, LDS_BYTES, stream);
    if (e != hipSuccess) fprintf(stderr, "cooperative launch failed: %s (grid %d)\n", hipGetErrorString(e), grid);
#else
    for (int p = 0; p < NPHASES; ++p) {
        a.ph_lo = p; a.ph_hi = p + 1; a.coop = 0;
        hipLaunchKernelGGL(mk_fwd, dim3(grid), dim3(NTHREADS), LDS_BYTES, stream, a);
    }
#endif
}
```

```cpp
#include <hip/hip_runtime.h>
#include <hip/hip_cooperative_groups.h>
#include <cstdio>
#include <cstdint>
namespace cg = cooperative_groups;

#ifndef NAIVE_GEMM
#define NAIVE_GEMM 0
#endif
#ifndef ROUTER_MFMA
#define ROUTER_MFMA 1
#endif
#ifndef ATTN_MFMA
#define ATTN_MFMA 1
#endif
#ifndef HGRN_MFMA
#define HGRN_MFMA 1
#endif
#ifndef XCD_BARRIER
#define XCD_BARRIER 1
#endif
#ifndef N_LAUNCH_MODE
#define N_LAUNCH_MODE 1
#endif

#ifndef PROBE_PHASE
#define PROBE_PHASE -1
#endif
#ifndef PROBE_MULT
#define PROBE_MULT 4
#endif
#ifndef PROBE_SECTION
#define PROBE_SECTION -1
#endif
#define LAS __attribute__((address_space(3)))
typedef unsigned short bf16_t;
typedef short bf16x8 __attribute__((ext_vector_type(8)));
typedef float f32x4 __attribute__((ext_vector_type(4)));
typedef float f32x2 __attribute__((ext_vector_type(2)));
typedef unsigned u32x4 __attribute__((ext_vector_type(4)));
typedef unsigned u32x2 __attribute__((ext_vector_type(2)));

constexpr int T_ = 65536, DM = 1024, SEQ = 2048, NBATCH = 32;
constexpr int PW = 4864;
constexpr int NE = 32, DE = 512;
constexpr int CAP = 131072;
constexpr float DN_ALPHA = 1.189207115002721f;
constexpr float LN_EPS = 1e-5f, RMS_EPS = 1e-6f;
constexpr int NWAVES = 8, NTHREADS = 512;

constexpr size_t MiB = 1u << 20;
constexpr size_t WS_CTL = 0;
constexpr size_t WS_LB = 1 * MiB;
constexpr size_t WS_WIN = 2 * MiB;
constexpr size_t WS_WA = 12 * MiB;
constexpr size_t WS_WB = 13 * MiB;
constexpr size_t WS_WO = 14 * MiB;
constexpr size_t WS_WGU = 16 * MiB;
constexpr size_t WS_WD = 80 * MiB;
constexpr size_t WS_SLOT = 112 * MiB;
constexpr size_t WS_ASGW = 128 * MiB;
constexpr size_t WS_ASGEP = 129 * MiB;
constexpr size_t WS_RA = 132 * MiB;
constexpr size_t WS_RB = 260 * MiB;
constexpr size_t WS_RC = 516 * MiB;
constexpr size_t WS_RD = 612 * MiB;
constexpr size_t WS_RE = 868 * MiB;
constexpr size_t WS_RF = 932 * MiB;
constexpr size_t WS_END = 996 * MiB;
constexpr int CW_CNT = 64;
constexpr int CW_ATTQ = 128;
constexpr int CW_BAR = 4096;

constexpr int RING_BYTES = 131072;
constexpr int MISC_OFF = RING_BYTES;
constexpr int LDS_BYTES = 147456;

__device__ __forceinline__ float bf2f(bf16_t v) { return __uint_as_float((unsigned)v << 16); }
__device__ __forceinline__ unsigned f2bf(float f) { unsigned u = __float_as_uint(f); return (u + 0x7fffu + ((u >> 16) & 1u)) >> 16; }
typedef __bf16 hwbf16x2 __attribute__((ext_vector_type(2)));
__device__ __forceinline__ unsigned pk2(float lo, float hi) { f32x2 v = {lo, hi}; hwbf16x2 b = __builtin_convertvector(v, hwbf16x2); return __builtin_bit_cast(unsigned, b); }
__device__ __forceinline__ float bflo(unsigned w) { return __uint_as_float(w << 16); }
__device__ __forceinline__ float bfhi(unsigned w) { return __uint_as_float(w & 0xffff0000u); }
__device__ __forceinline__ float sigm(float x) { return __builtin_amdgcn_rcpf(1.f + __builtin_amdgcn_exp2f(x * -1.4426950408889634f)); }
__device__ __forceinline__ float silu(float x) { return x * sigm(x); }
__device__ __forceinline__ float wave_sum(float v) {
#pragma unroll
    for (int o = 1; o < 64; o <<= 1) v += __shfl_xor(v, o);
    return v;
}
__device__ __forceinline__ float wave_max(float v) {
#pragma unroll
    for (int o = 1; o < 64; o <<= 1) v = fmaxf(v, __shfl_xor(v, o));
    return v;
}
#define LDS_WAIT() asm volatile("s_waitcnt lgkmcnt(0)" ::: "memory")
#if PROBE_SECTION >= 0
#define SEC_DECL unsigned long long sec_t = 0, sec_acc = 0
#define SEC_MARK(id) do { const unsigned long long _n = __builtin_amdgcn_s_memrealtime(); if ((id) == PROBE_SECTION + 1) sec_acc += _n - sec_t; sec_t = _n; } while (0)
#define SEC_STORE(lds) do { if (blockIdx.x == 0 && threadIdx.x == 0) *(LAS unsigned long long*)((lds) + LDS_BYTES - 32) = sec_acc; } while (0)
#else
#define SEC_DECL do { } while (0)
#define SEC_MARK(id) do { } while (0)
#define SEC_STORE(lds) do { } while (0)
#endif

constexpr int BM = 256, BK = 64, HALF = 128, HTB = HALF * BK * 2, NXCD = 8, WGM = 8;
__host__ __device__ __forceinline__ int lds_byte(int r, int c) { const int st = (r >> 4) * 2 + (c >> 5), rr = r & 15, cc = c & 31, ob = rr * 64 + cc * 2; return st * 1024 + (ob ^ (((ob >> 9) & 1) << 5)); }
__host__ __device__ __forceinline__ void stage_rc(int b, int& R, int& C) { const int st = b / 1024, sb = b % 1024, swz = sb ^ (((sb >> 9) & 1) << 5); R = (st >> 1) * 16 + swz / 64; C = (st & 1) * 32 + (swz % 64) / 2; }
__host__ __device__ __forceinline__ int perm32(int rho) { const int n = rho >> 4, i = rho & 15; return 8 * (i >> 2) + 4 * n + (i & 3); }

struct Unit { int pm, pn, e, mt; };

struct DenseProb {
    const char* Abase; const char* Bt; int K; int nM, nN, nwg, G, c;
    __device__ __forceinline__ void init(const void* A, const void* B, int M, int N, int K_, int G_, int c_) { Abase = (const char*)A; Bt = (const char*)B; K = K_; nM = M / BM; nN = N / BM; nwg = nM * nN; G = G_; c = c_; }
    __device__ __forceinline__ bool next(int i, Unit& u) const {
        const long L = (long)i * G + c; if (L >= nwg) return false;
        int wgid = (int)L; { const int q = nwg / NXCD, r = nwg % NXCD, xcd = wgid % NXCD, off = wgid / NXCD; wgid = (xcd < r ? xcd * (q + 1) : r * (q + 1) + (xcd - r) * q) + off; }
        const int nig = WGM * nN, gid = wgid / nig, fm = gid * WGM, gsz = (nM - fm) < WGM ? (nM - fm) : WGM;
        u.pm = fm + ((wgid % nig) % gsz); u.pn = (wgid % nig) / gsz; u.e = 0; u.mt = 0; return true;
    }
    __device__ __forceinline__ unsigned a_rowoff(const Unit& u, int r) const { return (unsigned)(u.pm * BM + r) * (unsigned)K * 2u; }
    __device__ __forceinline__ const char* b_base(const Unit& u) const { return Bt + (size_t)u.pn * BM * K * 2; }
};

template <bool GATHER> struct MoeProb {
    const char* Abase; const char* Bt; int K; int G, c; const LAS int* tp; const LAS int* cn; const int* slot; size_t estride;
    __device__ __forceinline__ bool next(int i, Unit& u) const {
        const int L = i * G + c; const int total = tp[32] * 4; if (L >= total) return false;
        const int tau = L >> 2; int e = 0;
        for (int j = 1; j < 32; ++j) e = (tau >= tp[j]) ? j : e;
        u.pm = tau; u.pn = L & 3; u.e = __builtin_amdgcn_readfirstlane(e); u.mt = __builtin_amdgcn_readfirstlane(tau - tp[e]); return true;
    }
    __device__ __forceinline__ unsigned a_rowoff(const Unit& u, int r) const {
        if (GATHER) { const int s = u.mt * BM + r; const int asg = (s < cn[u.e]) ? slot[(size_t)u.e * CAP + s] : 0; return (unsigned)(asg >> 1) * (unsigned)K * 2u; }
        else return (unsigned)(u.pm * BM + r) * (unsigned)K * 2u;
    }
    __device__ __forceinline__ const char* b_base(const Unit& u) const { return Bt + (size_t)u.e * estride + (size_t)u.pn * BM * K * 2; }
};

struct EpiProj {
    static constexpr bool PERM = true;
    bf16_t* HB; bf16_t* AB; bf16_t* GB; const float* lb;
    template <int MODE> __device__ __forceinline__ void run(const f32x4 (&acc)[2][4][2], bf16_t* base, int ld, int row0, int col0, int lbcol) const {
#pragma unroll
        for (int bj = 0; bj < 2; ++bj) {
            float l8[8];
            if (MODE == 2) {
#pragma unroll
                for (int j = 0; j < 8; ++j) l8[j] = lb[lbcol + bj * HALF + j];
            }
#pragma unroll
            for (int m = 0; m < 4; ++m) {
                float v[8];
#pragma unroll
                for (int j = 0; j < 4; ++j) { v[j] = acc[bj][m][0][j]; v[4 + j] = acc[bj][m][1][j]; }
#pragma unroll
                for (int j = 0; j < 8; ++j) {
                    if (MODE == 1) v[j] = silu(v[j]);
                    else if (MODE == 2) v[j] = __logf(l8[j] + (1.f - l8[j]) * sigm(v[j]));
                    else if (MODE == 3) v[j] = v[j] * 0.18033688011112042f;
                    else if (MODE == 4) v[j] = sigm(v[j]);
                }
                u32x4 w; w.x = pk2(v[0], v[1]); w.y = pk2(v[2], v[3]); w.z = pk2(v[4], v[5]); w.w = pk2(v[6], v[7]);
                *(u32x4*)(base + (size_t)(row0 + m * 16) * ld + col0 + bj * HALF) = w;
            }
        }
    }
    __device__ __forceinline__ void operator()(const f32x4 (&acc)[2][4][2], int ai, const Unit& u, int wr, int wc, int fr, int fq) const {
        const int pn = u.pn, row0 = u.pm * BM + ai * HALF + wr * 64 + fr, colg = pn * BM + wc * 32 + 8 * fq;
        if (pn < 2) run<1>(acc, HB, 2048, row0, colg, 0);
        else if (pn < 4) run<2>(acc, HB, 2048, row0, colg, colg - 512);
        else if (pn < 6) run<0>(acc, HB, 2048, row0, colg, 0);
        else if (pn < 8) run<1>(acc, HB, 2048, row0, colg, 0);
        else if (pn < 10) run<3>(acc, AB, 768, row0, colg - 2048, 0);
        else if (pn < 11) run<0>(acc, AB, 768, row0, colg - 2048, 0);
        else run<0>(acc, GB, 2048, row0, colg - 2816, 0);
    }
};
template <int PASS> struct EpiGate {
    static constexpr bool PERM = true;
    bf16_t* MG; const bf16_t* GB;
    __device__ __forceinline__ void operator()(const f32x4 (&acc)[2][4][2], int ai, const Unit& u, int wr, int wc, int fr, int fq) const {
        const unsigned gbase = ((unsigned)(u.pm * BM + ai * HALF + wr * 64 + fr) * 2048u + (unsigned)(PASS * 1024 + u.pn * BM + wc * 32 + 8 * fq)) * 2u;
        const unsigned mbase = ((unsigned)(u.pm * BM + ai * HALF + wr * 64 + fr) * 1024u + (unsigned)(u.pn * BM + wc * 32 + 8 * fq)) * 2u;
#pragma unroll
        for (int mh = 0; mh < 2; ++mh) {
            u32x4 gt[2][2], pt[2][2];
#pragma unroll
            for (int mm = 0; mm < 2; ++mm)
#pragma unroll
                for (int bj = 0; bj < 2; ++bj) {
                    const int m = mh * 2 + mm;
                    gt[mm][bj] = *(const u32x4*)((const char*)GB + (gbase + (unsigned)((m * 16 * 2048 + bj * HALF) * 2)));
                    if (PASS == 1) pt[mm][bj] = *(const u32x4*)((const char*)MG + (mbase + (unsigned)((m * 16 * 1024 + bj * HALF) * 2)));
                }
#pragma unroll
            for (int mm = 0; mm < 2; ++mm)
#pragma unroll
                for (int bj = 0; bj < 2; ++bj) {
                    const int m = mh * 2 + mm; const u32x4 g = gt[mm][bj];
                    float v[8];
#pragma unroll
                    for (int j = 0; j < 4; ++j) { v[j] = acc[bj][m][0][j]; v[4 + j] = acc[bj][m][1][j]; }
                    v[0] *= sigm(bflo(g.x)); v[1] *= sigm(bfhi(g.x)); v[2] *= sigm(bflo(g.y)); v[3] *= sigm(bfhi(g.y)); v[4] *= sigm(bflo(g.z)); v[5] *= sigm(bfhi(g.z)); v[6] *= sigm(bflo(g.w)); v[7] *= sigm(bfhi(g.w));
                    if (PASS == 1) { const u32x4 p = pt[mm][bj];
                        v[0] += bflo(p.x); v[1] += bfhi(p.x); v[2] += bflo(p.y); v[3] += bfhi(p.y); v[4] += bflo(p.z); v[5] += bfhi(p.z); v[6] += bflo(p.w); v[7] += bfhi(p.w); }
                    u32x4 w; w.x = pk2(v[0], v[1]); w.y = pk2(v[2], v[3]); w.z = pk2(v[4], v[5]); w.w = pk2(v[6], v[7]);
                    *(u32x4*)((char*)MG + (mbase + (unsigned)((m * 16 * 1024 + bj * HALF) * 2))) = w;
                }
            asm volatile("" ::: "memory");
        }
    }
};
struct EpiPre1 {
    static constexpr bool PERM = false;
    const float* x; float* out;
    __device__ __forceinline__ void operator()(const f32x4 (&acc)[2][4][2], int ai, const Unit& u, int wr, int wc, int fr, int fq) const {
        const unsigned base = ((unsigned)(u.pm * BM + ai * HALF + wr * 64 + fr) * DM + (unsigned)(u.pn * BM + wc * 32 + 4 * fq)) * 4u;
#pragma unroll
        for (int mh = 0; mh < 2; ++mh) {
            f32x4 xv[2][2][2];
#pragma unroll
            for (int mm = 0; mm < 2; ++mm)
#pragma unroll
                for (int bj = 0; bj < 2; ++bj)
#pragma unroll
                    for (int n = 0; n < 2; ++n)
                        xv[mm][bj][n] = *(const f32x4*)((const char*)x + (base + (unsigned)((((mh * 2 + mm) * 16) * DM + bj * HALF + n * 16) * 4)));
#pragma unroll
            for (int mm = 0; mm < 2; ++mm)
#pragma unroll
                for (int bj = 0; bj < 2; ++bj)
#pragma unroll
                    for (int n = 0; n < 2; ++n)
                        *(f32x4*)((char*)out + (base + (unsigned)((((mh * 2 + mm) * 16) * DM + bj * HALF + n * 16) * 4))) = acc[bj][mh * 2 + mm][n] + xv[mm][bj][n] * DN_ALPHA;
            asm volatile("" ::: "memory");
        }
    }
};
struct EpiSwiGLU {
    static constexpr bool PERM = true;
    bf16_t* H;
    __device__ __forceinline__ void operator()(const f32x4 (&acc)[2][4][2], int ai, const Unit& u, int wr, int wc, int fr, int fq) const {
        const int row0 = u.pm * BM + ai * HALF + wr * 64 + fr, col0 = u.pn * 128 + wc * 16 + 4 * fq;
#pragma unroll
        for (int m = 0; m < 4; ++m)
#pragma unroll
            for (int bj = 0; bj < 2; ++bj) {
                const f32x4 g = acc[bj][m][0], up = acc[bj][m][1];
                u32x2 w; w.x = pk2(silu(g[0]) * up[0], silu(g[1]) * up[1]); w.y = pk2(silu(g[2]) * up[2], silu(g[3]) * up[3]);
                *(u32x2*)(H + (size_t)(row0 + m * 16) * DE + col0 + bj * 64) = w;
            }
    }
};
struct EpiDown {
    static constexpr bool PERM = true;
    bf16_t* Y;
    __device__ __forceinline__ void operator()(const f32x4 (&acc)[2][4][2], int ai, const Unit& u, int wr, int wc, int fr, int fq) const {
        const unsigned base = ((unsigned)(u.pm * BM + ai * HALF + wr * 64 + fr) * DM + (unsigned)(u.pn * BM + wc * 32 + 8 * fq)) * 2u;
#pragma unroll
        for (int m = 0; m < 4; ++m)
#pragma unroll
            for (int bj = 0; bj < 2; ++bj) {
                const f32x4 a = acc[bj][m][0], b = acc[bj][m][1];
                u32x4 o; o.x = pk2(a[0], a[1]); o.y = pk2(a[2], a[3]); o.z = pk2(b[0], b[1]); o.w = pk2(b[2], b[3]);
                *(u32x4*)((char*)Y + (base + (unsigned)((m * 16 * DM + bj * HALF) * 2))) = o;
            }
    }
};

template <class Prob, class Epi>
__device__ __forceinline__ void gemm_phase_naive(const Prob& P, const Epi& E) {
    const int tid = threadIdx.x, wid = tid >> 6, lane = tid & 63, wr = wid >> 2, wc = wid & 3, fr = lane & 15, fq = lane >> 4;
    const int K = P.K;
    Unit u;
    for (int i = 0; P.next(i, u); ++i) {
        const char* bB = P.b_base(u);
        for (int ai = 0; ai < 2; ++ai) {
            f32x4 acc[2][4][2];
#pragma unroll
            for (int b = 0; b < 2; ++b)
#pragma unroll
                for (int m = 0; m < 4; ++m)
#pragma unroll
                    for (int n = 0; n < 2; ++n) acc[b][m][n] = (f32x4){0.f, 0.f, 0.f, 0.f};
            unsigned ro[4];
#pragma unroll
            for (int m = 0; m < 4; ++m) ro[m] = P.a_rowoff(u, ai * HALF + wr * 64 + m * 16 + fr);
#pragma unroll 1
            for (int k = 0; k < K; k += 4) {
                u32x2 ap[4];
#pragma unroll
                for (int m = 0; m < 4; ++m) ap[m] = *(const u32x2*)(P.Abase + (ro[m] + (unsigned)k * 2u));
#pragma unroll
                for (int bj = 0; bj < 2; ++bj)
#pragma unroll
                    for (int n = 0; n < 2; ++n)
#pragma unroll
                        for (int j = 0; j < 4; ++j) {
                            const unsigned col = (unsigned)(bj * HALF + wc * 32 + (Epi::PERM ? (8 * fq + 4 * n + j) : (16 * n + 4 * fq + j)));
                            const u32x2 b = *(const u32x2*)(bB + (col * (unsigned)K + (unsigned)k) * 2u);
                            const float b0 = bflo(b.x), b1 = bfhi(b.x), b2 = bflo(b.y), b3 = bfhi(b.y);
#pragma unroll
                            for (int m = 0; m < 4; ++m) {
                                const u32x2 a = ap[m];
                                float s = acc[bj][m][n][j];
                                s = fmaf(bflo(a.x), b0, s); s = fmaf(bfhi(a.x), b1, s); s = fmaf(bflo(a.y), b2, s); s = fmaf(bfhi(a.y), b3, s);
                                acc[bj][m][n][j] = s;
                            }
                        }
                asm volatile("" ::: "memory");
            }
            E(acc, ai, u, wr, wc, fr, fq);
        }
    }
}

template <class Prob, class Epi, bool ALIGN_EPI, bool SP2>
__device__ __forceinline__ void gemm_phase_mfma(LAS unsigned char* lds, const Prob& P, const Epi& E) {
    const int tid = threadIdx.x, wid = __builtin_amdgcn_readfirstlane(tid >> 6), lane = tid & 63, wr = wid >> 2, wc = wid & 3, fr = lane & 15, fq = lane >> 4;
    const int K = P.K, nt = K / BK;
    int Ra[2]; unsigned Ca[2], voffB[2];
#pragma unroll
    for (int i = 0; i < 2; ++i) { int R, C; stage_rc(tid * 16 + i * 8192, R, C); const int Rb = Epi::PERM ? ((R & ~31) + perm32(R & 31)) : R;
        Ra[i] = R; Ca[i] = (unsigned)C * 2u; voffB[i] = (unsigned)(Rb * K + C) * 2u; }
    const size_t kstep = (size_t)(BK * 2);
    const size_t hstep = (size_t)HALF * K * 2;
    const unsigned ldsw = (unsigned)wid * 1024u;
    const int aoff = lds_byte(wr * 64 + fr, fq * 8), boff = lds_byte(wc * 32 + fr, fq * 8);
#define PG8_SA(b, h) (((b) * 2 + (h)) * HTB)
#define PG8_SB(b, h) ((4 + (b) * 2 + (h)) * HTB)
#define PG8_STAGEB(bufoff, gbase) do { _Pragma("unroll") for (int _i = 0; _i < 2; ++_i) \
        __builtin_amdgcn_global_load_lds((const unsigned*)((const char*)(gbase) + voffB[_i]), (LAS unsigned*)(lds + (bufoff) + ldsw + _i * 8192), 16, 0, 0); } while (0)
#define PG8_STAGEA(bufoff, gbase, v0, v1) do { \
        __builtin_amdgcn_global_load_lds((const unsigned*)((const char*)(gbase) + (v0)), (LAS unsigned*)(lds + (bufoff) + ldsw), 16, 0, 0); \
        __builtin_amdgcn_global_load_lds((const unsigned*)((const char*)(gbase) + (v1)), (LAS unsigned*)(lds + (bufoff) + ldsw + 8192), 16, 0, 0); } while (0)
#define PG8_LDA(dst, b, h) do { _Pragma("unroll") for (int m = 0; m < 4; ++m) _Pragma("unroll") for (int k = 0; k < 2; ++k) dst[m][k] = *(const LAS bf16x8*)(lds + PG8_SA(b, h) + aoff + m * 2048 + k * 1024); } while (0)
#define PG8_LDB(dst, b, h) do { _Pragma("unroll") for (int n = 0; n < 2; ++n) _Pragma("unroll") for (int k = 0; k < 2; ++k) dst[n][k] = *(const LAS bf16x8*)(lds + PG8_SB(b, h) + boff + n * 2048 + k * 1024); } while (0)
#define PG8_MMA(ai, bj, At, Bt) do { __builtin_amdgcn_s_setprio(1); _Pragma("unroll") for (int m = 0; m < 4; ++m) _Pragma("unroll") for (int n = 0; n < 2; ++n) _Pragma("unroll") for (int k = 0; k < 2; ++k) \
        acc[ai][bj][m][n] = __builtin_amdgcn_mfma_f32_16x16x32_bf16(Bt[n][k], At[m][k], acc[ai][bj][m][n], 0, 0, 0); __builtin_amdgcn_s_setprio(0); } while (0)
#define PG8_WAIT_V(n) asm volatile("s_waitcnt vmcnt(" #n ")" ::: "memory")
#define PG8_WAIT_L(n) asm volatile("s_waitcnt lgkmcnt(" #n ")" ::: "memory")
#define PG8_BAR __builtin_amdgcn_s_barrier()
#define PG8_SCHED __builtin_amdgcn_sched_barrier(0)
    Unit cur, nxt; int ui = 0;
    if (!P.next(0, cur)) return;
    f32x4 acc[2][2][4][2];
#pragma unroll
    for (int a = 0; a < 2; ++a)
#pragma unroll
        for (int b = 0; b < 2; ++b)
#pragma unroll
            for (int m = 0; m < 4; ++m)
#pragma unroll
                for (int n = 0; n < 2; ++n) acc[a][b][m][n] = (f32x4){0.f, 0.f, 0.f, 0.f};
    bf16x8 At[4][2], B0[2][2], B1[2][2];
    const char* const cA = P.Abase;
    const char* cB = P.b_base(cur);
    unsigned va0, va1, va2, va3;
    va0 = P.a_rowoff(cur, Ra[0]) + Ca[0]; va1 = P.a_rowoff(cur, Ra[1]) + Ca[1]; va2 = P.a_rowoff(cur, HALF + Ra[0]) + Ca[0]; va3 = P.a_rowoff(cur, HALF + Ra[1]) + Ca[1];
    if constexpr (SP2) {
        PG8_STAGEB(PG8_SB(0, 0), cB); PG8_STAGEB(PG8_SB(0, 1), cB + hstep); PG8_STAGEA(PG8_SA(0, 0), cA, va0, va1); PG8_STAGEA(PG8_SA(0, 1), cA, va2, va3);
        if (wr == 1) PG8_BAR;
        PG8_WAIT_V(2); PG8_BAR;
        PG8_STAGEB(PG8_SB(1, 0), cB + kstep); PG8_STAGEA(PG8_SA(1, 0), cA + kstep, va0, va1); PG8_STAGEB(PG8_SB(1, 1), cB + hstep + kstep);
        PG8_WAIT_V(6); PG8_BAR;
    } else {
        PG8_STAGEB(PG8_SB(0, 0), cB); PG8_STAGEA(PG8_SA(0, 0), cA, va0, va1); PG8_STAGEB(PG8_SB(0, 1), cB + hstep); PG8_STAGEA(PG8_SA(0, 1), cA, va2, va3);
        if (wr == 1) PG8_BAR;
        PG8_WAIT_V(4); PG8_BAR;
        PG8_STAGEB(PG8_SB(1, 0), cB + kstep); PG8_STAGEA(PG8_SA(1, 0), cA + kstep, va0, va1); PG8_STAGEB(PG8_SB(1, 1), cB + hstep + kstep);
        PG8_WAIT_V(6); PG8_BAR;
    }
    for (;;) {
        const bool has_next = P.next(ui + 1, nxt);
        unsigned vn0 = va0, vn1 = va1, vn2 = va2, vn3 = va3; const char* nB = cB;
        if (has_next) { nB = P.b_base(nxt);
            vn0 = P.a_rowoff(nxt, Ra[0]) + Ca[0]; vn1 = P.a_rowoff(nxt, Ra[1]) + Ca[1]; vn2 = P.a_rowoff(nxt, HALF + Ra[0]) + Ca[0]; vn3 = P.a_rowoff(nxt, HALF + Ra[1]) + Ca[1]; }
        for (int t = 0; t < nt; t += 2) {
            const bool last = (t == nt - 2);
            const char* a1 = cA + (size_t)(t + 1) * kstep;
            const char* a2 = last ? cA : cA + (size_t)(t + 2) * kstep; const char* b2 = last ? nB : cB + (size_t)(t + 2) * kstep;
            const char* a3 = a2 + kstep; const char* b3 = b2 + kstep;
            const unsigned w0 = last ? vn0 : va0, w1 = last ? vn1 : va1, w2 = last ? vn2 : va2, w3 = last ? vn3 : va3;
            if constexpr (SP2) {
            PG8_LDB(B0, 0, 0); PG8_LDB(B1, 0, 1); PG8_SCHED; PG8_LDA(At, 0, 0); PG8_STAGEA(PG8_SA(1, 1), a1, va2, va3);
            PG8_WAIT_V(8); PG8_WAIT_L(0); PG8_BAR; PG8_MMA(0, 0, At, B0); PG8_MMA(0, 1, At, B1); PG8_BAR; PG8_SCHED;
            PG8_LDA(At, 0, 1); PG8_STAGEB(PG8_SB(0, 0), b2); PG8_STAGEB(PG8_SB(0, 1), b2 + hstep); PG8_STAGEA(PG8_SA(0, 0), a2, w0, w1);
            PG8_WAIT_V(8); PG8_WAIT_L(0); PG8_BAR; PG8_MMA(1, 0, At, B0); PG8_MMA(1, 1, At, B1); PG8_BAR; PG8_SCHED;
            PG8_LDB(B0, 1, 0); PG8_LDB(B1, 1, 1); PG8_SCHED; PG8_LDA(At, 1, 0); PG8_STAGEA(PG8_SA(0, 1), a2, w2, w3);
            PG8_WAIT_V(8); PG8_WAIT_L(0); PG8_BAR; PG8_MMA(0, 0, At, B0); PG8_MMA(0, 1, At, B1); PG8_BAR; PG8_SCHED;
            PG8_LDA(At, 1, 1); PG8_STAGEB(PG8_SB(1, 0), b3); PG8_STAGEB(PG8_SB(1, 1), b3 + hstep); PG8_STAGEA(PG8_SA(1, 0), a3, w0, w1);
            PG8_WAIT_V(8); PG8_WAIT_L(0); PG8_BAR; PG8_MMA(1, 0, At, B0); PG8_MMA(1, 1, At, B1); PG8_BAR; PG8_SCHED;
            } else {
            PG8_LDB(B0, 0, 0); PG8_SCHED; PG8_LDA(At, 0, 0); PG8_STAGEA(PG8_SA(1, 1), a1, va2, va3);
            PG8_WAIT_L(8); PG8_BAR; PG8_WAIT_L(0); PG8_MMA(0, 0, At, B0); PG8_BAR; PG8_SCHED;
            PG8_LDB(B1, 0, 1); PG8_STAGEB(PG8_SB(0, 0), b2);
            PG8_BAR; PG8_WAIT_L(0); PG8_MMA(0, 1, At, B1); PG8_BAR;
            PG8_LDA(At, 0, 1); PG8_STAGEA(PG8_SA(0, 0), a2, w0, w1);
            PG8_BAR; PG8_WAIT_L(0); PG8_MMA(1, 0, At, B0); PG8_BAR; PG8_SCHED;
            PG8_STAGEB(PG8_SB(0, 1), b2 + hstep);
            PG8_WAIT_V(6); PG8_BAR; PG8_MMA(1, 1, At, B1); PG8_BAR;
            PG8_LDB(B0, 1, 0); PG8_SCHED; PG8_LDA(At, 1, 0); PG8_STAGEA(PG8_SA(0, 1), a2, w2, w3);
            PG8_WAIT_L(8); PG8_BAR; PG8_WAIT_L(0); PG8_MMA(0, 0, At, B0); PG8_BAR; PG8_SCHED;
            PG8_LDB(B1, 1, 1); PG8_STAGEB(PG8_SB(1, 0), b3);
            PG8_BAR; PG8_WAIT_L(0); PG8_MMA(0, 1, At, B1); PG8_BAR;
            PG8_LDA(At, 1, 1); PG8_STAGEA(PG8_SA(1, 0), a3, w0, w1);
            PG8_BAR; PG8_WAIT_L(0); PG8_MMA(1, 0, At, B0); PG8_BAR; PG8_SCHED;
            PG8_STAGEB(PG8_SB(1, 1), b3 + hstep);
            PG8_WAIT_V(6); PG8_BAR; PG8_MMA(1, 1, At, B1); PG8_BAR;
            }
        }
        if constexpr (ALIGN_EPI) { if (wr == 0) PG8_BAR; }
        E(acc[0], 0, cur, wr, wc, fr, fq); E(acc[1], 1, cur, wr, wc, fr, fq);
        if (!has_next) break;
#pragma unroll
        for (int a = 0; a < 2; ++a)
#pragma unroll
            for (int b = 0; b < 2; ++b)
#pragma unroll
                for (int m = 0; m < 4; ++m)
#pragma unroll
                    for (int n = 0; n < 2; ++n) acc[a][b][m][n] = (f32x4){0.f, 0.f, 0.f, 0.f};
        cur = nxt; cB = nB; va0 = vn0; va1 = vn1; va2 = vn2; va3 = vn3; ++ui;
        if constexpr (ALIGN_EPI) { if (wr == 1) PG8_BAR; }
    }
    PG8_WAIT_V(0);
    if constexpr (!ALIGN_EPI) { if (wr == 0) PG8_BAR; }
    PG8_BAR;
#undef PG8_SA
#undef PG8_SB
#undef PG8_STAGEA
#undef PG8_STAGEB
#undef PG8_LDA
#undef PG8_LDB
#undef PG8_MMA
#undef PG8_WAIT_V
#undef PG8_WAIT_L
#undef PG8_BAR
#undef PG8_SCHED
}

template <class Prob, class Epi>
__device__ __forceinline__ void gemm_phase(LAS unsigned char* lds, const Prob& P, const Epi& E) {
#if NAIVE_GEMM
    gemm_phase_naive<Prob, Epi>(P, E);
#else
    gemm_phase_mfma<Prob, Epi, true, true>(lds, P, E);
#endif
}

#define XB_TMO      128
#define XB_XCNT(j)  (256  + 64 * (j))
#define XB_XSUB(j)  (1280 + 64 * (j))
#define XB_XGEN(j)  (2304 + 64 * (j))
#define XB_TOP      3328
#define XB_TOPGEN   3392
#define XCD_BAR_WORDS 3456
#define XB_SPIN_CAP (1u << 18)
__device__ __forceinline__ unsigned xb_ld(unsigned* p)              { return __hip_atomic_load(p, __ATOMIC_RELAXED, __HIP_MEMORY_SCOPE_AGENT); }
__device__ __forceinline__ unsigned xb_add(unsigned* p, unsigned v) { return __hip_atomic_fetch_add(p, v, __ATOMIC_RELAXED, __HIP_MEMORY_SCOPE_AGENT); }
__device__ __forceinline__ unsigned xb_xcc_id() { return (unsigned)__builtin_amdgcn_s_getreg((3 << 11) | 20) & 0xFu; }
#define XB_SPIN(cond, bar) do { unsigned _sp = 0; while (cond) { __builtin_amdgcn_s_sleep(1); \
    if ((++_sp & 255u) == 0u) { if (xb_ld(&(bar)[XB_TMO])) break; if (_sp > XB_SPIN_CAP) { atomicAdd(&(bar)[XB_TMO], 1u); break; } } } } while (0)
struct XcdBarrier { unsigned* bar; unsigned x; volatile LAS unsigned* st; };
__device__ __forceinline__ XcdBarrier xcd_barrier_post(unsigned* bar, volatile LAS unsigned* st) {
    XcdBarrier b; b.bar = bar; b.x = xb_xcc_id(); b.st = st;
    if (threadIdx.x == 0) (void)xb_add(&bar[XB_XCNT(b.x)], 1u);
    return b;
}
__device__ __forceinline__ void xcd_barrier_complete(unsigned* bar, unsigned x, unsigned& nloc, unsigned& nx) {
    const unsigned G = gridDim.x * gridDim.y * gridDim.z;
    unsigned sum, cnt, mine, sp = 0u;
    for (;;) {
        sum = 0u; cnt = 0u; mine = 0u;
#pragma unroll
        for (unsigned j = 0; j < 16; ++j) { const unsigned c = xb_ld(&bar[XB_XCNT(j)]); sum += c; cnt += (c > 0u) ? 1u : 0u; mine = (j == x) ? c : mine; }
        if (sum == G) break;
        __builtin_amdgcn_s_sleep(1);
        if ((++sp & 255u) == 0u) { if (xb_ld(&bar[XB_TMO])) break; if (sp > XB_SPIN_CAP) { atomicAdd(&bar[XB_TMO], 1u); break; } }
    }
    nloc = mine > 0u ? mine : 1u; nx = cnt > 0u ? cnt : 1u;
}
__device__ __forceinline__ void xcd_barrier(const XcdBarrier& b) {
    asm volatile("s_waitcnt vmcnt(0)" ::: "memory");
    __syncthreads();
    if (threadIdx.x == 0) {
        unsigned* bar = b.bar;
        __builtin_amdgcn_s_waitcnt(0);
        unsigned nloc = b.st[0], nx = b.st[1];
        if (nloc == 0u) { xcd_barrier_complete(bar, b.x, nloc, nx); b.st[0] = nloc; b.st[1] = nx; }
        const unsigned old = xb_add(&bar[XB_XSUB(b.x)], 1u);
        const unsigned gen = old / nloc;
        if (old + 1u == (gen + 1u) * nloc) {
            __builtin_amdgcn_fence(__ATOMIC_RELEASE, "agent");
            asm volatile("s_waitcnt vmcnt(0)" ::: "memory");
            const unsigned og = xb_add(&bar[XB_TOP], 1u);
            const unsigned tg = og / nx;
            if (og + 1u == (tg + 1u) * nx) xb_add(&bar[XB_TOPGEN], 1u);
            else XB_SPIN(xb_ld(&bar[XB_TOPGEN]) == tg, bar);
            __builtin_amdgcn_fence(__ATOMIC_ACQUIRE, "agent");
            xb_add(&bar[XB_XGEN(b.x)], 1u);
            asm volatile("s_waitcnt vmcnt(0)" ::: "memory");
        } else {
            XB_SPIN(xb_ld(&bar[XB_XGEN(b.x)]) == gen, bar);
            __builtin_amdgcn_fence(__ATOMIC_ACQUIRE, "agent");
            asm volatile("s_waitcnt vmcnt(0)" ::: "memory");
        }
    }
    __syncthreads();
}

struct Args {
    const float* in[19]; float* out; unsigned char* ws; int ph_lo, ph_hi, coop, pad;
};

struct TDesc { const float* W; bf16_t* WT; int K, N, mode, item; };
__device__ __forceinline__ void t_load(const TDesc& d, f32x4 (&v)[8], int lane) {
    const int nblk = d.N / 32, kb = d.item / nblk, nb = d.item % nblk, k0 = 64 * kb, n0 = 32 * nb;
#pragma unroll
    for (int i = 0; i < 8; ++i) { const int idx = lane + 64 * i, kk = idx >> 3, n4 = idx & 7; v[i] = *(const f32x4*)(d.W + (size_t)(k0 + kk) * d.N + n0 + 4 * n4); }
}
__device__ __forceinline__ void t_finish(const TDesc& d, const f32x4 (&v)[8], LAS float* scr, int lane) {
    const int nblk = d.N / 32, kb = d.item / nblk, nb = d.item % nblk, k0 = 64 * kb, n0 = 32 * nb;
#pragma unroll
    for (int i = 0; i < 8; ++i) { const int idx = lane + 64 * i, kk = idx >> 3, n4 = idx & 7; LAS float* p = scr + kk * 33 + 4 * n4; p[0] = v[i][0]; p[1] = v[i][1]; p[2] = v[i][2]; p[3] = v[i][3]; }
    LDS_WAIT();
    const int c = lane & 7;
#pragma unroll
    for (int j = 0; j < 4; ++j) { const int n = (lane >> 3) + 8 * j; const LAS float* sp = scr + (8 * c) * 33 + n;
        u32x4 o; o.x = pk2(sp[0 * 33], sp[1 * 33]); o.y = pk2(sp[2 * 33], sp[3 * 33]); o.z = pk2(sp[4 * 33], sp[5 * 33]); o.w = pk2(sp[6 * 33], sp[7 * 33]);
        const int ng = n0 + n; const int row = (d.mode == 0) ? ng : ((ng >> 2) * 8 + (d.mode == 2 ? 4 : 0) + (ng & 3));
        *(u32x4*)(d.WT + (size_t)row * d.K + k0 + 8 * c) = o; }
    LDS_WAIT();
}
constexpr int TI_A = (512 / 64) * (DM / 32), TI_O = (DM / 64) * (DM / 32), TI_G = (DM / 64) * (DE / 32), TI_D = (DE / 64) * (DM / 32), TI_IN = (DM / 64) * (PW / 32);
constexpr int TI_REST = 2 * TI_A + TI_O + NE * (2 * TI_G + TI_D);
__device__ __forceinline__ TDesc t_decode_rest(const Args& a, int it) {
    unsigned char* ws = a.ws; TDesc d; int r = it;
    if (r < TI_A) { d = TDesc{a.in[5], (bf16_t*)(ws + WS_WA), 512, DM, 0, r}; return d; } r -= TI_A;
    if (r < TI_A) { d = TDesc{a.in[6], (bf16_t*)(ws + WS_WB), 512, DM, 0, r}; return d; } r -= TI_A;
    if (r < TI_O) { d = TDesc{a.in[7], (bf16_t*)(ws + WS_WO), DM, DM, 0, r}; return d; } r -= TI_O;
    const int e = r / (2 * TI_G + TI_D); r -= e * (2 * TI_G + TI_D);
    if (r < TI_G) { d = TDesc{a.in[14] + (size_t)e * DM * DE, (bf16_t*)(ws + WS_WGU) + (size_t)e * DM * DM, DM, DE, 1, r}; return d; } r -= TI_G;
    if (r < TI_G) { d = TDesc{a.in[15] + (size_t)e * DM * DE, (bf16_t*)(ws + WS_WGU) + (size_t)e * DM * DM, DM, DE, 2, r}; return d; } r -= TI_G;
    d = TDesc{a.in[16] + (size_t)e * DE * DM, (bf16_t*)(ws + WS_WD) + (size_t)e * DM * DE, DE, DM, 0, r}; return d;
}
__device__ __forceinline__ void p0_rest(const Args& a, LAS unsigned char* lds, int gw, int NGW) {
    const int tid = threadIdx.x, lane = tid & 63, wave = tid >> 6;
    LAS float* scr = (LAS float*)(lds + wave * 16384);
    f32x4 va[8], vb[8];
    int it = gw;
    if (it >= TI_REST) return;
    TDesc dc = t_decode_rest(a, it); t_load(dc, va, lane);
    for (;;) {
        const int itn = it + NGW; const bool more = itn < TI_REST;
        TDesc dn = dc; if (more) { dn = t_decode_rest(a, itn); t_load(dn, vb, lane); }
        t_finish(dc, va, scr, lane);
        if (!more) break;
        const int itn2 = itn + NGW; const bool more2 = itn2 < TI_REST;
        if (more2) { dc = t_decode_rest(a, itn2); t_load(dc, va, lane); }
        t_finish(dn, vb, scr, lane);
        if (!more2) break;
        it = itn2;
    }
}
__device__ __forceinline__ void p0_prologue(const Args& a, LAS unsigned char* lds) {
    const int tid = threadIdx.x, lane = tid & 63, wave = tid >> 6;
    unsigned char* ws = a.ws;
    LAS float* scr = (LAS float*)(lds + wave * 16384);
    const int gw = blockIdx.x * NWAVES + wave, NGW = gridDim.x * NWAVES;
    for (int it = gw; it < TI_IN; it += NGW) { TDesc d{a.in[2], (bf16_t*)(ws + WS_WIN), DM, PW, 0, it}; f32x4 v[8]; t_load(d, v, lane); t_finish(d, v, scr, lane); }
    {
        const f32x4* x4 = (const f32x4*)a.in[0]; u32x4* o = (u32x4*)(ws + WS_RA);
        const size_t n8 = (size_t)T_ * DM / 8, stride = (size_t)gridDim.x * NTHREADS;
        for (size_t i = (size_t)blockIdx.x * NTHREADS + tid; i < n8; i += 4 * stride) {
            f32x4 p[4], q[4];
#pragma unroll
            for (int j = 0; j < 4; ++j) { const size_t ii = i + j * stride; if (ii < n8) { p[j] = x4[2 * ii]; q[j] = x4[2 * ii + 1]; } }
#pragma unroll
            for (int j = 0; j < 4; ++j) { const size_t ii = i + j * stride; if (ii < n8) {
                u32x4 w; w.x = pk2(p[j][0], p[j][1]); w.y = pk2(p[j][2], p[j][3]); w.z = pk2(q[j][0], q[j][1]); w.w = pk2(q[j][2], q[j][3]);
                o[ii] = w; } }
        }
    }
    if (blockIdx.x == 0) {
        float* lb = (float*)(ws + WS_LB); const float* lg = a.in[1];
        lb[tid] = 1.f / (1.f + __expf(lg[512 + tid] - lg[tid]));
        unsigned* ctl = (unsigned*)(ws + WS_CTL);
        if (tid < 32) ctl[CW_CNT + tid] = 0u;
        if (tid == 32) ctl[CW_ATTQ] = 0u;
    }
}

__device__ __forceinline__ void hgrn_naive(LAS unsigned char* lds, const bf16_t* HB, const float* normw, bf16_t* OH, int item) {
    const int tid = threadIdx.x, lane = tid & 63, wave = tid >> 6, v = tid & 127, kg = tid >> 7;
    const int b = item >> 2, h = item & 3;
    LAS float* sq = (LAS float*)lds;
    LAS float* sf = sq + 64 * 128;
    LAS float* sv = sf + 64 * 128;
    LAS float* so = sv + 64 * 128;
    LAS float* sp = so + 64 * 128;
    float S[32];
#pragma unroll
    for (int i = 0; i < 32; ++i) S[i] = 0.f;
    for (int c = 0; c < 32; ++c) {
        const size_t row0 = (size_t)b * SEQ + c * 64;
        for (int i = 0; i < 16; ++i) { const int idx = tid + 512 * i, r = idx >> 7, col = idx & 127; const bf16_t* p = HB + (row0 + r) * 2048 + h * 128 + col;
            sq[idx] = bf2f(p[0]); sf[idx] = __expf(bf2f(p[512])); sv[idx] = bf2f(p[1024]); }
        __syncthreads();
        for (int t = 0; t < 64; ++t) {
            const float vt = sv[t * 128 + v]; float part = 0.f;
#pragma unroll
            for (int i = 0; i < 32; ++i) { const float f = sf[t * 128 + kg * 32 + i]; S[i] = f * S[i] + (1.f - f) * vt; part += sq[t * 128 + kg * 32 + i] * S[i]; }
            sp[((t & 1) * 4 + kg) * 128 + v] = part;
            __syncthreads();
            if (kg == 0) { const LAS float* q = sp + (t & 1) * 4 * 128 + v; so[t * 128 + v] = (q[0] + q[128]) + (q[256] + q[384]); }
        }
        __syncthreads();
        for (int tt = 0; tt < 8; ++tt) { const int t = wave * 8 + tt; const float o0 = so[t * 128 + lane], o1 = so[t * 128 + 64 + lane];
            const float ss = wave_sum(o0 * o0 + o1 * o1); const float rstd = rsqrtf(ss * (1.f / 128.f) + RMS_EPS);
            const bf16_t* g = HB + (row0 + t) * 2048 + 1536 + h * 128; bf16_t* o = OH + (row0 + t) * 512 + h * 128;
            o[lane] = (bf16_t)f2bf(o0 * rstd * normw[lane] * bf2f(g[lane])); o[64 + lane] = (bf16_t)f2bf(o1 * rstd * normw[64 + lane] * bf2f(g[64 + lane])); }
        __syncthreads();
    }
}

constexpr int HG_QS = 136, HG_TS = 72;
constexpr int HG_QT = 64 * HG_QS + 8 * 16;
#define HQ(t) ((t) * HG_QS + ((t) >> 3) * 16)
__device__ __forceinline__ void hgrn_mfma(LAS unsigned char* lds, const bf16_t* HB, const float* normw, bf16_t* OH, int item) {
    const int tid = threadIdx.x, lane = tid & 63, wave = __builtin_amdgcn_readfirstlane(tid >> 6), r16 = lane & 15, g = lane >> 4;
    const int b = item >> 2, h = item & 3;
    const int cpi = lane & 7, rg = lane >> 3;
    const int k0 = 16 * wave + 2 * cpi;
    LAS bf16_t* Qp = (LAS bf16_t*)lds;
    LAS bf16_t* Kp = Qp + HG_QT;
    LAS bf16_t* KppT = Kp + HG_QT;
    LAS bf16_t* VT = KppT + 128 * HG_TS;
    LAS bf16_t* Pm = VT + 128 * HG_TS;
    LAS bf16_t* Gs0 = Pm + 64 * HG_TS;
    LAS float* dl = (LAS float*)(Gs0 + 2 * HG_QT);
    LAS float* rs = dl + 128;
    SEC_DECL;
    f32x4 st[8];
#pragma unroll
    for (int kt = 0; kt < 8; ++kt) st[kt] = (f32x4){0.f, 0.f, 0.f, 0.f};
    const f32x4 nw4 = *(const f32x4*)(normw + 16 * wave + 4 * g);
    unsigned rqA[8], rfA[8], rvA[8], rgA[8], rqB[8], rfB[8], rvB[8], rgB[8];
    {
        const unsigned* p32 = (const unsigned*)(HB + ((size_t)b * SEQ + 8 * rg) * 2048 + h * 128 + k0);
#pragma unroll
        for (int i = 0; i < 8; ++i) { rqA[i] = p32[(size_t)i * 1024]; rfA[i] = p32[(size_t)i * 1024 + 256]; rvA[i] = p32[(size_t)i * 1024 + 512]; rgA[i] = p32[(size_t)i * 1024 + 768]; }
        p32 += (size_t)64 * 1024;
#pragma unroll
        for (int i = 0; i < 8; ++i) { rqB[i] = p32[(size_t)i * 1024]; rfB[i] = p32[(size_t)i * 1024 + 256]; rvB[i] = p32[(size_t)i * 1024 + 512]; rgB[i] = p32[(size_t)i * 1024 + 768]; }
    }
    __syncthreads();
#define HG_BODY(cc, rq, rf, rv, rg_) do { const int c = (cc); \
        const size_t row0 = (size_t)b * SEQ + c * 64; \
        LAS bf16_t* Gs = Gs0 + (c & 1) * HG_QT; \
        SEC_MARK(0); \
        { \
            float f0[8], f1[8], c0[8], c1[8]; float run0 = 1.f, run1 = 1.f; \
_Pragma("unroll") \
            for (int i = 0; i < 8; ++i) { f0[i] = __builtin_amdgcn_exp2f(bflo(rf[i]) * 1.4426950408889634f); f1[i] = __builtin_amdgcn_exp2f(bfhi(rf[i]) * 1.4426950408889634f); run0 *= f0[i]; run1 *= f1[i]; c0[i] = run0; c1[i] = run1; } \
            float inc0 = run0, inc1 = run1; \
_Pragma("unroll") \
            for (int d = 8; d < 64; d <<= 1) { const float y0 = __shfl_up(inc0, d), y1 = __shfl_up(inc1, d); if (lane >= d) { inc0 *= y0; inc1 *= y1; } } \
            float off0 = __shfl_up(inc0, 8), off1 = __shfl_up(inc1, 8); if (rg == 0) { off0 = 1.f; off1 = 1.f; } \
            const float dl0 = __shfl(inc0, 56 + cpi), dl1 = __shfl(inc1, 56 + cpi); \
            if (rg == 0) *(LAS f32x2*)(dl + k0) = (f32x2){dl0, dl1}; \
            float kq0[8], kq1[8]; \
_Pragma("unroll") \
            for (int i = 0; i < 8; ++i) { \
                const float eb0 = off0 * c0[i], eb1 = off1 * c1[i], rb0 = __builtin_amdgcn_rcpf(eb0), rb1 = __builtin_amdgcn_rcpf(eb1); \
                const float kp0 = (1.f - f0[i]) * rb0, kp1 = (1.f - f1[i]) * rb1; \
                const int t = 8 * rg + i; \
                *(LAS unsigned*)(Qp + HQ(t) + k0) = pk2(bflo(rq[i]) * eb0, bfhi(rq[i]) * eb1); \
                *(LAS unsigned*)(Kp + HQ(t) + k0) = pk2(kp0, kp1); \
                *(LAS unsigned*)(Gs + HQ(t) + k0) = rg_[i]; \
                kq0[i] = kp0 * dl0; kq1[i] = kp1 * dl1; \
            } \
            u32x4 w0; \
            w0.x = pk2(kq0[0], kq0[1]); w0.y = pk2(kq0[2], kq0[3]); w0.z = pk2(kq0[4], kq0[5]); w0.w = pk2(kq0[6], kq0[7]); \
            *(LAS u32x4*)(KppT + k0 * HG_TS + 8 * rg) = w0; \
            w0.x = pk2(kq1[0], kq1[1]); w0.y = pk2(kq1[2], kq1[3]); w0.z = pk2(kq1[4], kq1[5]); w0.w = pk2(kq1[6], kq1[7]); \
            *(LAS u32x4*)(KppT + (k0 + 1) * HG_TS + 8 * rg) = w0; \
            w0.x = (rv[0] & 0xffffu) | (rv[1] << 16); w0.y = (rv[2] & 0xffffu) | (rv[3] << 16); w0.z = (rv[4] & 0xffffu) | (rv[5] << 16); w0.w = (rv[6] & 0xffffu) | (rv[7] << 16); \
            *(LAS u32x4*)(VT + k0 * HG_TS + 8 * rg) = w0; \
            w0.x = (rv[0] >> 16) | (rv[1] & 0xffff0000u); w0.y = (rv[2] >> 16) | (rv[3] & 0xffff0000u); w0.z = (rv[4] >> 16) | (rv[5] & 0xffff0000u); w0.w = (rv[6] >> 16) | (rv[7] & 0xffff0000u); \
            *(LAS u32x4*)(VT + (k0 + 1) * HG_TS + 8 * rg) = w0; \
            if (c + 2 < 32) {                                                \
                const unsigned* p32 = (const unsigned*)(HB + (row0 + 128 + 8 * rg) * 2048 + h * 128 + k0); \
_Pragma("unroll") \
                for (int i = 0; i < 8; ++i) { rq[i] = p32[(size_t)i * 1024]; rf[i] = p32[(size_t)i * 1024 + 256]; rv[i] = p32[(size_t)i * 1024 + 512]; rg_[i] = p32[(size_t)i * 1024 + 768]; } \
            } \
        } \
        SEC_MARK(1); \
        __syncthreads(); \
        SEC_MARK(2); \
_Pragma("unroll") \
        for (int u = 0; u < 2; ++u) { \
            const int ti = 2 * wave + u, sti = ti >> 2, tti = ti & 3; \
            f32x4 d = (f32x4){0.f, 0.f, 0.f, 0.f}; \
            if (sti <= tti) { \
_Pragma("unroll") \
                for (int ks = 0; ks < 4; ++ks) { \
                    const bf16x8 ka = *(const LAS bf16x8*)(Kp + HQ(16 * sti + r16) + 32 * ks + 8 * g); \
                    const bf16x8 qb = *(const LAS bf16x8*)(Qp + HQ(16 * tti + r16) + 32 * ks + 8 * g); \
                    d = __builtin_amdgcn_mfma_f32_16x16x32_bf16(ka, qb, d, 0, 0, 0); \
                } \
            } \
            const int t = 16 * tti + r16, s0 = 16 * sti + 4 * g; \
            float pv[4]; \
_Pragma("unroll") \
            for (int r = 0; r < 4; ++r) pv[r] = (sti <= tti && s0 + r <= t) ? d[r] : 0.f; \
            u32x2 w; w.x = pk2(pv[0], pv[1]); w.y = pk2(pv[2], pv[3]); \
            *(LAS u32x2*)(Pm + t * HG_TS + s0) = w; \
        } \
        SEC_MARK(3); \
        __syncthreads(); \
        SEC_MARK(4); \
        bf16x8 vtf[2], sa[4]; \
_Pragma("unroll") \
        for (int ks = 0; ks < 2; ++ks) vtf[ks] = *(const LAS bf16x8*)(VT + (16 * wave + r16) * HG_TS + 32 * ks + 8 * g); \
_Pragma("unroll") \
        for (int q = 0; q < 4; ++q) { u32x4 w; w.x = pk2(st[2 * q][0], st[2 * q][1]); w.y = pk2(st[2 * q][2], st[2 * q][3]); w.z = pk2(st[2 * q + 1][0], st[2 * q + 1][1]); w.w = pk2(st[2 * q + 1][2], st[2 * q + 1][3]); \
            sa[q] = __builtin_bit_cast(bf16x8, w); } \
        f32x4 o[4]; \
_Pragma("unroll") \
        for (int tt = 0; tt < 4; ++tt) { \
            f32x4 d = (f32x4){0.f, 0.f, 0.f, 0.f}; \
            const int t = 16 * tt + r16; \
_Pragma("unroll") \
            for (int ks = 0; ks < 2; ++ks) { \
                const bf16x8 pb = *(const LAS bf16x8*)(Pm + t * HG_TS + 32 * ks + 8 * g); \
                d = __builtin_amdgcn_mfma_f32_16x16x32_bf16(vtf[ks], pb, d, 0, 0, 0); \
            } \
_Pragma("unroll") \
            for (int q = 0; q < 4; ++q) { \
                const u32x2 lo = *(const LAS u32x2*)(Qp + HQ(t) + 32 * q + 4 * g), hi = *(const LAS u32x2*)(Qp + HQ(t) + 32 * q + 16 + 4 * g); \
                u32x4 w; w.x = lo.x; w.y = lo.y; w.z = hi.x; w.w = hi.y; \
                d = __builtin_amdgcn_mfma_f32_16x16x32_bf16(sa[q], __builtin_bit_cast(bf16x8, w), d, 0, 0, 0); \
            } \
            o[tt] = d; \
            float ss = d[0] * d[0] + d[1] * d[1] + d[2] * d[2] + d[3] * d[3]; \
            ss += __shfl_xor(ss, 16); ss += __shfl_xor(ss, 32); \
            if (g == 0) rs[t * 8 + wave] = ss; \
        } \
_Pragma("unroll") \
        for (int kt = 0; kt < 8; ++kt) { \
            const f32x4 d4 = *(const LAS f32x4*)(dl + 16 * kt + 4 * g); \
            f32x4 d = st[kt] * d4; \
_Pragma("unroll") \
            for (int ks = 0; ks < 2; ++ks) { \
                const bf16x8 ka = *(const LAS bf16x8*)(KppT + (16 * kt + r16) * HG_TS + 32 * ks + 8 * g); \
                d = __builtin_amdgcn_mfma_f32_16x16x32_bf16(ka, vtf[ks], d, 0, 0, 0); \
            } \
            st[kt] = d; \
        } \
        SEC_MARK(5); \
        __syncthreads(); \
        SEC_MARK(6); \
_Pragma("unroll") \
        for (int tt = 0; tt < 4; ++tt) { \
            const int t = 16 * tt + r16; \
            const f32x4 a0 = *(const LAS f32x4*)(rs + t * 8), a1 = *(const LAS f32x4*)(rs + t * 8 + 4); \
            const float tot = ((a0[0] + a0[1]) + (a0[2] + a0[3])) + ((a1[0] + a1[1]) + (a1[2] + a1[3])); \
            const float rstd = rsqrtf(tot * (1.f / 128.f) + RMS_EPS); \
            const u32x2 gg = *(const LAS u32x2*)(Gs + HQ(t) + 16 * wave + 4 * g); \
            u32x2 w; w.x = pk2(o[tt][0] * rstd * nw4[0] * bflo(gg.x), o[tt][1] * rstd * nw4[1] * bfhi(gg.x)); w.y = pk2(o[tt][2] * rstd * nw4[2] * bflo(gg.y), o[tt][3] * rstd * nw4[3] * bfhi(gg.y)); \
            *(u32x2*)(OH + (row0 + t) * 512 + h * 128 + 16 * wave + 4 * g) = w; \
        } \
        SEC_MARK(7); \
          \
    } while (0)
    for (int c2 = 0; c2 < 32; c2 += 2) { HG_BODY(c2, rqA, rfA, rvA, rgA); HG_BODY(c2 + 1, rqB, rfB, rvB, rgB); }
#undef HG_BODY
    SEC_STORE(lds);
}

__device__ __forceinline__ void attn_naive(LAS unsigned char* lds, const bf16_t* AB, const float* sinks, bf16_t* OA, int item) {
    const int tid = threadIdx.x, lane = tid & 63, wave = tid >> 6;
    const int hk = item & 1, n = (item >> 1) & 15, b = item >> 5;
    LAS bf16_t* Ks = (LAS bf16_t*)lds;
    LAS bf16_t* Vs = Ks + 256 * 64;
    LAS float* qs = (LAS float*)(lds + 65536) + wave * 192;
    LAS float* ps = qs + 64;
    __syncthreads();
    for (int i = 0; i < 8; ++i) { const int ch = tid + 512 * i; const int kv = ch >> 11, rr = (ch >> 3) & 255, c8 = ch & 7; const int kp = n * 128 - 128 + rr;
        u32x4 val = (u32x4){0u, 0u, 0u, 0u};
        if (kp >= 0) val = *(const u32x4*)(AB + ((size_t)b * SEQ + kp) * 768 + 512 + kv * 128 + hk * 64 + c8 * 8);
        *(LAS u32x4*)((kv ? Vs : Ks) + rr * 64 + c8 * 8) = val; }
    __syncthreads();
    const int g = wave >> 1, head = hk * 4 + g; const float slope = exp2f(-(float)(head + 1)); const float sink = sinks[head];
    for (int ii = 0; ii < 64; ++ii) {
        const int i = (wave & 1) * 64 + ii; const size_t row = (size_t)b * SEQ + n * 128 + i;
        qs[lane] = bf2f(AB[row * 768 + head * 64 + lane]) * 0.6931471805599453f;
        LDS_WAIT();
        float s0 = 0.f, s1 = 0.f; const int j0 = i + 1 + lane, j1 = i + 65 + lane;
#pragma unroll
        for (int d8 = 0; d8 < 8; ++d8) {
            const u32x4 k0 = *(const LAS u32x4*)(Ks + j0 * 64 + d8 * 8), k1 = *(const LAS u32x4*)(Ks + j1 * 64 + d8 * 8);
            const f32x4 qa = *(const LAS f32x4*)(qs + d8 * 8), qb = *(const LAS f32x4*)(qs + d8 * 8 + 4);
            s0 += qa[0] * bflo(k0.x) + qa[1] * bfhi(k0.x) + qa[2] * bflo(k0.y) + qa[3] * bfhi(k0.y) + qb[0] * bflo(k0.z) + qb[1] * bfhi(k0.z) + qb[2] * bflo(k0.w) + qb[3] * bfhi(k0.w);
            s1 += qa[0] * bflo(k1.x) + qa[1] * bfhi(k1.x) + qa[2] * bflo(k1.y) + qa[3] * bfhi(k1.y) + qb[0] * bflo(k1.z) + qb[1] * bfhi(k1.z) + qb[2] * bflo(k1.w) + qb[3] * bfhi(k1.w);
        }
        const bool v0 = (n * 128 - 128 + j0) >= 0, v1 = (n * 128 - 128 + j1) >= 0;
        const float l0 = v0 ? s0 - slope * (float)(127 - lane) : -1e30f, l1 = v1 ? s1 - slope * (float)(63 - lane) : -1e30f;
        const float mx = fmaxf(wave_max(fmaxf(l0, l1)), sink);
        const float e0 = __expf(l0 - mx), e1 = __expf(l1 - mx);
        const float den = wave_sum(e0 + e1) + __expf(sink - mx); const float inv = 1.f / den;
        ps[lane] = e0 * inv; ps[64 + lane] = e1 * inv;
        LDS_WAIT();
        float o = 0.f;
#pragma unroll 8
        for (int jj = 0; jj < 128; ++jj) o += ps[jj] * bf2f(Vs[(i + 1 + jj) * 64 + lane]);
        OA[row * 512 + head * 64 + lane] = (bf16_t)f2bf(o);
        LDS_WAIT();
    }
}

constexpr int ATT_KS = 72, ATT_VS = 280;
struct AttnStage { u32x4 kv[4], vv[4]; };
__device__ __forceinline__ void attn_stage_load(AttnStage& st, const bf16_t* AB, int item) {
    const int tid = threadIdx.x; const int hk = item & 1, n = (item >> 1) & 15, b = item >> 5;
#pragma unroll
    for (int i = 0; i < 4; ++i) { const int ch = tid + 512 * i, rr = ch >> 3, c8 = ch & 7; const int kp = n * 128 - 128 + rr;
        st.kv[i] = (u32x4){0u, 0u, 0u, 0u}; st.vv[i] = (u32x4){0u, 0u, 0u, 0u};
        if (kp >= 0) { const bf16_t* p = AB + ((size_t)b * SEQ + kp) * 768 + 512 + hk * 64 + c8 * 8; st.kv[i] = *(const u32x4*)p; st.vv[i] = *(const u32x4*)(p + 128); } }
}
__device__ __forceinline__ void attn_mfma(LAS unsigned char* lds, const bf16_t* AB, const float* sinks, bf16_t* OA, int item, AttnStage& st, int nitem) {
    const int tid = threadIdx.x, lane = tid & 63, wave = __builtin_amdgcn_readfirstlane(tid >> 6), r16 = lane & 15, g = lane >> 4;
    const int hk = item & 1, n = (item >> 1) & 15, b = item >> 5;
    LAS bf16_t* Ks = (LAS bf16_t*)lds;
    LAS bf16_t* VT = Ks + 256 * ATT_KS;
    __syncthreads();
#pragma unroll
    for (int i = 0; i < 4; ++i) { const int ch = tid + 512 * i, rr = ch >> 3, c8 = ch & 7;
        const u32x4 kv = st.kv[i], vv = st.vv[i];
        *(LAS u32x4*)(Ks + rr * ATT_KS + c8 * 8) = kv;
        LAS bf16_t* vt = VT + (c8 * 8) * ATT_VS + rr;
        vt[0 * ATT_VS] = (bf16_t)(vv.x & 0xffffu); vt[1 * ATT_VS] = (bf16_t)(vv.x >> 16); vt[2 * ATT_VS] = (bf16_t)(vv.y & 0xffffu); vt[3 * ATT_VS] = (bf16_t)(vv.y >> 16);
        vt[4 * ATT_VS] = (bf16_t)(vv.z & 0xffffu); vt[5 * ATT_VS] = (bf16_t)(vv.z >> 16); vt[6 * ATT_VS] = (bf16_t)(vv.w & 0xffffu); vt[7 * ATT_VS] = (bf16_t)(vv.w >> 16); }
    *(LAS unsigned*)(VT + (tid >> 3) * ATT_VS + 256 + (tid & 7) * 2) = 0u;
    if (nitem >= 0) attn_stage_load(st, AB, nitem);
    __syncthreads();
    const int g4 = wave >> 1, qh = wave & 1, head = hk * 4 + g4;
    const float L2E = 1.4426950408889634f;
    const float slope = exp2f(-(float)(head + 1)) * L2E, sink = sinks[head] * L2E;
    const float c0 = slope * (float)(128 + r16 - 4 * g);
    bf16x8 QF[4][2];
#pragma unroll
    for (int qt = 0; qt < 4; ++qt) { const size_t qr = (size_t)b * SEQ + n * 128 + qh * 64 + qt * 16 + r16;
        QF[qt][0] = *(const bf16x8*)(AB + qr * 768 + head * 64 + 8 * g); QF[qt][1] = *(const bf16x8*)(AB + qr * 768 + head * 64 + 32 + 8 * g); }
#pragma unroll
    for (int qt = 0; qt < 4; ++qt) {
        const int q0 = qh * 64 + qt * 16;
        const size_t qrow = (size_t)b * SEQ + n * 128 + q0 + r16;
        const bf16x8 Q0 = QF[qt][0], Q1 = QF[qt][1];
        f32x4 sc[9];
#pragma unroll
        for (int t9 = 0; t9 < 9; ++t9) {
            const LAS bf16_t* kp = Ks + (q0 + t9 * 16 + r16) * ATT_KS + 8 * g;
            const bf16x8 K0 = *(const LAS bf16x8*)kp, K1 = *(const LAS bf16x8*)(kp + 32);
            f32x4 z;
#pragma unroll
            for (int r = 0; r < 4; ++r) z[r] = fmaf(slope, (float)(16 * t9 + r), -c0);
            z = __builtin_amdgcn_mfma_f32_16x16x32_bf16(K0, Q0, z, 0, 0, 0);
            sc[t9] = __builtin_amdgcn_mfma_f32_16x16x32_bf16(K1, Q1, z, 0, 0, 0);
        }
        { const int d0 = r16 - 4 * g;
#pragma unroll
          for (int r = 0; r < 4; ++r) { if (d0 - r >= 0) sc[0][r] = -1e30f; if (d0 - r < 0) sc[8][r] = -1e30f; } }
        if (n == 0) {
#pragma unroll
            for (int t9 = 0; t9 < 9; ++t9)
#pragma unroll
                for (int r = 0; r < 4; ++r) if (q0 + 16 * t9 + 4 * g + r < 128) sc[t9][r] = -1e30f;
        }
        float mx = sink;
#pragma unroll
        for (int t9 = 0; t9 < 9; ++t9)
#pragma unroll
            for (int r = 0; r < 4; ++r) mx = fmaxf(mx, sc[t9][r]);
        mx = fmaxf(mx, __shfl_xor(mx, 16)); mx = fmaxf(mx, __shfl_xor(mx, 32));
        float sum = 0.f;
#pragma unroll
        for (int t9 = 0; t9 < 9; ++t9)
#pragma unroll
            for (int r = 0; r < 4; ++r) { const float e = __builtin_amdgcn_exp2f(sc[t9][r] - mx); sc[t9][r] = e; sum += e; }
        sum += __shfl_xor(sum, 16); sum += __shfl_xor(sum, 32);
        const float inv = __builtin_amdgcn_rcpf(sum + __builtin_amdgcn_exp2f(sink - mx));
        bf16x8 PB[5];
#pragma unroll
        for (int sl = 0; sl < 5; ++sl) {
            u32x4 w; w.x = pk2(sc[2 * sl][0], sc[2 * sl][1]); w.y = pk2(sc[2 * sl][2], sc[2 * sl][3]);
            if (sl < 4) { w.z = pk2(sc[2 * sl + 1][0], sc[2 * sl + 1][1]); w.w = pk2(sc[2 * sl + 1][2], sc[2 * sl + 1][3]); } else { w.z = 0u; w.w = 0u; }
            PB[sl] = __builtin_bit_cast(bf16x8, w);
        }
        f32x4 o[4];
#pragma unroll
        for (int dt = 0; dt < 4; ++dt) {
            o[dt] = (f32x4){0.f, 0.f, 0.f, 0.f};
#pragma unroll
            for (int sl = 0; sl < 5; ++sl) {
                const LAS bf16_t* vp = VT + (dt * 16 + r16) * ATT_VS + q0 + 32 * sl + 4 * g;
                const u32x2 lo = *(const LAS u32x2*)vp, hi = *(const LAS u32x2*)(vp + 16);
                u32x4 a; a.x = lo.x; a.y = lo.y; a.z = hi.x; a.w = hi.y;
                o[dt] = __builtin_amdgcn_mfma_f32_16x16x32_bf16(__builtin_bit_cast(bf16x8, a), PB[sl], o[dt], 0, 0, 0);
            }
        }
#pragma unroll
        for (int dt = 0; dt < 4; ++dt) { u32x2 w; w.x = pk2(o[dt][0] * inv, o[dt][1] * inv); w.y = pk2(o[dt][2] * inv, o[dt][3] * inv);
            *(u32x2*)(OA + qrow * 512 + head * 64 + dt * 16 + 4 * g) = w; }
        __builtin_amdgcn_sched_barrier(0);
    }
}

__device__ __forceinline__ void p5_ln_router(const Args& a, LAS unsigned char* lds) {
    const int tid = threadIdx.x, lane = tid & 63, wave = tid >> 6;
    unsigned char* ws = a.ws;
    const float* pre1 = a.out; bf16_t* X1B = (bf16_t*)(ws + WS_RA);
    const float* g1 = a.in[8]; const float* b1 = a.in[9];
    const float* rgw = a.in[10]; const float* rgb = a.in[11]; const float* rew = a.in[12]; const float* reb = a.in[13];
    unsigned* ctl = (unsigned*)(ws + WS_CTL); int* slot = (int*)(ws + WS_SLOT); float* asgw = (float*)(ws + WS_ASGW);
    LAS int* hist = (LAS int*)(lds);
    LAS int* base = hist + 32;
    LAS int* se = base + 32;
    LAS int* sr = se + 128;
    LAS float* sw = (LAS float*)(sr + 128);
    f32x4 gv[4], bv[4];
#pragma unroll
    for (int j = 0; j < 4; ++j) { gv[j] = *(const f32x4*)(g1 + 4 * lane + 256 * j); bv[j] = *(const f32x4*)(b1 + 4 * lane + 256 * j); }
    for (int it = blockIdx.x; it < T_ / 64; it += gridDim.x) {
        __syncthreads();
        if (tid < 32) hist[tid] = 0;
        __syncthreads();
        for (int rr = 0; rr < 8; ++rr) {
            const int rl = wave * 8 + rr; const size_t row = (size_t)it * 64 + rl;
            f32x4 v[4]; float s = 0.f;
#pragma unroll
            for (int j = 0; j < 4; ++j) { v[j] = *(const f32x4*)(pre1 + row * DM + 4 * lane + 256 * j); s += (v[j][0] + v[j][1]) + (v[j][2] + v[j][3]); }
            const float mean = wave_sum(s) * (1.f / DM); float s2 = 0.f;
#pragma unroll
            for (int j = 0; j < 4; ++j) { v[j] = v[j] - mean; s2 += (v[j][0] * v[j][0] + v[j][1] * v[j][1]) + (v[j][2] * v[j][2] + v[j][3] * v[j][3]); }
            const float rstd = rsqrtf(wave_sum(s2) * (1.f / DM) + LN_EPS);
#pragma unroll
            for (int j = 0; j < 4; ++j) { v[j] = v[j] * rstd * gv[j] + bv[j];
                u32x2 w; w.x = pk2(v[j][0], v[j][1]); w.y = pk2(v[j][2], v[j][3]); *(u32x2*)(X1B + row * DM + 4 * lane + 256 * j) = w; }
            float lg[36];
#pragma unroll
            for (int o = 0; o < 36; ++o) lg[o] = 0.f;
#pragma unroll
            for (int j = 0; j < 4; ++j)
#pragma unroll
                for (int c = 0; c < 4; ++c) { const int k = 4 * lane + 256 * j + c; const float xv = v[j][c];
                    const f32x4 wg = *(const f32x4*)(rgw + (size_t)k * 4);
#pragma unroll
                    for (int o = 0; o < 4; ++o) lg[o] += xv * wg[o];
#pragma unroll
                    for (int q = 0; q < 8; ++q) { const f32x4 we = *(const f32x4*)(rew + (size_t)k * 32 + 4 * q);
#pragma unroll
                        for (int o = 0; o < 4; ++o) lg[4 + 4 * q + o] += xv * we[o]; }
                    asm volatile("" ::: "memory"); }
#pragma unroll
            for (int o = 0; o < 36; ++o) lg[o] = wave_sum(lg[o]);
            if (lane == 0) {
                float gl[4]; int gs = 0; float gm;
#pragma unroll
                for (int o = 0; o < 4; ++o) gl[o] = lg[o] + rgb[o];
                gm = gl[0];
#pragma unroll
                for (int o = 1; o < 4; ++o) if (gl[o] > gm) { gm = gl[o]; gs = o; }
                float gsum = 0.f;
#pragma unroll
                for (int o = 0; o < 4; ++o) gsum += __expf(gl[o] - gm);
                const float gw = 1.f / gsum;
                float el[8];
#pragma unroll
                for (int o = 0; o < 8; ++o) { float t = 0.f;
#pragma unroll
                    for (int q = 0; q < 4; ++q) t = (gs == q) ? (lg[4 + 8 * q + o] + reb[8 * q + o]) : t;
                    el[o] = t; }
                int i1 = 0; float m1 = el[0];
#pragma unroll
                for (int o = 1; o < 8; ++o) if (el[o] > m1) { m1 = el[o]; i1 = o; }
                int i2 = -1; float m2 = -3.0e38f;
#pragma unroll
                for (int o = 0; o < 8; ++o) if (o != i1 && el[o] > m2) { m2 = el[o]; i2 = o; }
                const float e2 = __expf(m2 - m1); const float w1 = gw / (1.f + e2), w2 = gw * e2 / (1.f + e2);
                const int x1 = gs * 8 + i1, x2 = gs * 8 + i2;
                se[rl * 2] = x1; se[rl * 2 + 1] = x2; sw[rl * 2] = w1; sw[rl * 2 + 1] = w2;
                sr[rl * 2] = atomicAdd((int*)(hist + x1), 1); sr[rl * 2 + 1] = atomicAdd((int*)(hist + x2), 1);
            }
        }
        __syncthreads();
        if (tid < 32) { const int hcount = hist[tid]; base[tid] = hcount > 0 ? (int)atomicAdd(ctl + CW_CNT + tid, (unsigned)hcount) : 0; }
        __syncthreads();
        if (tid < 128) { const int e = se[tid]; const int pos = base[e] + sr[tid]; const int asg = (it * 64 + (tid >> 1)) * 2 + (tid & 1);
            slot[(size_t)e * CAP + pos] = asg; asgw[asg] = sw[tid]; }
    }
}

__device__ __forceinline__ unsigned hi16(float f) { return f2bf(f); }
__device__ __forceinline__ void p5_ln_router_mfma(const Args& a, LAS unsigned char* lds) {
    const int tid = threadIdx.x, lane = tid & 63, wave = __builtin_amdgcn_readfirstlane(tid >> 6), r16 = lane & 15, g = lane >> 4;
    unsigned char* ws = a.ws;
    const float* pre1 = a.out; bf16_t* X1B = (bf16_t*)(ws + WS_RA);
    const float* rgw = a.in[10]; const float* rgb = a.in[11]; const float* rew = a.in[12]; const float* reb = a.in[13];
    unsigned* ctl = (unsigned*)(ws + WS_CTL); int* slot = (int*)(ws + WS_SLOT); float* asgw = (float*)(ws + WS_ASGW); int* asgep = (int*)(ws + WS_ASGEP);
    LAS float* sgam = (LAS float*)lds;
    LAS float* sbet = sgam + 1024;
    LAS f32x2* red = (LAS f32x2*)(lds + 8192);
    LAS float* part = (LAS float*)(lds + 9216);
    LAS float* lgs = (LAS float*)(lds + 33792);
    LAS int* hist = (LAS int*)(lds + 36096);
    LAS int* base = hist + 32;
    LAS int* sel_e = (LAS int*)(lds + 36608);
    LAS int* sel_r = sel_e + 2048;
    LAS float* sel_w = (LAS float*)(sel_r + 2048);
    __syncthreads();
    for (int i = tid; i < 1024; i += NTHREADS) { sgam[i] = a.in[8][i]; sbet[i] = a.in[9][i]; }
    if (tid < 32) hist[tid] = 0;
    const int kb = 128 * wave + 8 * g;
    bf16x8 WH[4][3], WL[4][3];
#pragma unroll
    for (int ks = 0; ks < 4; ++ks)
#pragma unroll
        for (int nt = 0; nt < 3; ++nt) {
            const int o = 16 * nt + r16;
            unsigned h[8], l[8];
#pragma unroll
            for (int j = 0; j < 8; ++j) { const int k = kb + 32 * ks + j;
                float w = 0.f; if (o < 4) w = rgw[(size_t)k * 4 + o]; else if (o < 36) w = rew[(size_t)k * 32 + (o - 4)];
                h[j] = f2bf(w); l[j] = f2bf(w - __uint_as_float(h[j] << 16)); }
            u32x4 ph, pl; ph.x = h[0] | (h[1] << 16); ph.y = h[2] | (h[3] << 16); ph.z = h[4] | (h[5] << 16); ph.w = h[6] | (h[7] << 16);
            pl.x = l[0] | (l[1] << 16); pl.y = l[2] | (l[3] << 16); pl.z = l[4] | (l[5] << 16); pl.w = l[6] | (l[7] << 16);
            WH[ks][nt] = __builtin_bit_cast(bf16x8, ph); WL[ks][nt] = __builtin_bit_cast(bf16x8, pl);
        }
    __syncthreads();
    const int NIT = T_ / 16;
    f32x4 xc[4][2], xn[4][2];
    int it = blockIdx.x, jj = 0;
    if (it < NIT) {
#pragma unroll
        for (int ks = 0; ks < 4; ++ks) { const float* p = pre1 + (size_t)(it * 16 + r16) * DM + kb + 32 * ks; xn[ks][0] = *(const f32x4*)p; xn[ks][1] = *(const f32x4*)(p + 4); }
    }
    for (; it < NIT; it += gridDim.x, ++jj) {
#pragma unroll
        for (int ks = 0; ks < 4; ++ks) { xc[ks][0] = xn[ks][0]; xc[ks][1] = xn[ks][1]; }
        const int itn = it + gridDim.x;
        if (itn < NIT) {
#pragma unroll
            for (int ks = 0; ks < 4; ++ks) { const float* p = pre1 + (size_t)(itn * 16 + r16) * DM + kb + 32 * ks; xn[ks][0] = *(const f32x4*)p; xn[ks][1] = *(const f32x4*)(p + 4); }
        }
        float s = 0.f, s2 = 0.f;
#pragma unroll
        for (int ks = 0; ks < 4; ++ks)
#pragma unroll
            for (int q = 0; q < 2; ++q)
#pragma unroll
                for (int c = 0; c < 4; ++c) { const float v = xc[ks][q][c]; s += v; s2 = fmaf(v, v, s2); }
        s += __shfl_xor(s, 16); s2 += __shfl_xor(s2, 16); s += __shfl_xor(s, 32); s2 += __shfl_xor(s2, 32);
        if (g == 0) red[wave * 16 + r16] = (f32x2){s, s2};
        __syncthreads();
        float S = 0.f, S2 = 0.f;
#pragma unroll
        for (int w = 0; w < 8; ++w) { const f32x2 t = red[w * 16 + r16]; S += t.x; S2 += t.y; }
        const float mean = S * (1.f / DM); const float rstd = rsqrtf(fmaxf(S2 * (1.f / DM) - mean * mean, 0.f) + LN_EPS);
        f32x4 acc[3];
#pragma unroll
        for (int nt = 0; nt < 3; ++nt) acc[nt] = (f32x4){0.f, 0.f, 0.f, 0.f};
#pragma unroll
        for (int ks = 0; ks < 4; ++ks) {
            float y[8];
#pragma unroll
            for (int q = 0; q < 2; ++q) { const f32x4 gm = *(const LAS f32x4*)(sgam + kb + 32 * ks + 4 * q), bt = *(const LAS f32x4*)(sbet + kb + 32 * ks + 4 * q);
#pragma unroll
                for (int c = 0; c < 4; ++c) y[4 * q + c] = (xc[ks][q][c] - mean) * rstd * gm[c] + bt[c]; }
            unsigned h[8], l[8];
#pragma unroll
            for (int j = 0; j < 8; ++j) { h[j] = f2bf(y[j]); l[j] = f2bf(y[j] - __uint_as_float(h[j] << 16)); }
            u32x4 ph, pl; ph.x = h[0] | (h[1] << 16); ph.y = h[2] | (h[3] << 16); ph.z = h[4] | (h[5] << 16); ph.w = h[6] | (h[7] << 16);
            pl.x = l[0] | (l[1] << 16); pl.y = l[2] | (l[3] << 16); pl.z = l[4] | (l[5] << 16); pl.w = l[6] | (l[7] << 16);
            *(u32x4*)(X1B + (size_t)(it * 16 + r16) * DM + kb + 32 * ks) = ph;
            const bf16x8 AH = __builtin_bit_cast(bf16x8, ph), AL = __builtin_bit_cast(bf16x8, pl);
#pragma unroll
            for (int nt = 0; nt < 3; ++nt) {
                acc[nt] = __builtin_amdgcn_mfma_f32_16x16x32_bf16(AH, WH[ks][nt], acc[nt], 0, 0, 0);
                acc[nt] = __builtin_amdgcn_mfma_f32_16x16x32_bf16(AL, WH[ks][nt], acc[nt], 0, 0, 0);
                acc[nt] = __builtin_amdgcn_mfma_f32_16x16x32_bf16(AH, WL[ks][nt], acc[nt], 0, 0, 0);
            }
        }
#pragma unroll
        for (int nt = 0; nt < 3; ++nt)
#pragma unroll
            for (int r = 0; r < 4; ++r) part[(wave * 16 + 4 * g + r) * 48 + 16 * nt + r16] = acc[nt][r];
        __syncthreads();
        { const int row = tid >> 5, c = tid & 31; float t = 0.f, t2 = 0.f;
#pragma unroll
          for (int w = 0; w < 8; ++w) { t += part[(w * 16 + row) * 48 + 4 + c]; if (c < 4) t2 += part[(w * 16 + row) * 48 + c]; }
          lgs[row * 36 + 4 + c] = t; if (c < 4) lgs[row * 36 + c] = t2; }
        __syncthreads();
        if (tid < 16) {
            const LAS float* lg = lgs + tid * 36;
            float gl[4]; int gs = 0;
#pragma unroll
            for (int o = 0; o < 4; ++o) gl[o] = lg[o] + rgb[o];
            float gm = gl[0];
#pragma unroll
            for (int o = 1; o < 4; ++o) if (gl[o] > gm) { gm = gl[o]; gs = o; }
            float gsum = 0.f;
#pragma unroll
            for (int o = 0; o < 4; ++o) gsum += __expf(gl[o] - gm);
            const float gw = 1.f / gsum;
            float el[8];
#pragma unroll
            for (int o = 0; o < 8; ++o) el[o] = lg[4 + gs * 8 + o] + reb[gs * 8 + o];
            int i1 = 0; float m1 = el[0];
#pragma unroll
            for (int o = 1; o < 8; ++o) if (el[o] > m1) { m1 = el[o]; i1 = o; }
            int i2 = -1; float m2 = -3.0e38f;
#pragma unroll
            for (int o = 0; o < 8; ++o) if (o != i1 && el[o] > m2) { m2 = el[o]; i2 = o; }
            const float e2 = __expf(m2 - m1); const float w1 = gw / (1.f + e2), w2 = gw * e2 / (1.f + e2);
            const int x1 = gs * 8 + i1, x2 = gs * 8 + i2; const int si = (jj * 16 + tid) * 2;
            sel_e[si] = x1; sel_e[si + 1] = x2; sel_w[si] = w1; sel_w[si + 1] = w2;
            sel_r[si] = atomicAdd((int*)(hist + x1), 1); sel_r[si + 1] = atomicAdd((int*)(hist + x2), 1);
        }
    }
    __syncthreads();
    if (tid < 32) { const int hcount = hist[tid]; base[tid] = hcount > 0 ? (int)atomicAdd(ctl + CW_CNT + tid, (unsigned)hcount) : 0; }
    __syncthreads();
    for (int idx = tid; idx < jj * 32; idx += NTHREADS) {
        const int j2 = idx >> 5, rem = idx & 31; const int token = (blockIdx.x + j2 * gridDim.x) * 16 + (rem >> 1); const int asg = token * 2 + (rem & 1);
        const int e = sel_e[idx]; const int pos = base[e] + sel_r[idx];
        slot[(size_t)e * CAP + pos] = asg; asgw[asg] = sel_w[idx]; asgep[asg] = e | (pos << 5);
    }
}

__device__ __forceinline__ void p7_final(const Args& a, const LAS int* tp) {
    const int tid = threadIdx.x, lane = tid & 63, wave = tid >> 6;
    const bf16_t* X1B = (const bf16_t*)(a.ws + WS_RA); const bf16_t* Y = (const bf16_t*)(a.ws + WS_RB);
    const float* asgw = (const float*)(a.ws + WS_ASGW); const int* asgep = (const int*)(a.ws + WS_ASGEP);
    const float* g2 = a.in[17]; const float* b2 = a.in[18];
    f32x4 gv[4], bv[4];
#pragma unroll
    for (int j = 0; j < 4; ++j) { gv[j] = *(const f32x4*)(g2 + 4 * lane + 256 * j); bv[j] = *(const f32x4*)(b2 + 4 * lane + 256 * j); }
    const int gw = blockIdx.x * NWAVES + wave, NGW = gridDim.x * NWAVES;
    const int per = (T_ + NGW - 1) / NGW;
    for (int r0 = gw * per; r0 < min(T_, (gw + 1) * per); r0 += 32) {
        int yr0 = 0, yr1 = 0; float w0 = 0.f, w1 = 0.f;
        if (lane < 32 && r0 + lane < T_) { const int t = r0 + lane; const int p0 = asgep[2 * t], p1 = asgep[2 * t + 1];
            yr0 = tp[p0 & 31] * BM + (p0 >> 5); yr1 = tp[p1 & 31] * BM + (p1 >> 5); w0 = asgw[2 * t]; w1 = asgw[2 * t + 1]; }
        const int nr = min(32, min(T_, (gw + 1) * per) - r0);
        for (int jj = 0; jj < nr; jj += 2) {
            f32x4 v[2][4]; float s[2];
#pragma unroll
            for (int q = 0; q < 2; ++q) {
                const int jq = min(jj + q, nr - 1); const int row = r0 + jq;
                const int ya = __shfl(yr0, jq), yb = __shfl(yr1, jq); const float wa = __shfl(w0, jq), wb = __shfl(w1, jq);
                s[q] = 0.f;
#pragma unroll
                for (int j = 0; j < 4; ++j) {
                    const u32x2 xw = *(const u32x2*)(X1B + (size_t)row * DM + 4 * lane + 256 * j);
                    const u32x2 y0 = *(const u32x2*)(Y + (size_t)ya * DM + 4 * lane + 256 * j);
                    const u32x2 y1 = *(const u32x2*)(Y + (size_t)yb * DM + 4 * lane + 256 * j);
                    v[q][j][0] = DN_ALPHA * bflo(xw.x) + (wa * bflo(y0.x) + wb * bflo(y1.x)); v[q][j][1] = DN_ALPHA * bfhi(xw.x) + (wa * bfhi(y0.x) + wb * bfhi(y1.x));
                    v[q][j][2] = DN_ALPHA * bflo(xw.y) + (wa * bflo(y0.y) + wb * bflo(y1.y)); v[q][j][3] = DN_ALPHA * bfhi(xw.y) + (wa * bfhi(y0.y) + wb * bfhi(y1.y));
                    s[q] += (v[q][j][0] + v[q][j][1]) + (v[q][j][2] + v[q][j][3]);
                }
            }
#pragma unroll
            for (int q = 0; q < 2; ++q) {
                if (jj + q < nr) {
                    const int row = r0 + jj + q;
                    const float mean = wave_sum(s[q]) * (1.f / DM); float s2 = 0.f;
#pragma unroll
                    for (int j = 0; j < 4; ++j) { v[q][j] = v[q][j] - mean; s2 += (v[q][j][0] * v[q][j][0] + v[q][j][1] * v[q][j][1]) + (v[q][j][2] * v[q][j][2] + v[q][j][3] * v[q][j][3]); }
                    const float rstd = rsqrtf(wave_sum(s2) * (1.f / DM) + LN_EPS);
#pragma unroll
                    for (int j = 0; j < 4; ++j) *(f32x4*)(a.out + (size_t)row * DM + 4 * lane + 256 * j) = v[q][j] * rstd * gv[j] + bv[j];
                }
            }
        }
    }
}

__device__ __forceinline__ void moe_tables(const Args& a, LAS unsigned char* lds) {
    LAS int* cn = (LAS int*)(lds + MISC_OFF); LAS int* tp = cn + 32;
    const unsigned* ctl = (const unsigned*)(a.ws + WS_CTL);
    __syncthreads();
    if (threadIdx.x < 32) cn[threadIdx.x] = (int)__hip_atomic_load(ctl + CW_CNT + threadIdx.x, __ATOMIC_RELAXED, __HIP_MEMORY_SCOPE_AGENT);
    __syncthreads();
    if (threadIdx.x == 0) { int s = 0; for (int e = 0; e < 32; ++e) { tp[e] = s; s += (cn[e] + BM - 1) / BM; } tp[32] = s; }
    __syncthreads();
}

constexpr int NPHASES = 10;
__global__ void __launch_bounds__(NTHREADS, 2) mk_fwd(Args a) {
    extern __shared__ __attribute__((aligned(16))) unsigned char lds_raw[];
    LAS unsigned char* lds = (LAS unsigned char*)lds_raw;
    unsigned char* ws = a.ws;
    const int lo = a.ph_lo, hi = a.ph_hi;
    const int G = gridDim.x, bid = blockIdx.x;
#ifndef PHASE_MASK
#define PHASE_MASK 0x3ff
#endif
#define IN(k) (((PHASE_MASK >> (k)) & 1) && lo <= (k) && (k) < hi)
#if PROBE_PHASE >= 0
    unsigned long long t_lo = 0, t_hi = 0;
#define STAMP(k) do { if ((k) == PROBE_PHASE) t_lo = __builtin_amdgcn_s_memrealtime(); if ((k) == PROBE_PHASE + 1) t_hi = __builtin_amdgcn_s_memrealtime(); } while (0)
#else
#define STAMP(k) do { } while (0)
#endif
#if XCD_BARRIER
#define SEAM(k) do { if (IN(k) && IN((k) + 1) && a.coop) { if (a.coop == 2) cg::this_grid().sync(); else xcd_barrier(xbar); } STAMP((k) + 1); } while (0)
#else
#define SEAM(k) do { if (IN(k) && IN((k) + 1) && a.coop) { cg::this_grid().sync(); } STAMP((k) + 1); } while (0)
#endif
    bf16_t* XB = (bf16_t*)(ws + WS_RA); bf16_t* MG = (bf16_t*)(ws + WS_RA); bf16_t* X1B = (bf16_t*)(ws + WS_RA);
    bf16_t* HB = (bf16_t*)(ws + WS_RB); bf16_t* Yb = (bf16_t*)(ws + WS_RB);
    bf16_t* AB = (bf16_t*)(ws + WS_RC); bf16_t* GB = (bf16_t*)(ws + WS_RD); bf16_t* HM = (bf16_t*)(ws + WS_RD);
    bf16_t* OH = (bf16_t*)(ws + WS_RE); bf16_t* OA = (bf16_t*)(ws + WS_RF);

    volatile LAS unsigned* xst = (volatile LAS unsigned*)(lds + LDS_BYTES - 16);
    if (threadIdx.x == 0) { xst[0] = 0u; xst[1] = 0u; }
    __syncthreads();
    XcdBarrier xbar; xbar.bar = (unsigned*)(ws + WS_CTL) + CW_BAR; xbar.x = 0; xbar.st = xst;
    if (a.coop) xbar = xcd_barrier_post((unsigned*)(ws + WS_CTL) + CW_BAR, xst);
    STAMP(0);
    if (IN(0)) { p0_prologue(a, lds); }
    SEAM(0);
    if (IN(1)) {
        DenseProb P; P.init(XB, ws + WS_WIN, T_, PW, DM, G, bid);
        EpiProj E{HB, AB, GB, (const float*)(ws + WS_LB)};
        gemm_phase<DenseProb, EpiProj>(lds, P, E);
    }
    SEAM(1);
    if (IN(2)) {
        if (bid >= 128) { __syncthreads(); p0_rest(a, lds, (bid - 128) * NWAVES + (int)(threadIdx.x >> 6), (G - 128) * NWAVES); }
#if HGRN_MFMA
        if (bid < 128) hgrn_mfma(lds, HB, a.in[3], OH, bid);
#else
        if (bid < 128) hgrn_naive(lds, HB, a.in[3], OH, bid);
#endif
        unsigned* ctl = (unsigned*)(ws + WS_CTL);
        LAS int* qi = (LAS int*)(lds + MISC_OFF + 1024);
#if ATTN_MFMA
        {
            __syncthreads();
            if (threadIdx.x == 0) { qi[0] = (int)atomicAdd(ctl + CW_ATTQ, 1u); qi[1] = (int)atomicAdd(ctl + CW_ATTQ, 1u); }
            __syncthreads();
            int item = qi[0], nitem = qi[1], par = 0;
            AttnStage stg;
            if (item < 1024) attn_stage_load(stg, AB, item);
            while (item < 1024) {
                if (threadIdx.x == 0) qi[2 + par] = (int)atomicAdd(ctl + CW_ATTQ, 1u);
                attn_mfma(lds, AB, a.in[4], OA, item, stg, nitem < 1024 ? nitem : -1);
                item = nitem; nitem = qi[2 + par]; par ^= 1;
            }
        }
#else
        for (;;) {
            __syncthreads();
            if (threadIdx.x == 0) qi[0] = (int)atomicAdd(ctl + CW_ATTQ, 1u);
            __syncthreads();
            const int item = qi[0];
            if (item >= 1024) break;
            attn_naive(lds, AB, a.in[4], OA, item);
        }
#endif
    }
    SEAM(2);
    if (IN(3)) {
        DenseProb P; P.init(OH, ws + WS_WA, T_, DM, 512, G, bid);
        EpiGate<0> E{MG, GB};
        gemm_phase<DenseProb, EpiGate<0>>(lds, P, E);
    }
    SEAM(3);
    if (IN(4)) {
        DenseProb P; P.init(OA, ws + WS_WB, T_, DM, 512, G, bid);
        EpiGate<1> E{MG, GB};
        gemm_phase<DenseProb, EpiGate<1>>(lds, P, E);
    }
    SEAM(4);
    if (IN(5)) {
        DenseProb P; P.init(MG, ws + WS_WO, T_, DM, DM, G, bid);
        EpiPre1 E{a.in[0], a.out};
        gemm_phase<DenseProb, EpiPre1>(lds, P, E);
    }
    SEAM(5);
#if ROUTER_MFMA
    if (IN(6)) { p5_ln_router_mfma(a, lds); }
#else
    if (IN(6)) { p5_ln_router(a, lds); }
#endif
    SEAM(6);
    if (IN(7)) {
        moe_tables(a, lds);
        MoeProb<true> P; P.Abase = (const char*)X1B; P.Bt = (const char*)(ws + WS_WGU); P.K = DM; P.G = G; P.c = bid;
        P.tp = (const LAS int*)(lds + MISC_OFF) + 32; P.cn = (const LAS int*)(lds + MISC_OFF); P.slot = (const int*)(ws + WS_SLOT); P.estride = (size_t)DM * DM * 2;
        EpiSwiGLU E{HM};
        gemm_phase<MoeProb<true>, EpiSwiGLU>(lds, P, E);
    }
    SEAM(7);
    if (IN(8)) {
        moe_tables(a, lds);
        MoeProb<false> P; P.Abase = (const char*)HM; P.Bt = (const char*)(ws + WS_WD); P.K = DE; P.G = G; P.c = bid;
        P.tp = (const LAS int*)(lds + MISC_OFF) + 32; P.cn = (const LAS int*)(lds + MISC_OFF); P.slot = (const int*)(ws + WS_SLOT); P.estride = (size_t)DM * DE * 2;
        EpiDown E{Yb};
        gemm_phase<MoeProb<false>, EpiDown>(lds, P, E);
    }
    SEAM(8);
    if (IN(9)) { moe_tables(a, lds); p7_final(a, (const LAS int*)(lds + MISC_OFF) + 32); }
#if PROBE_SECTION >= 0
    if (bid == 0 && threadIdx.x == 0) { const unsigned long long dt = *(LAS unsigned long long*)(lds + LDS_BYTES - 32);
        const unsigned long long target = __builtin_amdgcn_s_memrealtime() + (unsigned long long)PROBE_MULT * dt;
        while (__builtin_amdgcn_s_memrealtime() < target) __builtin_amdgcn_s_sleep(8); }
#endif
#if PROBE_PHASE >= 0
    STAMP(10);
    if (bid == 0 && threadIdx.x == 0) { const unsigned long long target = __builtin_amdgcn_s_memrealtime() + (unsigned long long)PROBE_MULT * (t_hi - t_lo);
        while (__builtin_amdgcn_s_memrealtime() < target) __builtin_amdgcn_s_sleep(8); }
#endif
#undef IN
#undef SEAM
}

extern "C" void kernel_launch(void* const* d_in, const int* in_sizes, int n_in, void* d_out, int out_size, void* d_ws, size_t ws_size, hipStream_t stream) {
    static int grid = 0;
    if (grid == 0) {
        if (n_in != 19 || out_size != T_ * DM || ws_size < WS_END) { fprintf(stderr, "kernel_launch: unexpected shapes (n_in %d out %d ws %zu)\n", n_in, out_size, ws_size); grid = -1; return; }
        int dev = 0, cus = 0, per_cu = 0;
        (void)hipGetDevice(&dev); (void)hipDeviceGetAttribute(&cus, hipDeviceAttributeMultiprocessorCount, dev);
        (void)hipFuncSetAttribute((const void*)mk_fwd, hipFuncAttributeMaxDynamicSharedMemorySize, LDS_BYTES);
        (void)hipOccupancyMaxActiveBlocksPerMultiprocessor(&per_cu, (const void*)mk_fwd, NTHREADS, LDS_BYTES);
        if (per_cu < 1) { fprintf(stderr, "kernel_launch: occupancy query says %d blocks/CU\n", per_cu); per_cu = 1; }
        (void)hipGetLastError();
        grid = cus * 1;
        fprintf(stderr, "kernel_launch: cus %d per_cu %d grid %d\n", cus, per_cu, grid);
    }
    if (grid < 0) return;
    (void)hipMemsetAsync((char*)d_ws + WS_CTL, 0, 65536, stream);
    Args a{};
    for (int i = 0; i < 19; ++i) a.in[i] = (const float*)d_in[i];
    a.out = (float*)d_out; a.ws = (unsigned char*)d_ws;
#if N_LAUNCH_MODE == 1
    a.ph_lo = 0; a.ph_hi = NPHASES; a.coop = 1;
    void* args[] = {&a};
    hipError_t e = hipLaunchCooperativeKernel((const void*)mk_fwd, dim3(grid), dim3(NTHREADS), args, LDS_BYTES, stream);
    if (e != hipSuccess) fprintf(stderr, "cooperative launch failed: %s (grid %d)\n", hipGetErrorString(e), grid);
#else
    for (int p = 0; p < NPHASES; ++p) {
        a.ph_lo = p; a.ph_hi = p + 1; a.coop = 0;
        hipLaunchKernelGGL(mk_fwd, dim3(grid), dim3(NTHREADS), LDS_BYTES, stream, a);
    }
#endif
}
```

```cpp
#include <hip/hip_runtime.h>
#include <hip/hip_cooperative_groups.h>
#include <cstdio>
#include <cstdint>
namespace cg = cooperative_groups;

#ifndef NAIVE_GEMM
#define NAIVE_GEMM 0
#endif
#ifndef ROUTER_MFMA
#define ROUTER_MFMA 1
#endif
#ifndef ATTN_MFMA
#define ATTN_MFMA 1
#endif
#ifndef HGRN_MFMA
#define HGRN_MFMA 1
#endif
#ifndef XCD_BARRIER
#define XCD_BARRIER 1
#endif
#ifndef N_LAUNCH_MODE
#define N_LAUNCH_MODE 1
#endif

#ifndef PROBE_PHASE
#define PROBE_PHASE -1
#endif
#ifndef PROBE_MULT
#define PROBE_MULT 4
#endif
#ifndef PROBE_SECTION
#define PROBE_SECTION -1
#endif
#define LAS __attribute__((address_space(3)))
typedef unsigned short bf16_t;
typedef short bf16x8 __attribute__((ext_vector_type(8)));
typedef float f32x4 __attribute__((ext_vector_type(4)));
typedef float f32x2 __attribute__((ext_vector_type(2)));
typedef unsigned u32x4 __attribute__((ext_vector_type(4)));
typedef unsigned u32x2 __attribute__((ext_vector_type(2)));

constexpr int T_ = 65536, DM = 1024, SEQ = 2048, NBATCH = 32;
constexpr int PW = 4864;
constexpr int NE = 32, DE = 512;
constexpr int CAP = 131072;
constexpr float DN_ALPHA = 1.189207115002721f;
constexpr float LN_EPS = 1e-5f, RMS_EPS = 1e-6f;
constexpr int NWAVES = 8, NTHREADS = 512;

constexpr size_t MiB = 1u << 20;
constexpr size_t WS_CTL = 0;
constexpr size_t WS_LB = 1 * MiB;
constexpr size_t WS_WIN = 2 * MiB;
constexpr size_t WS_WA = 12 * MiB;
constexpr size_t WS_WB = 13 * MiB;
constexpr size_t WS_WO = 14 * MiB;
constexpr size_t WS_WGU = 16 * MiB;
constexpr size_t WS_WD = 80 * MiB;
constexpr size_t WS_SLOT = 112 * MiB;
constexpr size_t WS_ASGW = 128 * MiB;
constexpr size_t WS_ASGEP = 129 * MiB;
constexpr size_t WS_RA = 132 * MiB;
constexpr size_t WS_RB = 260 * MiB;
constexpr size_t WS_RC = 516 * MiB;
constexpr size_t WS_RD = 612 * MiB;
constexpr size_t WS_RE = 868 * MiB;
constexpr size_t WS_RF = 932 * MiB;
constexpr size_t WS_END = 996 * MiB;
constexpr int CW_CNT = 64;
constexpr int CW_ATTQ = 128;
constexpr int CW_BAR = 4096;

constexpr int RING_BYTES = 131072;
constexpr int MISC_OFF = RING_BYTES;
constexpr int LDS_BYTES = 147456;

__device__ __forceinline__ float bf2f(bf16_t v) { return __uint_as_float((unsigned)v << 16); }
__device__ __forceinline__ unsigned f2bf(float f) { unsigned u = __float_as_uint(f); return (u + 0x7fffu + ((u >> 16) & 1u)) >> 16; }
typedef __bf16 hwbf16x2 __attribute__((ext_vector_type(2)));
__device__ __forceinline__ unsigned pk2(float lo, float hi) { f32x2 v = {lo, hi}; hwbf16x2 b = __builtin_convertvector(v, hwbf16x2); return __builtin_bit_cast(unsigned, b); }
__device__ __forceinline__ float bflo(unsigned w) { return __uint_as_float(w << 16); }
__device__ __forceinline__ float bfhi(unsigned w) { return __uint_as_float(w & 0xffff0000u); }
__device__ __forceinline__ float sigm(float x) { return __builtin_amdgcn_rcpf(1.f + __builtin_amdgcn_exp2f(x * -1.4426950408889634f)); }
__device__ __forceinline__ float silu(float x) { return x * sigm(x); }
__device__ __forceinline__ float wave_sum(float v) {
#pragma unroll
    for (int o = 1; o < 64; o <<= 1) v += __shfl_xor(v, o);
    return v;
}
__device__ __forceinline__ float wave_max(float v) {
#pragma unroll
    for (int o = 1; o < 64; o <<= 1) v = fmaxf(v, __shfl_xor(v, o));
    return v;
}
#define LDS_WAIT() asm volatile("s_waitcnt lgkmcnt(0)" ::: "memory")
#if PROBE_SECTION >= 0
#define SEC_DECL unsigned long long sec_t = 0, sec_acc = 0
#define SEC_MARK(id) do { const unsigned long long _n = __builtin_amdgcn_s_memrealtime(); if ((id) == PROBE_SECTION + 1) sec_acc += _n - sec_t; sec_t = _n; } while (0)
#define SEC_STORE(lds) do { if (blockIdx.x == 0 && threadIdx.x == 0) *(LAS unsigned long long*)((lds) + LDS_BYTES - 32) = sec_acc; } while (0)
#else
#define SEC_DECL do { } while (0)
#define SEC_MARK(id) do { } while (0)
#define SEC_STORE(lds) do { } while (0)
#endif

constexpr int BM = 256, BK = 64, HALF = 128, HTB = HALF * BK * 2, NXCD = 8, WGM = 8;
__host__ __device__ __forceinline__ int lds_byte(int r, int c) { const int st = (r >> 4) * 2 + (c >> 5), rr = r & 15, cc = c & 31, ob = rr * 64 + cc * 2; return st * 1024 + (ob ^ (((ob >> 9) & 1) << 5)); }
__host__ __device__ __forceinline__ void stage_rc(int b, int& R, int& C) { const int st = b / 1024, sb = b % 1024, swz = sb ^ (((sb >> 9) & 1) << 5); R = (st >> 1) * 16 + swz / 64; C = (st & 1) * 32 + (swz % 64) / 2; }
__host__ __device__ __forceinline__ int perm32(int rho) { const int n = rho >> 4, i = rho & 15; return 8 * (i >> 2) + 4 * n + (i & 3); }

struct Unit { int pm, pn, e, mt; };

struct DenseProb {
    const char* Abase; const char* Bt; int K; int nM, nN, nwg, G, c;
    __device__ __forceinline__ void init(const void* A, const void* B, int M, int N, int K_, int G_, int c_) { Abase = (const char*)A; Bt = (const char*)B; K = K_; nM = M / BM; nN = N / BM; nwg = nM * nN; G = G_; c = c_; }
    __device__ __forceinline__ bool next(int i, Unit& u) const {
        const long L = (long)i * G + c; if (L >= nwg) return false;
        int wgid = (int)L; { const int q = nwg / NXCD, r = nwg % NXCD, xcd = wgid % NXCD, off = wgid / NXCD; wgid = (xcd < r ? xcd * (q + 1) : r * (q + 1) + (xcd - r) * q) + off; }
        const int nig = WGM * nN, gid = wgid / nig, fm = gid * WGM, gsz = (nM - fm) < WGM ? (nM - fm) : WGM;
        u.pm = fm + ((wgid % nig) % gsz); u.pn = (wgid % nig) / gsz; u.e = 0; u.mt = 0; return true;
    }
    __device__ __forceinline__ unsigned a_rowoff(const Unit& u, int r) const { return (unsigned)(u.pm * BM + r) * (unsigned)K * 2u; }
    __device__ __forceinline__ const char* b_base(const Unit& u) const { return Bt + (size_t)u.pn * BM * K * 2; }
};

template <bool GATHER> struct MoeProb {
    const char* Abase; const char* Bt; int K; int G, c; const LAS int* tp; const LAS int* cn; const int* slot; size_t estride;
    __device__ __forceinline__ bool next(int i, Unit& u) const {
        const int L = i * G + c; const int total = tp[32] * 4; if (L >= total) return false;
        const int tau = L >> 2; int e = 0;
        for (int j = 1; j < 32; ++j) e = (tau >= tp[j]) ? j : e;
        u.pm = tau; u.pn = L & 3; u.e = __builtin_amdgcn_readfirstlane(e); u.mt = __builtin_amdgcn_readfirstlane(tau - tp[e]); return true;
    }
    __device__ __forceinline__ unsigned a_rowoff(const Unit& u, int r) const {
        if (GATHER) { const int s = u.mt * BM + r; const int asg = (s < cn[u.e]) ? slot[(size_t)u.e * CAP + s] : 0; return (unsigned)(asg >> 1) * (unsigned)K * 2u; }
        else return (unsigned)(u.pm * BM + r) * (unsigned)K * 2u;
    }
    __device__ __forceinline__ const char* b_base(const Unit& u) const { return Bt + (size_t)u.e * estride + (size_t)u.pn * BM * K * 2; }
};

struct EpiProj {
    static constexpr bool PERM = true;
    bf16_t* HB; bf16_t* AB; bf16_t* GB; const float* lb;
    template <int MODE> __device__ __forceinline__ void run(const f32x4 (&acc)[2][4][2], bf16_t* base, int ld, int row0, int col0, int lbcol) const {
#pragma unroll
        for (int bj = 0; bj < 2; ++bj) {
            float l8[8];
            if (MODE == 2) {
#pragma unroll
                for (int j = 0; j < 8; ++j) l8[j] = lb[lbcol + bj * HALF + j];
            }
#pragma unroll
            for (int m = 0; m < 4; ++m) {
                float v[8];
#pragma unroll
                for (int j = 0; j < 4; ++j) { v[j] = acc[bj][m][0][j]; v[4 + j] = acc[bj][m][1][j]; }
#pragma unroll
                for (int j = 0; j < 8; ++j) {
                    if (MODE == 1) v[j] = silu(v[j]);
                    else if (MODE == 2) v[j] = __logf(l8[j] + (1.f - l8[j]) * sigm(v[j]));
                    else if (MODE == 3) v[j] = v[j] * 0.18033688011112042f;
                    else if (MODE == 4) v[j] = sigm(v[j]);
                }
                u32x4 w; w.x = pk2(v[0], v[1]); w.y = pk2(v[2], v[3]); w.z = pk2(v[4], v[5]); w.w = pk2(v[6], v[7]);
                *(u32x4*)(base + (size_t)(row0 + m * 16) * ld + col0 + bj * HALF) = w;
            }
        }
    }
    __device__ __forceinline__ void operator()(const f32x4 (&acc)[2][4][2], int ai, const Unit& u, int wr, int wc, int fr, int fq) const {
        const int pn = u.pn, row0 = u.pm * BM + ai * HALF + wr * 64 + fr, colg = pn * BM + wc * 32 + 8 * fq;
        if (pn < 2) run<1>(acc, HB, 2048, row0, colg, 0);
        else if (pn < 4) run<2>(acc, HB, 2048, row0, colg, colg - 512);
        else if (pn < 6) run<0>(acc, HB, 2048, row0, colg, 0);
        else if (pn < 8) run<1>(acc, HB, 2048, row0, colg, 0);
        else if (pn < 10) run<3>(acc, AB, 768, row0, colg - 2048, 0);
        else if (pn < 11) run<0>(acc, AB, 768, row0, colg - 2048, 0);
        else run<0>(acc, GB, 2048, row0, colg - 2816, 0);
    }
};
template <int PASS> struct EpiGate {
    static constexpr bool PERM = true;
    bf16_t* MG; const bf16_t* GB;
    __device__ __forceinline__ void operator()(const f32x4 (&acc)[2][4][2], int ai, const Unit& u, int wr, int wc, int fr, int fq) const {
        const unsigned gbase = ((unsigned)(u.pm * BM + ai * HALF + wr * 64 + fr) * 2048u + (unsigned)(PASS * 1024 + u.pn * BM + wc * 32 + 8 * fq)) * 2u;
        const unsigned mbase = ((unsigned)(u.pm * BM + ai * HALF + wr * 64 + fr) * 1024u + (unsigned)(u.pn * BM + wc * 32 + 8 * fq)) * 2u;
#pragma unroll
        for (int mh = 0; mh < 2; ++mh) {
            u32x4 gt[2][2], pt[2][2];
#pragma unroll
            for (int mm = 0; mm < 2; ++mm)
#pragma unroll
                for (int bj = 0; bj < 2; ++bj) {
                    const int m = mh * 2 + mm;
                    gt[mm][bj] = *(const u32x4*)((const char*)GB + (gbase + (unsigned)((m * 16 * 2048 + bj * HALF) * 2)));
                    if (PASS == 1) pt[mm][bj] = *(const u32x4*)((const char*)MG + (mbase + (unsigned)((m * 16 * 1024 + bj * HALF) * 2)));
                }
#pragma unroll
            for (int mm = 0; mm < 2; ++mm)
#pragma unroll
                for (int bj = 0; bj < 2; ++bj) {
                    const int m = mh * 2 + mm; const u32x4 g = gt[mm][bj];
                    float v[8];
#pragma unroll
                    for (int j = 0; j < 4; ++j) { v[j] = acc[bj][m][0][j]; v[4 + j] = acc[bj][m][1][j]; }
                    v[0] *= sigm(bflo(g.x)); v[1] *= sigm(bfhi(g.x)); v[2] *= sigm(bflo(g.y)); v[3] *= sigm(bfhi(g.y)); v[4] *= sigm(bflo(g.z)); v[5] *= sigm(bfhi(g.z)); v[6] *= sigm(bflo(g.w)); v[7] *= sigm(bfhi(g.w));
                    if (PASS == 1) { const u32x4 p = pt[mm][bj];
                        v[0] += bflo(p.x); v[1] += bfhi(p.x); v[2] += bflo(p.y); v[3] += bfhi(p.y); v[4] += bflo(p.z); v[5] += bfhi(p.z); v[6] += bflo(p.w); v[7] += bfhi(p.w); }
                    u32x4 w; w.x = pk2(v[0], v[1]); w.y = pk2(v[2], v[3]); w.z = pk2(v[4], v[5]); w.w = pk2(v[6], v[7]);
                    *(u32x4*)((char*)MG + (mbase + (unsigned)((m * 16 * 1024 + bj * HALF) * 2))) = w;
                }
            asm volatile("" ::: "memory");
        }
    }
};
struct EpiPre1 {
    static constexpr bool PERM = true;
    const float* x; bf16_t* out;
    __device__ __forceinline__ void operator()(const f32x4 (&acc)[2][4][2], int ai, const Unit& u, int wr, int wc, int fr, int fq) const {
        const unsigned base = (unsigned)(u.pm * BM + ai * HALF + wr * 64 + fr) * DM + (unsigned)(u.pn * BM + wc * 32 + 8 * fq);
#pragma unroll
        for (int mh = 0; mh < 2; ++mh) {
            f32x4 xv[2][2][2];
#pragma unroll
            for (int mm = 0; mm < 2; ++mm)
#pragma unroll
                for (int bj = 0; bj < 2; ++bj)
#pragma unroll
                    for (int n = 0; n < 2; ++n)
                        xv[mm][bj][n] = *(const f32x4*)((const char*)x + (base + (unsigned)(((mh * 2 + mm) * 16) * DM + bj * HALF + n * 4)) * 4u);
#pragma unroll
            for (int mm = 0; mm < 2; ++mm)
#pragma unroll
                for (int bj = 0; bj < 2; ++bj) {
                    const f32x4 a = acc[bj][mh * 2 + mm][0] + xv[mm][bj][0] * DN_ALPHA, b = acc[bj][mh * 2 + mm][1] + xv[mm][bj][1] * DN_ALPHA;
                    u32x4 o; o.x = pk2(a[0], a[1]); o.y = pk2(a[2], a[3]); o.z = pk2(b[0], b[1]); o.w = pk2(b[2], b[3]);
                    *(u32x4*)((char*)out + (base + (unsigned)(((mh * 2 + mm) * 16) * DM + bj * HALF)) * 2u) = o;
                }
            asm volatile("" ::: "memory");
        }
    }
};
struct EpiSwiGLU {
    static constexpr bool PERM = true;
    bf16_t* H;
    __device__ __forceinline__ void operator()(const f32x4 (&acc)[2][4][2], int ai, const Unit& u, int wr, int wc, int fr, int fq) const {
        const int row0 = u.pm * BM + ai * HALF + wr * 64 + fr, col0 = u.pn * 128 + wc * 16 + 4 * fq;
#pragma unroll
        for (int m = 0; m < 4; ++m)
#pragma unroll
            for (int bj = 0; bj < 2; ++bj) {
                const f32x4 g = acc[bj][m][0], up = acc[bj][m][1];
                u32x2 w; w.x = pk2(silu(g[0]) * up[0], silu(g[1]) * up[1]); w.y = pk2(silu(g[2]) * up[2], silu(g[3]) * up[3]);
                *(u32x2*)(H + (size_t)(row0 + m * 16) * DE + col0 + bj * 64) = w;
            }
    }
};
struct EpiDown {
    static constexpr bool PERM = true;
    bf16_t* Y;
    __device__ __forceinline__ void operator()(const f32x4 (&acc)[2][4][2], int ai, const Unit& u, int wr, int wc, int fr, int fq) const {
        const unsigned base = ((unsigned)(u.pm * BM + ai * HALF + wr * 64 + fr) * DM + (unsigned)(u.pn * BM + wc * 32 + 8 * fq)) * 2u;
#pragma unroll
        for (int m = 0; m < 4; ++m)
#pragma unroll
            for (int bj = 0; bj < 2; ++bj) {
                const f32x4 a = acc[bj][m][0], b = acc[bj][m][1];
                u32x4 o; o.x = pk2(a[0], a[1]); o.y = pk2(a[2], a[3]); o.z = pk2(b[0], b[1]); o.w = pk2(b[2], b[3]);
                *(u32x4*)((char*)Y + (base + (unsigned)((m * 16 * DM + bj * HALF) * 2))) = o;
            }
    }
};

template <class Prob, class Epi>
__device__ __forceinline__ void gemm_phase_naive(const Prob& P, const Epi& E) {
    const int tid = threadIdx.x, wid = tid >> 6, lane = tid & 63, wr = wid >> 2, wc = wid & 3, fr = lane & 15, fq = lane >> 4;
    const int K = P.K;
    Unit u;
    for (int i = 0; P.next(i, u); ++i) {
        const char* bB = P.b_base(u);
        for (int ai = 0; ai < 2; ++ai) {
            f32x4 acc[2][4][2];
#pragma unroll
            for (int b = 0; b < 2; ++b)
#pragma unroll
                for (int m = 0; m < 4; ++m)
#pragma unroll
                    for (int n = 0; n < 2; ++n) acc[b][m][n] = (f32x4){0.f, 0.f, 0.f, 0.f};
            unsigned ro[4];
#pragma unroll
            for (int m = 0; m < 4; ++m) ro[m] = P.a_rowoff(u, ai * HALF + wr * 64 + m * 16 + fr);
#pragma unroll 1
            for (int k = 0; k < K; k += 4) {
                u32x2 ap[4];
#pragma unroll
                for (int m = 0; m < 4; ++m) ap[m] = *(const u32x2*)(P.Abase + (ro[m] + (unsigned)k * 2u));
#pragma unroll
                for (int bj = 0; bj < 2; ++bj)
#pragma unroll
                    for (int n = 0; n < 2; ++n)
#pragma unroll
                        for (int j = 0; j < 4; ++j) {
                            const unsigned col = (unsigned)(bj * HALF + wc * 32 + (Epi::PERM ? (8 * fq + 4 * n + j) : (16 * n + 4 * fq + j)));
                            const u32x2 b = *(const u32x2*)(bB + (col * (unsigned)K + (unsigned)k) * 2u);
                            const float b0 = bflo(b.x), b1 = bfhi(b.x), b2 = bflo(b.y), b3 = bfhi(b.y);
#pragma unroll
                            for (int m = 0; m < 4; ++m) {
                                const u32x2 a = ap[m];
                                float s = acc[bj][m][n][j];
                                s = fmaf(bflo(a.x), b0, s); s = fmaf(bfhi(a.x), b1, s); s = fmaf(bflo(a.y), b2, s); s = fmaf(bfhi(a.y), b3, s);
                                acc[bj][m][n][j] = s;
                            }
                        }
                asm volatile("" ::: "memory");
            }
            E(acc, ai, u, wr, wc, fr, fq);
        }
    }
}

template <class Prob, class Epi, bool ALIGN_EPI, bool SP2>
__device__ __forceinline__ void gemm_phase_mfma(LAS unsigned char* lds, const Prob& P, const Epi& E) {
    const int tid = threadIdx.x, wid = __builtin_amdgcn_readfirstlane(tid >> 6), lane = tid & 63, wr = wid >> 2, wc = wid & 3, fr = lane & 15, fq = lane >> 4;
    const int K = P.K, nt = K / BK;
    int Ra[2]; unsigned Ca[2], voffB[2];
#pragma unroll
    for (int i = 0; i < 2; ++i) { int R, C; stage_rc(tid * 16 + i * 8192, R, C); const int Rb = Epi::PERM ? ((R & ~31) + perm32(R & 31)) : R;
        Ra[i] = R; Ca[i] = (unsigned)C * 2u; voffB[i] = (unsigned)(Rb * K + C) * 2u; }
    const size_t kstep = (size_t)(BK * 2);
    const size_t hstep = (size_t)HALF * K * 2;
    const unsigned ldsw = (unsigned)wid * 1024u;
    const int aoff = lds_byte(wr * 64 + fr, fq * 8), boff = lds_byte(wc * 32 + fr, fq * 8);
#define PG8_SA(b, h) (((b) * 2 + (h)) * HTB)
#define PG8_SB(b, h) ((4 + (b) * 2 + (h)) * HTB)
#define PG8_STAGEB(bufoff, gbase) do { _Pragma("unroll") for (int _i = 0; _i < 2; ++_i) \
        __builtin_amdgcn_global_load_lds((const unsigned*)((const char*)(gbase) + voffB[_i]), (LAS unsigned*)(lds + (bufoff) + ldsw + _i * 8192), 16, 0, 0); } while (0)
#define PG8_STAGEA(bufoff, gbase, v0, v1) do { \
        __builtin_amdgcn_global_load_lds((const unsigned*)((const char*)(gbase) + (v0)), (LAS unsigned*)(lds + (bufoff) + ldsw), 16, 0, 0); \
        __builtin_amdgcn_global_load_lds((const unsigned*)((const char*)(gbase) + (v1)), (LAS unsigned*)(lds + (bufoff) + ldsw + 8192), 16, 0, 0); } while (0)
#define PG8_LDA(dst, b, h) do { _Pragma("unroll") for (int m = 0; m < 4; ++m) _Pragma("unroll") for (int k = 0; k < 2; ++k) dst[m][k] = *(const LAS bf16x8*)(lds + PG8_SA(b, h) + aoff + m * 2048 + k * 1024); } while (0)
#define PG8_LDB(dst, b, h) do { _Pragma("unroll") for (int n = 0; n < 2; ++n) _Pragma("unroll") for (int k = 0; k < 2; ++k) dst[n][k] = *(const LAS bf16x8*)(lds + PG8_SB(b, h) + boff + n * 2048 + k * 1024); } while (0)
#define PG8_MMA(ai, bj, At, Bt) do { __builtin_amdgcn_s_setprio(1); _Pragma("unroll") for (int m = 0; m < 4; ++m) _Pragma("unroll") for (int n = 0; n < 2; ++n) _Pragma("unroll") for (int k = 0; k < 2; ++k) \
        acc[ai][bj][m][n] = __builtin_amdgcn_mfma_f32_16x16x32_bf16(Bt[n][k], At[m][k], acc[ai][bj][m][n], 0, 0, 0); __builtin_amdgcn_s_setprio(0); } while (0)
#define PG8_WAIT_V(n) asm volatile("s_waitcnt vmcnt(" #n ")" ::: "memory")
#define PG8_WAIT_L(n) asm volatile("s_waitcnt lgkmcnt(" #n ")" ::: "memory")
#define PG8_BAR __builtin_amdgcn_s_barrier()
#define PG8_SCHED __builtin_amdgcn_sched_barrier(0)
    Unit cur, nxt; int ui = 0;
    if (!P.next(0, cur)) return;
    f32x4 acc[2][2][4][2];
#pragma unroll
    for (int a = 0; a < 2; ++a)
#pragma unroll
        for (int b = 0; b < 2; ++b)
#pragma unroll
            for (int m = 0; m < 4; ++m)
#pragma unroll
                for (int n = 0; n < 2; ++n) acc[a][b][m][n] = (f32x4){0.f, 0.f, 0.f, 0.f};
    bf16x8 At[4][2], B0[2][2], B1[2][2];
    const char* const cA = P.Abase;
    const char* cB = P.b_base(cur);
    unsigned va0, va1, va2, va3;
    va0 = P.a_rowoff(cur, Ra[0]) + Ca[0]; va1 = P.a_rowoff(cur, Ra[1]) + Ca[1]; va2 = P.a_rowoff(cur, HALF + Ra[0]) + Ca[0]; va3 = P.a_rowoff(cur, HALF + Ra[1]) + Ca[1];
    if constexpr (SP2) {
        PG8_STAGEB(PG8_SB(0, 0), cB); PG8_STAGEB(PG8_SB(0, 1), cB + hstep); PG8_STAGEA(PG8_SA(0, 0), cA, va0, va1); PG8_STAGEA(PG8_SA(0, 1), cA, va2, va3);
        if (wr == 1) PG8_BAR;
        PG8_WAIT_V(2); PG8_BAR;
        PG8_STAGEB(PG8_SB(1, 0), cB + kstep); PG8_STAGEA(PG8_SA(1, 0), cA + kstep, va0, va1); PG8_STAGEB(PG8_SB(1, 1), cB + hstep + kstep);
        PG8_WAIT_V(6); PG8_BAR;
    } else {
        PG8_STAGEB(PG8_SB(0, 0), cB); PG8_STAGEA(PG8_SA(0, 0), cA, va0, va1); PG8_STAGEB(PG8_SB(0, 1), cB + hstep); PG8_STAGEA(PG8_SA(0, 1), cA, va2, va3);
        if (wr == 1) PG8_BAR;
        PG8_WAIT_V(4); PG8_BAR;
        PG8_STAGEB(PG8_SB(1, 0), cB + kstep); PG8_STAGEA(PG8_SA(1, 0), cA + kstep, va0, va1); PG8_STAGEB(PG8_SB(1, 1), cB + hstep + kstep);
        PG8_WAIT_V(6); PG8_BAR;
    }
    for (;;) {
        const bool has_next = P.next(ui + 1, nxt);
        unsigned vn0 = va0, vn1 = va1, vn2 = va2, vn3 = va3; const char* nB = cB;
        if (has_next) { nB = P.b_base(nxt);
            vn0 = P.a_rowoff(nxt, Ra[0]) + Ca[0]; vn1 = P.a_rowoff(nxt, Ra[1]) + Ca[1]; vn2 = P.a_rowoff(nxt, HALF + Ra[0]) + Ca[0]; vn3 = P.a_rowoff(nxt, HALF + Ra[1]) + Ca[1]; }
        for (int t = 0; t < nt; t += 2) {
            const bool last = (t == nt - 2);
            const char* a1 = cA + (size_t)(t + 1) * kstep;
            const char* a2 = last ? cA : cA + (size_t)(t + 2) * kstep; const char* b2 = last ? nB : cB + (size_t)(t + 2) * kstep;
            const char* a3 = a2 + kstep; const char* b3 = b2 + kstep;
            const unsigned w0 = last ? vn0 : va0, w1 = last ? vn1 : va1, w2 = last ? vn2 : va2, w3 = last ? vn3 : va3;
            if constexpr (SP2) {
            PG8_LDB(B0, 0, 0); PG8_LDB(B1, 0, 1); PG8_SCHED; PG8_LDA(At, 0, 0); PG8_STAGEA(PG8_SA(1, 1), a1, va2, va3);
            PG8_WAIT_V(8); PG8_WAIT_L(0); PG8_BAR; PG8_MMA(0, 0, At, B0); PG8_MMA(0, 1, At, B1); PG8_BAR; PG8_SCHED;
            PG8_LDA(At, 0, 1); PG8_STAGEB(PG8_SB(0, 0), b2); PG8_STAGEB(PG8_SB(0, 1), b2 + hstep); PG8_STAGEA(PG8_SA(0, 0), a2, w0, w1);
            PG8_WAIT_V(8); PG8_WAIT_L(0); PG8_BAR; PG8_MMA(1, 0, At, B0); PG8_MMA(1, 1, At, B1); PG8_BAR; PG8_SCHED;
            PG8_LDB(B0, 1, 0); PG8_LDB(B1, 1, 1); PG8_SCHED; PG8_LDA(At, 1, 0); PG8_STAGEA(PG8_SA(0, 1), a2, w2, w3);
            PG8_WAIT_V(8); PG8_WAIT_L(0); PG8_BAR; PG8_MMA(0, 0, At, B0); PG8_MMA(0, 1, At, B1); PG8_BAR; PG8_SCHED;
            PG8_LDA(At, 1, 1); PG8_STAGEB(PG8_SB(1, 0), b3); PG8_STAGEB(PG8_SB(1, 1), b3 + hstep); PG8_STAGEA(PG8_SA(1, 0), a3, w0, w1);
            PG8_WAIT_V(8); PG8_WAIT_L(0); PG8_BAR; PG8_MMA(1, 0, At, B0); PG8_MMA(1, 1, At, B1); PG8_BAR; PG8_SCHED;
            } else {
            PG8_LDB(B0, 0, 0); PG8_SCHED; PG8_LDA(At, 0, 0); PG8_STAGEA(PG8_SA(1, 1), a1, va2, va3);
            PG8_WAIT_L(8); PG8_BAR; PG8_WAIT_L(0); PG8_MMA(0, 0, At, B0); PG8_BAR; PG8_SCHED;
            PG8_LDB(B1, 0, 1); PG8_STAGEB(PG8_SB(0, 0), b2);
            PG8_BAR; PG8_WAIT_L(0); PG8_MMA(0, 1, At, B1); PG8_BAR;
            PG8_LDA(At, 0, 1); PG8_STAGEA(PG8_SA(0, 0), a2, w0, w1);
            PG8_BAR; PG8_WAIT_L(0); PG8_MMA(1, 0, At, B0); PG8_BAR; PG8_SCHED;
            PG8_STAGEB(PG8_SB(0, 1), b2 + hstep);
            PG8_WAIT_V(6); PG8_BAR; PG8_MMA(1, 1, At, B1); PG8_BAR;
            PG8_LDB(B0, 1, 0); PG8_SCHED; PG8_LDA(At, 1, 0); PG8_STAGEA(PG8_SA(0, 1), a2, w2, w3);
            PG8_WAIT_L(8); PG8_BAR; PG8_WAIT_L(0); PG8_MMA(0, 0, At, B0); PG8_BAR; PG8_SCHED;
            PG8_LDB(B1, 1, 1); PG8_STAGEB(PG8_SB(1, 0), b3);
            PG8_BAR; PG8_WAIT_L(0); PG8_MMA(0, 1, At, B1); PG8_BAR;
            PG8_LDA(At, 1, 1); PG8_STAGEA(PG8_SA(1, 0), a3, w0, w1);
            PG8_BAR; PG8_WAIT_L(0); PG8_MMA(1, 0, At, B0); PG8_BAR; PG8_SCHED;
            PG8_STAGEB(PG8_SB(1, 1), b3 + hstep);
            PG8_WAIT_V(6); PG8_BAR; PG8_MMA(1, 1, At, B1); PG8_BAR;
            }
        }
        if constexpr (ALIGN_EPI) { if (wr == 0) PG8_BAR; }
        E(acc[0], 0, cur, wr, wc, fr, fq); E(acc[1], 1, cur, wr, wc, fr, fq);
        if (!has_next) break;
#pragma unroll
        for (int a = 0; a < 2; ++a)
#pragma unroll
            for (int b = 0; b < 2; ++b)
#pragma unroll
                for (int m = 0; m < 4; ++m)
#pragma unroll
                    for (int n = 0; n < 2; ++n) acc[a][b][m][n] = (f32x4){0.f, 0.f, 0.f, 0.f};
        cur = nxt; cB = nB; va0 = vn0; va1 = vn1; va2 = vn2; va3 = vn3; ++ui;
        if constexpr (ALIGN_EPI) { if (wr == 1) PG8_BAR; }
    }
    PG8_WAIT_V(0);
    if constexpr (!ALIGN_EPI) { if (wr == 0) PG8_BAR; }
    PG8_BAR;
#undef PG8_SA
#undef PG8_SB
#undef PG8_STAGEA
#undef PG8_STAGEB
#undef PG8_LDA
#undef PG8_LDB
#undef PG8_MMA
#undef PG8_WAIT_V
#undef PG8_WAIT_L
#undef PG8_BAR
#undef PG8_SCHED
}

template <class Prob, class Epi>
__device__ __forceinline__ void gemm_phase(LAS unsigned char* lds, const Prob& P, const Epi& E) {
#if NAIVE_GEMM
    gemm_phase_naive<Prob, Epi>(P, E);
#else
    gemm_phase_mfma<Prob, Epi, true, true>(lds, P, E);
#endif
}

#define XB_TMO      128
#define XB_XCNT(j)  (256  + 64 * (j))
#define XB_XSUB(j)  (1280 + 64 * (j))
#define XB_XGEN(j)  (2304 + 64 * (j))
#define XB_TOP      3328
#define XB_TOPGEN   3392
#define XCD_BAR_WORDS 3456
#define XB_SPIN_CAP (1u << 18)
__device__ __forceinline__ unsigned xb_ld(unsigned* p)              { return __hip_atomic_load(p, __ATOMIC_RELAXED, __HIP_MEMORY_SCOPE_AGENT); }
__device__ __forceinline__ unsigned xb_add(unsigned* p, unsigned v) { return __hip_atomic_fetch_add(p, v, __ATOMIC_RELAXED, __HIP_MEMORY_SCOPE_AGENT); }
__device__ __forceinline__ unsigned xb_xcc_id() { return (unsigned)__builtin_amdgcn_s_getreg((3 << 11) | 20) & 0xFu; }
#define XB_SPIN(cond, bar) do { unsigned _sp = 0; while (cond) { __builtin_amdgcn_s_sleep(1); \
    if ((++_sp & 255u) == 0u) { if (xb_ld(&(bar)[XB_TMO])) break; if (_sp > XB_SPIN_CAP) { atomicAdd(&(bar)[XB_TMO], 1u); break; } } } } while (0)
struct XcdBarrier { unsigned* bar; unsigned x; volatile LAS unsigned* st; };
__device__ __forceinline__ XcdBarrier xcd_barrier_post(unsigned* bar, volatile LAS unsigned* st) {
    XcdBarrier b; b.bar = bar; b.x = xb_xcc_id(); b.st = st;
    if (threadIdx.x == 0) (void)xb_add(&bar[XB_XCNT(b.x)], 1u);
    return b;
}
__device__ __forceinline__ void xcd_barrier_complete(unsigned* bar, unsigned x, unsigned& nloc, unsigned& nx) {
    const unsigned G = gridDim.x * gridDim.y * gridDim.z;
    unsigned sum, cnt, mine, sp = 0u;
    for (;;) {
        sum = 0u; cnt = 0u; mine = 0u;
#pragma unroll
        for (unsigned j = 0; j < 16; ++j) { const unsigned c = xb_ld(&bar[XB_XCNT(j)]); sum += c; cnt += (c > 0u) ? 1u : 0u; mine = (j == x) ? c : mine; }
        if (sum == G) break;
        __builtin_amdgcn_s_sleep(1);
        if ((++sp & 255u) == 0u) { if (xb_ld(&bar[XB_TMO])) break; if (sp > XB_SPIN_CAP) { atomicAdd(&bar[XB_TMO], 1u); break; } }
    }
    nloc = mine > 0u ? mine : 1u; nx = cnt > 0u ? cnt : 1u;
}
__device__ __forceinline__ void xcd_barrier(const XcdBarrier& b) {
    asm volatile("s_waitcnt vmcnt(0)" ::: "memory");
    __syncthreads();
    if (threadIdx.x == 0) {
        unsigned* bar = b.bar;
        __builtin_amdgcn_s_waitcnt(0);
        unsigned nloc = b.st[0], nx = b.st[1];
        if (nloc == 0u) { xcd_barrier_complete(bar, b.x, nloc, nx); b.st[0] = nloc; b.st[1] = nx; }
        const unsigned old = xb_add(&bar[XB_XSUB(b.x)], 1u);
        const unsigned gen = old / nloc;
        if (old + 1u == (gen + 1u) * nloc) {
            __builtin_amdgcn_fence(__ATOMIC_RELEASE, "agent");
            asm volatile("s_waitcnt vmcnt(0)" ::: "memory");
            const unsigned og = xb_add(&bar[XB_TOP], 1u);
            const unsigned tg = og / nx;
            if (og + 1u == (tg + 1u) * nx) xb_add(&bar[XB_TOPGEN], 1u);
            else XB_SPIN(xb_ld(&bar[XB_TOPGEN]) == tg, bar);
            __builtin_amdgcn_fence(__ATOMIC_ACQUIRE, "agent");
            xb_add(&bar[XB_XGEN(b.x)], 1u);
            asm volatile("s_waitcnt vmcnt(0)" ::: "memory");
        } else {
            XB_SPIN(xb_ld(&bar[XB_XGEN(b.x)]) == gen, bar);
            __builtin_amdgcn_fence(__ATOMIC_ACQUIRE, "agent");
            asm volatile("s_waitcnt vmcnt(0)" ::: "memory");
        }
    }
    __syncthreads();
}

struct Args {
    const float* in[19]; float* out; unsigned char* ws; int ph_lo, ph_hi, coop, pad;
};

struct TDesc { const float* W; bf16_t* WT; int K, N, mode, item; };
__device__ __forceinline__ void t_load(const TDesc& d, f32x4 (&v)[8], int lane) {
    const int nblk = d.N / 32, kb = d.item / nblk, nb = d.item % nblk, k0 = 64 * kb, n0 = 32 * nb;
#pragma unroll
    for (int i = 0; i < 8; ++i) { const int idx = lane + 64 * i, kk = idx >> 3, n4 = idx & 7; v[i] = *(const f32x4*)(d.W + (size_t)(k0 + kk) * d.N + n0 + 4 * n4); }
}
__device__ __forceinline__ void t_finish(const TDesc& d, const f32x4 (&v)[8], LAS float* scr, int lane) {
    const int nblk = d.N / 32, kb = d.item / nblk, nb = d.item % nblk, k0 = 64 * kb, n0 = 32 * nb;
#pragma unroll
    for (int i = 0; i < 8; ++i) { const int idx = lane + 64 * i, kk = idx >> 3, n4 = idx & 7; LAS float* p = scr + kk * 33 + 4 * n4; p[0] = v[i][0]; p[1] = v[i][1]; p[2] = v[i][2]; p[3] = v[i][3]; }
    LDS_WAIT();
    const int c = lane & 7;
#pragma unroll
    for (int j = 0; j < 4; ++j) { const int n = (lane >> 3) + 8 * j; const LAS float* sp = scr + (8 * c) * 33 + n;
        u32x4 o; o.x = pk2(sp[0 * 33], sp[1 * 33]); o.y = pk2(sp[2 * 33], sp[3 * 33]); o.z = pk2(sp[4 * 33], sp[5 * 33]); o.w = pk2(sp[6 * 33], sp[7 * 33]);
        const int ng = n0 + n; const int row = (d.mode == 0) ? ng : ((ng >> 2) * 8 + (d.mode == 2 ? 4 : 0) + (ng & 3));
        *(u32x4*)(d.WT + (size_t)row * d.K + k0 + 8 * c) = o; }
    LDS_WAIT();
}
constexpr int TI_A = (512 / 64) * (DM / 32), TI_O = (DM / 64) * (DM / 32), TI_G = (DM / 64) * (DE / 32), TI_D = (DE / 64) * (DM / 32), TI_IN = (DM / 64) * (PW / 32);
constexpr int TI_REST = 2 * TI_A + TI_O + NE * (2 * TI_G + TI_D);
__device__ __forceinline__ TDesc t_decode_rest(const Args& a, int it) {
    unsigned char* ws = a.ws; TDesc d; int r = it;
    if (r < TI_A) { d = TDesc{a.in[5], (bf16_t*)(ws + WS_WA), 512, DM, 0, r}; return d; } r -= TI_A;
    if (r < TI_A) { d = TDesc{a.in[6], (bf16_t*)(ws + WS_WB), 512, DM, 0, r}; return d; } r -= TI_A;
    if (r < TI_O) { d = TDesc{a.in[7], (bf16_t*)(ws + WS_WO), DM, DM, 0, r}; return d; } r -= TI_O;
    const int e = r / (2 * TI_G + TI_D); r -= e * (2 * TI_G + TI_D);
    if (r < TI_G) { d = TDesc{a.in[14] + (size_t)e * DM * DE, (bf16_t*)(ws + WS_WGU) + (size_t)e * DM * DM, DM, DE, 1, r}; return d; } r -= TI_G;
    if (r < TI_G) { d = TDesc{a.in[15] + (size_t)e * DM * DE, (bf16_t*)(ws + WS_WGU) + (size_t)e * DM * DM, DM, DE, 2, r}; return d; } r -= TI_G;
    d = TDesc{a.in[16] + (size_t)e * DE * DM, (bf16_t*)(ws + WS_WD) + (size_t)e * DM * DE, DE, DM, 0, r}; return d;
}
__device__ __forceinline__ void p0_rest(const Args& a, LAS unsigned char* lds, int gw, int NGW) {
    const int tid = threadIdx.x, lane = tid & 63, wave = tid >> 6;
    LAS float* scr = (LAS float*)(lds + wave * 16384);
    f32x4 va[8], vb[8];
    int it = gw;
    if (it >= TI_REST) return;
    TDesc dc = t_decode_rest(a, it); t_load(dc, va, lane);
    for (;;) {
        const int itn = it + NGW; const bool more = itn < TI_REST;
        TDesc dn = dc; if (more) { dn = t_decode_rest(a, itn); t_load(dn, vb, lane); }
        t_finish(dc, va, scr, lane);
        if (!more) break;
        const int itn2 = itn + NGW; const bool more2 = itn2 < TI_REST;
        if (more2) { dc = t_decode_rest(a, itn2); t_load(dc, va, lane); }
        t_finish(dn, vb, scr, lane);
        if (!more2) break;
        it = itn2;
    }
}
__device__ __forceinline__ void p0_prologue(const Args& a, LAS unsigned char* lds) {
    const int tid = threadIdx.x, lane = tid & 63, wave = tid >> 6;
    unsigned char* ws = a.ws;
    LAS float* scr = (LAS float*)(lds + wave * 16384);
    const int gw = blockIdx.x * NWAVES + wave, NGW = gridDim.x * NWAVES;
    for (int it = gw; it < TI_IN; it += NGW) { TDesc d{a.in[2], (bf16_t*)(ws + WS_WIN), DM, PW, 0, it}; f32x4 v[8]; t_load(d, v, lane); t_finish(d, v, scr, lane); }
    {
        const f32x4* x4 = (const f32x4*)a.in[0]; u32x4* o = (u32x4*)(ws + WS_RA);
        const size_t n8 = (size_t)T_ * DM / 8, stride = (size_t)gridDim.x * NTHREADS;
        for (size_t i = (size_t)blockIdx.x * NTHREADS + tid; i < n8; i += 4 * stride) {
            f32x4 p[4], q[4];
#pragma unroll
            for (int j = 0; j < 4; ++j) { const size_t ii = i + j * stride; if (ii < n8) { p[j] = x4[2 * ii]; q[j] = x4[2 * ii + 1]; } }
#pragma unroll
            for (int j = 0; j < 4; ++j) { const size_t ii = i + j * stride; if (ii < n8) {
                u32x4 w; w.x = pk2(p[j][0], p[j][1]); w.y = pk2(p[j][2], p[j][3]); w.z = pk2(q[j][0], q[j][1]); w.w = pk2(q[j][2], q[j][3]);
                o[ii] = w; } }
        }
    }
    if (blockIdx.x == 0) {
        float* lb = (float*)(ws + WS_LB); const float* lg = a.in[1];
        lb[tid] = 1.f / (1.f + __expf(lg[512 + tid] - lg[tid]));
        unsigned* ctl = (unsigned*)(ws + WS_CTL);
        if (tid < 32) ctl[CW_CNT + tid] = 0u;
        if (tid == 32) ctl[CW_ATTQ] = 0u;
    }
}

__device__ __forceinline__ void hgrn_naive(LAS unsigned char* lds, const bf16_t* HB, const float* normw, bf16_t* OH, int item) {
    const int tid = threadIdx.x, lane = tid & 63, wave = tid >> 6, v = tid & 127, kg = tid >> 7;
    const int b = item >> 2, h = item & 3;
    LAS float* sq = (LAS float*)lds;
    LAS float* sf = sq + 64 * 128;
    LAS float* sv = sf + 64 * 128;
    LAS float* so = sv + 64 * 128;
    LAS float* sp = so + 64 * 128;
    float S[32];
#pragma unroll
    for (int i = 0; i < 32; ++i) S[i] = 0.f;
    for (int c = 0; c < 32; ++c) {
        const size_t row0 = (size_t)b * SEQ + c * 64;
        for (int i = 0; i < 16; ++i) { const int idx = tid + 512 * i, r = idx >> 7, col = idx & 127; const bf16_t* p = HB + (row0 + r) * 2048 + h * 128 + col;
            sq[idx] = bf2f(p[0]); sf[idx] = __expf(bf2f(p[512])); sv[idx] = bf2f(p[1024]); }
        __syncthreads();
        for (int t = 0; t < 64; ++t) {
            const float vt = sv[t * 128 + v]; float part = 0.f;
#pragma unroll
            for (int i = 0; i < 32; ++i) { const float f = sf[t * 128 + kg * 32 + i]; S[i] = f * S[i] + (1.f - f) * vt; part += sq[t * 128 + kg * 32 + i] * S[i]; }
            sp[((t & 1) * 4 + kg) * 128 + v] = part;
            __syncthreads();
            if (kg == 0) { const LAS float* q = sp + (t & 1) * 4 * 128 + v; so[t * 128 + v] = (q[0] + q[128]) + (q[256] + q[384]); }
        }
        __syncthreads();
        for (int tt = 0; tt < 8; ++tt) { const int t = wave * 8 + tt; const float o0 = so[t * 128 + lane], o1 = so[t * 128 + 64 + lane];
            const float ss = wave_sum(o0 * o0 + o1 * o1); const float rstd = rsqrtf(ss * (1.f / 128.f) + RMS_EPS);
            const bf16_t* g = HB + (row0 + t) * 2048 + 1536 + h * 128; bf16_t* o = OH + (row0 + t) * 512 + h * 128;
            o[lane] = (bf16_t)f2bf(o0 * rstd * normw[lane] * bf2f(g[lane])); o[64 + lane] = (bf16_t)f2bf(o1 * rstd * normw[64 + lane] * bf2f(g[64 + lane])); }
        __syncthreads();
    }
}

constexpr int HG_QS = 136, HG_TS = 72;
constexpr int HG_QT = 64 * HG_QS + 8 * 16;
#define HQ(t) ((t) * HG_QS + ((t) >> 3) * 16)
__device__ __forceinline__ void hgrn_mfma(LAS unsigned char* lds, const bf16_t* HB, const float* normw, bf16_t* OH, int item) {
    const int tid = threadIdx.x, lane = tid & 63, wave = __builtin_amdgcn_readfirstlane(tid >> 6), r16 = lane & 15, g = lane >> 4;
    const int b = item >> 2, h = item & 3;
    const int cpi = lane & 7, rg = lane >> 3;
    const int k0 = 16 * wave + 2 * cpi;
    LAS bf16_t* Qp = (LAS bf16_t*)lds;
    LAS bf16_t* Kp = Qp + HG_QT;
    LAS bf16_t* KppT = Kp + HG_QT;
    LAS bf16_t* VT = KppT + 128 * HG_TS;
    LAS bf16_t* Pm = VT + 128 * HG_TS;
    LAS bf16_t* Gs0 = Pm + 64 * HG_TS;
    LAS float* dl = (LAS float*)(Gs0 + 2 * HG_QT);
    LAS float* rs = dl + 128;
    SEC_DECL;
    f32x4 st[8];
#pragma unroll
    for (int kt = 0; kt < 8; ++kt) st[kt] = (f32x4){0.f, 0.f, 0.f, 0.f};
    const f32x4 nw4 = *(const f32x4*)(normw + 16 * wave + 4 * g);
    unsigned rqA[8], rfA[8], rvA[8], rgA[8], rqB[8], rfB[8], rvB[8], rgB[8];
    {
        const unsigned* p32 = (const unsigned*)(HB + ((size_t)b * SEQ + 8 * rg) * 2048 + h * 128 + k0);
#pragma unroll
        for (int i = 0; i < 8; ++i) { rqA[i] = p32[(size_t)i * 1024]; rfA[i] = p32[(size_t)i * 1024 + 256]; rvA[i] = p32[(size_t)i * 1024 + 512]; rgA[i] = p32[(size_t)i * 1024 + 768]; }
        p32 += (size_t)64 * 1024;
#pragma unroll
        for (int i = 0; i < 8; ++i) { rqB[i] = p32[(size_t)i * 1024]; rfB[i] = p32[(size_t)i * 1024 + 256]; rvB[i] = p32[(size_t)i * 1024 + 512]; rgB[i] = p32[(size_t)i * 1024 + 768]; }
    }
    __syncthreads();
#define HG_BODY(cc, rq, rf, rv, rg_) do { const int c = (cc); \
        const size_t row0 = (size_t)b * SEQ + c * 64; \
        LAS bf16_t* Gs = Gs0 + (c & 1) * HG_QT; \
        SEC_MARK(0); \
        { \
            float f0[8], f1[8], c0[8], c1[8]; float run0 = 1.f, run1 = 1.f; \
_Pragma("unroll") \
            for (int i = 0; i < 8; ++i) { f0[i] = __builtin_amdgcn_exp2f(bflo(rf[i]) * 1.4426950408889634f); f1[i] = __builtin_amdgcn_exp2f(bfhi(rf[i]) * 1.4426950408889634f); run0 *= f0[i]; run1 *= f1[i]; c0[i] = run0; c1[i] = run1; } \
            float inc0 = run0, inc1 = run1; \
_Pragma("unroll") \
            for (int d = 8; d < 64; d <<= 1) { const float y0 = __shfl_up(inc0, d), y1 = __shfl_up(inc1, d); if (lane >= d) { inc0 *= y0; inc1 *= y1; } } \
            float off0 = __shfl_up(inc0, 8), off1 = __shfl_up(inc1, 8); if (rg == 0) { off0 = 1.f; off1 = 1.f; } \
            const float dl0 = __shfl(inc0, 56 + cpi), dl1 = __shfl(inc1, 56 + cpi); \
            if (rg == 0) *(LAS f32x2*)(dl + k0) = (f32x2){dl0, dl1}; \
            float kq0[8], kq1[8]; \
_Pragma("unroll") \
            for (int i = 0; i < 8; ++i) { \
                const float eb0 = off0 * c0[i], eb1 = off1 * c1[i], rb0 = __builtin_amdgcn_rcpf(eb0), rb1 = __builtin_amdgcn_rcpf(eb1); \
                const float kp0 = (1.f - f0[i]) * rb0, kp1 = (1.f - f1[i]) * rb1; \
                const int t = 8 * rg + i; \
                *(LAS unsigned*)(Qp + HQ(t) + k0) = pk2(bflo(rq[i]) * eb0, bfhi(rq[i]) * eb1); \
                *(LAS unsigned*)(Kp + HQ(t) + k0) = pk2(kp0, kp1); \
                *(LAS unsigned*)(Gs + HQ(t) + k0) = rg_[i]; \
                kq0[i] = kp0 * dl0; kq1[i] = kp1 * dl1; \
            } \
            u32x4 w0; \
            w0.x = pk2(kq0[0], kq0[1]); w0.y = pk2(kq0[2], kq0[3]); w0.z = pk2(kq0[4], kq0[5]); w0.w = pk2(kq0[6], kq0[7]); \
            *(LAS u32x4*)(KppT + k0 * HG_TS + 8 * rg) = w0; \
            w0.x = pk2(kq1[0], kq1[1]); w0.y = pk2(kq1[2], kq1[3]); w0.z = pk2(kq1[4], kq1[5]); w0.w = pk2(kq1[6], kq1[7]); \
            *(LAS u32x4*)(KppT + (k0 + 1) * HG_TS + 8 * rg) = w0; \
            w0.x = (rv[0] & 0xffffu) | (rv[1] << 16); w0.y = (rv[2] & 0xffffu) | (rv[3] << 16); w0.z = (rv[4] & 0xffffu) | (rv[5] << 16); w0.w = (rv[6] & 0xffffu) | (rv[7] << 16); \
            *(LAS u32x4*)(VT + k0 * HG_TS + 8 * rg) = w0; \
            w0.x = (rv[0] >> 16) | (rv[1] & 0xffff0000u); w0.y = (rv[2] >> 16) | (rv[3] & 0xffff0000u); w0.z = (rv[4] >> 16) | (rv[5] & 0xffff0000u); w0.w = (rv[6] >> 16) | (rv[7] & 0xffff0000u); \
            *(LAS u32x4*)(VT + (k0 + 1) * HG_TS + 8 * rg) = w0; \
            if (c + 2 < 32) {                                                \
                const unsigned* p32 = (const unsigned*)(HB + (row0 + 128 + 8 * rg) * 2048 + h * 128 + k0); \
_Pragma("unroll") \
                for (int i = 0; i < 8; ++i) { rq[i] = p32[(size_t)i * 1024]; rf[i] = p32[(size_t)i * 1024 + 256]; rv[i] = p32[(size_t)i * 1024 + 512]; rg_[i] = p32[(size_t)i * 1024 + 768]; } \
            } \
        } \
        SEC_MARK(1); \
        __syncthreads(); \
        SEC_MARK(2); \
_Pragma("unroll") \
        for (int u = 0; u < 2; ++u) { \
            const int ti = 2 * wave + u, sti = ti >> 2, tti = ti & 3; \
            f32x4 d = (f32x4){0.f, 0.f, 0.f, 0.f}; \
            if (sti <= tti) { \
_Pragma("unroll") \
                for (int ks = 0; ks < 4; ++ks) { \
                    const bf16x8 ka = *(const LAS bf16x8*)(Kp + HQ(16 * sti + r16) + 32 * ks + 8 * g); \
                    const bf16x8 qb = *(const LAS bf16x8*)(Qp + HQ(16 * tti + r16) + 32 * ks + 8 * g); \
                    d = __builtin_amdgcn_mfma_f32_16x16x32_bf16(ka, qb, d, 0, 0, 0); \
                } \
            } \
            const int t = 16 * tti + r16, s0 = 16 * sti + 4 * g; \
            float pv[4]; \
_Pragma("unroll") \
            for (int r = 0; r < 4; ++r) pv[r] = (sti <= tti && s0 + r <= t) ? d[r] : 0.f; \
            u32x2 w; w.x = pk2(pv[0], pv[1]); w.y = pk2(pv[2], pv[3]); \
            *(LAS u32x2*)(Pm + t * HG_TS + s0) = w; \
        } \
        SEC_MARK(3); \
        __syncthreads(); \
        SEC_MARK(4); \
        bf16x8 vtf[2], sa[4]; \
_Pragma("unroll") \
        for (int ks = 0; ks < 2; ++ks) vtf[ks] = *(const LAS bf16x8*)(VT + (16 * wave + r16) * HG_TS + 32 * ks + 8 * g); \
_Pragma("unroll") \
        for (int q = 0; q < 4; ++q) { u32x4 w; w.x = pk2(st[2 * q][0], st[2 * q][1]); w.y = pk2(st[2 * q][2], st[2 * q][3]); w.z = pk2(st[2 * q + 1][0], st[2 * q + 1][1]); w.w = pk2(st[2 * q + 1][2], st[2 * q + 1][3]); \
            sa[q] = __builtin_bit_cast(bf16x8, w); } \
        f32x4 o[4]; \
_Pragma("unroll") \
        for (int tt = 0; tt < 4; ++tt) { \
            f32x4 d = (f32x4){0.f, 0.f, 0.f, 0.f}; \
            const int t = 16 * tt + r16; \
_Pragma("unroll") \
            for (int ks = 0; ks < 2; ++ks) { \
                const bf16x8 pb = *(const LAS bf16x8*)(Pm + t * HG_TS + 32 * ks + 8 * g); \
                d = __builtin_amdgcn_mfma_f32_16x16x32_bf16(vtf[ks], pb, d, 0, 0, 0); \
            } \
_Pragma("unroll") \
            for (int q = 0; q < 4; ++q) { \
                const u32x2 lo = *(const LAS u32x2*)(Qp + HQ(t) + 32 * q + 4 * g), hi = *(const LAS u32x2*)(Qp + HQ(t) + 32 * q + 16 + 4 * g); \
                u32x4 w; w.x = lo.x; w.y = lo.y; w.z = hi.x; w.w = hi.y; \
                d = __builtin_amdgcn_mfma_f32_16x16x32_bf16(sa[q], __builtin_bit_cast(bf16x8, w), d, 0, 0, 0); \
            } \
            o[tt] = d; \
            float ss = d[0] * d[0] + d[1] * d[1] + d[2] * d[2] + d[3] * d[3]; \
            ss += __shfl_xor(ss, 16); ss += __shfl_xor(ss, 32); \
            if (g == 0) rs[t * 8 + wave] = ss; \
        } \
_Pragma("unroll") \
        for (int kt = 0; kt < 8; ++kt) { \
            const f32x4 d4 = *(const LAS f32x4*)(dl + 16 * kt + 4 * g); \
            f32x4 d = st[kt] * d4; \
_Pragma("unroll") \
            for (int ks = 0; ks < 2; ++ks) { \
                const bf16x8 ka = *(const LAS bf16x8*)(KppT + (16 * kt + r16) * HG_TS + 32 * ks + 8 * g); \
                d = __builtin_amdgcn_mfma_f32_16x16x32_bf16(ka, vtf[ks], d, 0, 0, 0); \
            } \
            st[kt] = d; \
        } \
        SEC_MARK(5); \
        __syncthreads(); \
        SEC_MARK(6); \
_Pragma("unroll") \
        for (int tt = 0; tt < 4; ++tt) { \
            const int t = 16 * tt + r16; \
            const f32x4 a0 = *(const LAS f32x4*)(rs + t * 8), a1 = *(const LAS f32x4*)(rs + t * 8 + 4); \
            const float tot = ((a0[0] + a0[1]) + (a0[2] + a0[3])) + ((a1[0] + a1[1]) + (a1[2] + a1[3])); \
            const float rstd = rsqrtf(tot * (1.f / 128.f) + RMS_EPS); \
            const u32x2 gg = *(const LAS u32x2*)(Gs + HQ(t) + 16 * wave + 4 * g); \
            u32x2 w; w.x = pk2(o[tt][0] * rstd * nw4[0] * bflo(gg.x), o[tt][1] * rstd * nw4[1] * bfhi(gg.x)); w.y = pk2(o[tt][2] * rstd * nw4[2] * bflo(gg.y), o[tt][3] * rstd * nw4[3] * bfhi(gg.y)); \
            *(u32x2*)(OH + (row0 + t) * 512 + h * 128 + 16 * wave + 4 * g) = w; \
        } \
        SEC_MARK(7); \
          \
    } while (0)
    for (int c2 = 0; c2 < 32; c2 += 2) { HG_BODY(c2, rqA, rfA, rvA, rgA); HG_BODY(c2 + 1, rqB, rfB, rvB, rgB); }
#undef HG_BODY
    SEC_STORE(lds);
}

__device__ __forceinline__ void attn_naive(LAS unsigned char* lds, const bf16_t* AB, const float* sinks, bf16_t* OA, int item) {
    const int tid = threadIdx.x, lane = tid & 63, wave = tid >> 6;
    const int hk = item & 1, n = (item >> 1) & 15, b = item >> 5;
    LAS bf16_t* Ks = (LAS bf16_t*)lds;
    LAS bf16_t* Vs = Ks + 256 * 64;
    LAS float* qs = (LAS float*)(lds + 65536) + wave * 192;
    LAS float* ps = qs + 64;
    __syncthreads();
    for (int i = 0; i < 8; ++i) { const int ch = tid + 512 * i; const int kv = ch >> 11, rr = (ch >> 3) & 255, c8 = ch & 7; const int kp = n * 128 - 128 + rr;
        u32x4 val = (u32x4){0u, 0u, 0u, 0u};
        if (kp >= 0) val = *(const u32x4*)(AB + ((size_t)b * SEQ + kp) * 768 + 512 + kv * 128 + hk * 64 + c8 * 8);
        *(LAS u32x4*)((kv ? Vs : Ks) + rr * 64 + c8 * 8) = val; }
    __syncthreads();
    const int g = wave >> 1, head = hk * 4 + g; const float slope = exp2f(-(float)(head + 1)); const float sink = sinks[head];
    for (int ii = 0; ii < 64; ++ii) {
        const int i = (wave & 1) * 64 + ii; const size_t row = (size_t)b * SEQ + n * 128 + i;
        qs[lane] = bf2f(AB[row * 768 + head * 64 + lane]) * 0.6931471805599453f;
        LDS_WAIT();
        float s0 = 0.f, s1 = 0.f; const int j0 = i + 1 + lane, j1 = i + 65 + lane;
#pragma unroll
        for (int d8 = 0; d8 < 8; ++d8) {
            const u32x4 k0 = *(const LAS u32x4*)(Ks + j0 * 64 + d8 * 8), k1 = *(const LAS u32x4*)(Ks + j1 * 64 + d8 * 8);
            const f32x4 qa = *(const LAS f32x4*)(qs + d8 * 8), qb = *(const LAS f32x4*)(qs + d8 * 8 + 4);
            s0 += qa[0] * bflo(k0.x) + qa[1] * bfhi(k0.x) + qa[2] * bflo(k0.y) + qa[3] * bfhi(k0.y) + qb[0] * bflo(k0.z) + qb[1] * bfhi(k0.z) + qb[2] * bflo(k0.w) + qb[3] * bfhi(k0.w);
            s1 += qa[0] * bflo(k1.x) + qa[1] * bfhi(k1.x) + qa[2] * bflo(k1.y) + qa[3] * bfhi(k1.y) + qb[0] * bflo(k1.z) + qb[1] * bfhi(k1.z) + qb[2] * bflo(k1.w) + qb[3] * bfhi(k1.w);
        }
        const bool v0 = (n * 128 - 128 + j0) >= 0, v1 = (n * 128 - 128 + j1) >= 0;
        const float l0 = v0 ? s0 - slope * (float)(127 - lane) : -1e30f, l1 = v1 ? s1 - slope * (float)(63 - lane) : -1e30f;
        const float mx = fmaxf(wave_max(fmaxf(l0, l1)), sink);
        const float e0 = __expf(l0 - mx), e1 = __expf(l1 - mx);
        const float den = wave_sum(e0 + e1) + __expf(sink - mx); const float inv = 1.f / den;
        ps[lane] = e0 * inv; ps[64 + lane] = e1 * inv;
        LDS_WAIT();
        float o = 0.f;
#pragma unroll 8
        for (int jj = 0; jj < 128; ++jj) o += ps[jj] * bf2f(Vs[(i + 1 + jj) * 64 + lane]);
        OA[row * 512 + head * 64 + lane] = (bf16_t)f2bf(o);
        LDS_WAIT();
    }
}

constexpr int ATT_KS = 72, ATT_VS = 280;
struct AttnStage { u32x4 kv[4], vv[4]; };
__device__ __forceinline__ void attn_stage_load(AttnStage& st, const bf16_t* AB, int item) {
    const int tid = threadIdx.x; const int hk = item & 1, n = (item >> 1) & 15, b = item >> 5;
#pragma unroll
    for (int i = 0; i < 4; ++i) { const int ch = tid + 512 * i, rr = ch >> 3, c8 = ch & 7; const int kp = n * 128 - 128 + rr;
        st.kv[i] = (u32x4){0u, 0u, 0u, 0u}; st.vv[i] = (u32x4){0u, 0u, 0u, 0u};
        if (kp >= 0) { const bf16_t* p = AB + ((size_t)b * SEQ + kp) * 768 + 512 + hk * 64 + c8 * 8; st.kv[i] = *(const u32x4*)p; st.vv[i] = *(const u32x4*)(p + 128); } }
}
__device__ __forceinline__ void attn_mfma(LAS unsigned char* lds, const bf16_t* AB, const float* sinks, bf16_t* OA, int item, AttnStage& st, int nitem) {
    const int tid = threadIdx.x, lane = tid & 63, wave = __builtin_amdgcn_readfirstlane(tid >> 6), r16 = lane & 15, g = lane >> 4;
    const int hk = item & 1, n = (item >> 1) & 15, b = item >> 5;
    LAS bf16_t* Ks = (LAS bf16_t*)lds;
    LAS bf16_t* VT = Ks + 256 * ATT_KS;
    __syncthreads();
#pragma unroll
    for (int i = 0; i < 4; ++i) { const int ch = tid + 512 * i, rr = ch >> 3, c8 = ch & 7;
        const u32x4 kv = st.kv[i], vv = st.vv[i];
        *(LAS u32x4*)(Ks + rr * ATT_KS + c8 * 8) = kv;
        LAS bf16_t* vt = VT + (c8 * 8) * ATT_VS + rr;
        vt[0 * ATT_VS] = (bf16_t)(vv.x & 0xffffu); vt[1 * ATT_VS] = (bf16_t)(vv.x >> 16); vt[2 * ATT_VS] = (bf16_t)(vv.y & 0xffffu); vt[3 * ATT_VS] = (bf16_t)(vv.y >> 16);
        vt[4 * ATT_VS] = (bf16_t)(vv.z & 0xffffu); vt[5 * ATT_VS] = (bf16_t)(vv.z >> 16); vt[6 * ATT_VS] = (bf16_t)(vv.w & 0xffffu); vt[7 * ATT_VS] = (bf16_t)(vv.w >> 16); }
    *(LAS unsigned*)(VT + (tid >> 3) * ATT_VS + 256 + (tid & 7) * 2) = 0u;
    if (nitem >= 0) attn_stage_load(st, AB, nitem);
    __syncthreads();
    const int g4 = wave >> 1, qh = wave & 1, head = hk * 4 + g4;
    const float L2E = 1.4426950408889634f;
    const float slope = exp2f(-(float)(head + 1)) * L2E, sink = sinks[head] * L2E;
    const float c0 = slope * (float)(128 + r16 - 4 * g);
    bf16x8 QF[4][2];
#pragma unroll
    for (int qt = 0; qt < 4; ++qt) { const size_t qr = (size_t)b * SEQ + n * 128 + qh * 64 + qt * 16 + r16;
        QF[qt][0] = *(const bf16x8*)(AB + qr * 768 + head * 64 + 8 * g); QF[qt][1] = *(const bf16x8*)(AB + qr * 768 + head * 64 + 32 + 8 * g); }
#pragma unroll
    for (int qt = 0; qt < 4; ++qt) {
        const int q0 = qh * 64 + qt * 16;
        const size_t qrow = (size_t)b * SEQ + n * 128 + q0 + r16;
        const bf16x8 Q0 = QF[qt][0], Q1 = QF[qt][1];
        f32x4 sc[9];
#pragma unroll
        for (int t9 = 0; t9 < 9; ++t9) {
            const LAS bf16_t* kp = Ks + (q0 + t9 * 16 + r16) * ATT_KS + 8 * g;
            const bf16x8 K0 = *(const LAS bf16x8*)kp, K1 = *(const LAS bf16x8*)(kp + 32);
            f32x4 z;
#pragma unroll
            for (int r = 0; r < 4; ++r) z[r] = fmaf(slope, (float)(16 * t9 + r), -c0);
            z = __builtin_amdgcn_mfma_f32_16x16x32_bf16(K0, Q0, z, 0, 0, 0);
            sc[t9] = __builtin_amdgcn_mfma_f32_16x16x32_bf16(K1, Q1, z, 0, 0, 0);
        }
        { const int d0 = r16 - 4 * g;
#pragma unroll
          for (int r = 0; r < 4; ++r) { if (d0 - r >= 0) sc[0][r] = -1e30f; if (d0 - r < 0) sc[8][r] = -1e30f; } }
        if (n == 0) {
#pragma unroll
            for (int t9 = 0; t9 < 9; ++t9)
#pragma unroll
                for (int r = 0; r < 4; ++r) if (q0 + 16 * t9 + 4 * g + r < 128) sc[t9][r] = -1e30f;
        }
        float mx = sink;
#pragma unroll
        for (int t9 = 0; t9 < 9; ++t9)
#pragma unroll
            for (int r = 0; r < 4; ++r) mx = fmaxf(mx, sc[t9][r]);
        mx = fmaxf(mx, __shfl_xor(mx, 16)); mx = fmaxf(mx, __shfl_xor(mx, 32));
        float sum = 0.f;
#pragma unroll
        for (int t9 = 0; t9 < 9; ++t9)
#pragma unroll
            for (int r = 0; r < 4; ++r) { const float e = __builtin_amdgcn_exp2f(sc[t9][r] - mx); sc[t9][r] = e; sum += e; }
        sum += __shfl_xor(sum, 16); sum += __shfl_xor(sum, 32);
        const float inv = __builtin_amdgcn_rcpf(sum + __builtin_amdgcn_exp2f(sink - mx));
        bf16x8 PB[5];
#pragma unroll
        for (int sl = 0; sl < 5; ++sl) {
            u32x4 w; w.x = pk2(sc[2 * sl][0], sc[2 * sl][1]); w.y = pk2(sc[2 * sl][2], sc[2 * sl][3]);
            if (sl < 4) { w.z = pk2(sc[2 * sl + 1][0], sc[2 * sl + 1][1]); w.w = pk2(sc[2 * sl + 1][2], sc[2 * sl + 1][3]); } else { w.z = 0u; w.w = 0u; }
            PB[sl] = __builtin_bit_cast(bf16x8, w);
        }
        f32x4 o[4];
#pragma unroll
        for (int dt = 0; dt < 4; ++dt) {
            o[dt] = (f32x4){0.f, 0.f, 0.f, 0.f};
#pragma unroll
            for (int sl = 0; sl < 5; ++sl) {
                const LAS bf16_t* vp = VT + (dt * 16 + r16) * ATT_VS + q0 + 32 * sl + 4 * g;
                const u32x2 lo = *(const LAS u32x2*)vp, hi = *(const LAS u32x2*)(vp + 16);
                u32x4 a; a.x = lo.x; a.y = lo.y; a.z = hi.x; a.w = hi.y;
                o[dt] = __builtin_amdgcn_mfma_f32_16x16x32_bf16(__builtin_bit_cast(bf16x8, a), PB[sl], o[dt], 0, 0, 0);
            }
        }
#pragma unroll
        for (int dt = 0; dt < 4; ++dt) { u32x2 w; w.x = pk2(o[dt][0] * inv, o[dt][1] * inv); w.y = pk2(o[dt][2] * inv, o[dt][3] * inv);
            *(u32x2*)(OA + qrow * 512 + head * 64 + dt * 16 + 4 * g) = w; }
        __builtin_amdgcn_sched_barrier(0);
    }
}

__device__ __forceinline__ void p5_ln_router(const Args& a, LAS unsigned char* lds) {
    const int tid = threadIdx.x, lane = tid & 63, wave = tid >> 6;
    unsigned char* ws = a.ws;
    const float* pre1 = a.out; bf16_t* X1B = (bf16_t*)(ws + WS_RA);
    const float* g1 = a.in[8]; const float* b1 = a.in[9];
    const float* rgw = a.in[10]; const float* rgb = a.in[11]; const float* rew = a.in[12]; const float* reb = a.in[13];
    unsigned* ctl = (unsigned*)(ws + WS_CTL); int* slot = (int*)(ws + WS_SLOT); float* asgw = (float*)(ws + WS_ASGW);
    LAS int* hist = (LAS int*)(lds);
    LAS int* base = hist + 32;
    LAS int* se = base + 32;
    LAS int* sr = se + 128;
    LAS float* sw = (LAS float*)(sr + 128);
    f32x4 gv[4], bv[4];
#pragma unroll
    for (int j = 0; j < 4; ++j) { gv[j] = *(const f32x4*)(g1 + 4 * lane + 256 * j); bv[j] = *(const f32x4*)(b1 + 4 * lane + 256 * j); }
    for (int it = blockIdx.x; it < T_ / 64; it += gridDim.x) {
        __syncthreads();
        if (tid < 32) hist[tid] = 0;
        __syncthreads();
        for (int rr = 0; rr < 8; ++rr) {
            const int rl = wave * 8 + rr; const size_t row = (size_t)it * 64 + rl;
            f32x4 v[4]; float s = 0.f;
#pragma unroll
            for (int j = 0; j < 4; ++j) { v[j] = *(const f32x4*)(pre1 + row * DM + 4 * lane + 256 * j); s += (v[j][0] + v[j][1]) + (v[j][2] + v[j][3]); }
            const float mean = wave_sum(s) * (1.f / DM); float s2 = 0.f;
#pragma unroll
            for (int j = 0; j < 4; ++j) { v[j] = v[j] - mean; s2 += (v[j][0] * v[j][0] + v[j][1] * v[j][1]) + (v[j][2] * v[j][2] + v[j][3] * v[j][3]); }
            const float rstd = rsqrtf(wave_sum(s2) * (1.f / DM) + LN_EPS);
#pragma unroll
            for (int j = 0; j < 4; ++j) { v[j] = v[j] * rstd * gv[j] + bv[j];
                u32x2 w; w.x = pk2(v[j][0], v[j][1]); w.y = pk2(v[j][2], v[j][3]); *(u32x2*)(X1B + row * DM + 4 * lane + 256 * j) = w; }
            float lg[36];
#pragma unroll
            for (int o = 0; o < 36; ++o) lg[o] = 0.f;
#pragma unroll
            for (int j = 0; j < 4; ++j)
#pragma unroll
                for (int c = 0; c < 4; ++c) { const int k = 4 * lane + 256 * j + c; const float xv = v[j][c];
                    const f32x4 wg = *(const f32x4*)(rgw + (size_t)k * 4);
#pragma unroll
                    for (int o = 0; o < 4; ++o) lg[o] += xv * wg[o];
#pragma unroll
                    for (int q = 0; q < 8; ++q) { const f32x4 we = *(const f32x4*)(rew + (size_t)k * 32 + 4 * q);
#pragma unroll
                        for (int o = 0; o < 4; ++o) lg[4 + 4 * q + o] += xv * we[o]; }
                    asm volatile("" ::: "memory"); }
#pragma unroll
            for (int o = 0; o < 36; ++o) lg[o] = wave_sum(lg[o]);
            if (lane == 0) {
                float gl[4]; int gs = 0; float gm;
#pragma unroll
                for (int o = 0; o < 4; ++o) gl[o] = lg[o] + rgb[o];
                gm = gl[0];
#pragma unroll
                for (int o = 1; o < 4; ++o) if (gl[o] > gm) { gm = gl[o]; gs = o; }
                float gsum = 0.f;
#pragma unroll
                for (int o = 0; o < 4; ++o) gsum += __expf(gl[o] - gm);
                const float gw = 1.f / gsum;
                float el[8];
#pragma unroll
                for (int o = 0; o < 8; ++o) { float t = 0.f;
#pragma unroll
                    for (int q = 0; q < 4; ++q) t = (gs == q) ? (lg[4 + 8 * q + o] + reb[8 * q + o]) : t;
                    el[o] = t; }
                int i1 = 0; float m1 = el[0];
#pragma unroll
                for (int o = 1; o < 8; ++o) if (el[o] > m1) { m1 = el[o]; i1 = o; }
                int i2 = -1; float m2 = -3.0e38f;
#pragma unroll
                for (int o = 0; o < 8; ++o) if (o != i1 && el[o] > m2) { m2 = el[o]; i2 = o; }
                const float e2 = __expf(m2 - m1); const float w1 = gw / (1.f + e2), w2 = gw * e2 / (1.f + e2);
                const int x1 = gs * 8 + i1, x2 = gs * 8 + i2;
                se[rl * 2] = x1; se[rl * 2 + 1] = x2; sw[rl * 2] = w1; sw[rl * 2 + 1] = w2;
                sr[rl * 2] = atomicAdd((int*)(hist + x1), 1); sr[rl * 2 + 1] = atomicAdd((int*)(hist + x2), 1);
            }
        }
        __syncthreads();
        if (tid < 32) { const int hcount = hist[tid]; base[tid] = hcount > 0 ? (int)atomicAdd(ctl + CW_CNT + tid, (unsigned)hcount) : 0; }
        __syncthreads();
        if (tid < 128) { const int e = se[tid]; const int pos = base[e] + sr[tid]; const int asg = (it * 64 + (tid >> 1)) * 2 + (tid & 1);
            slot[(size_t)e * CAP + pos] = asg; asgw[asg] = sw[tid]; }
    }
}

__device__ __forceinline__ unsigned hi16(float f) { return f2bf(f); }
__device__ __forceinline__ void p5_ln_router_mfma(const Args& a, LAS unsigned char* lds) {
    const int tid = threadIdx.x, lane = tid & 63, wave = __builtin_amdgcn_readfirstlane(tid >> 6), r16 = lane & 15, g = lane >> 4;
    unsigned char* ws = a.ws;
    const bf16_t* pre1 = (const bf16_t*)a.out; bf16_t* X1B = (bf16_t*)(ws + WS_RA);
    const float* rgw = a.in[10]; const float* rgb = a.in[11]; const float* rew = a.in[12]; const float* reb = a.in[13];
    unsigned* ctl = (unsigned*)(ws + WS_CTL); int* slot = (int*)(ws + WS_SLOT); float* asgw = (float*)(ws + WS_ASGW); int* asgep = (int*)(ws + WS_ASGEP);
    LAS float* sgam = (LAS float*)lds;
    LAS float* sbet = sgam + 1024;
    LAS f32x2* red = (LAS f32x2*)(lds + 8192);
    LAS float* part = (LAS float*)(lds + 9216);
    LAS float* lgs = (LAS float*)(lds + 33792);
    LAS int* hist = (LAS int*)(lds + 36096);
    LAS int* base = hist + 32;
    LAS int* sel_e = (LAS int*)(lds + 36608);
    LAS int* sel_r = sel_e + 2048;
    LAS float* sel_w = (LAS float*)(sel_r + 2048);
    __syncthreads();
    for (int i = tid; i < 1024; i += NTHREADS) { sgam[i] = a.in[8][i]; sbet[i] = a.in[9][i]; }
    if (tid < 32) hist[tid] = 0;
    const int kb = 128 * wave + 8 * g;
    bf16x8 WH[4][3], WL[4][3];
#pragma unroll
    for (int ks = 0; ks < 4; ++ks)
#pragma unroll
        for (int nt = 0; nt < 3; ++nt) {
            const int o = 16 * nt + r16;
            unsigned h[8], l[8];
#pragma unroll
            for (int j = 0; j < 8; ++j) { const int k = kb + 32 * ks + j;
                float w = 0.f; if (o < 4) w = rgw[(size_t)k * 4 + o]; else if (o < 36) w = rew[(size_t)k * 32 + (o - 4)];
                h[j] = f2bf(w); l[j] = f2bf(w - __uint_as_float(h[j] << 16)); }
            u32x4 ph, pl; ph.x = h[0] | (h[1] << 16); ph.y = h[2] | (h[3] << 16); ph.z = h[4] | (h[5] << 16); ph.w = h[6] | (h[7] << 16);
            pl.x = l[0] | (l[1] << 16); pl.y = l[2] | (l[3] << 16); pl.z = l[4] | (l[5] << 16); pl.w = l[6] | (l[7] << 16);
            WH[ks][nt] = __builtin_bit_cast(bf16x8, ph); WL[ks][nt] = __builtin_bit_cast(bf16x8, pl);
        }
    __syncthreads();
    const int NIT = T_ / 16;
    u32x4 xc[4], xn[4];
    int it = blockIdx.x, jj = 0;
    if (it < NIT) {
#pragma unroll
        for (int ks = 0; ks < 4; ++ks) xn[ks] = *(const u32x4*)(pre1 + (size_t)(it * 16 + r16) * DM + kb + 32 * ks);
    }
    for (; it < NIT; it += gridDim.x, ++jj) {
#pragma unroll
        for (int ks = 0; ks < 4; ++ks) xc[ks] = xn[ks];
        const int itn = it + gridDim.x;
        if (itn < NIT) {
#pragma unroll
            for (int ks = 0; ks < 4; ++ks) xn[ks] = *(const u32x4*)(pre1 + (size_t)(itn * 16 + r16) * DM + kb + 32 * ks);
        }
        float s = 0.f, s2 = 0.f;
#pragma unroll
        for (int ks = 0; ks < 4; ++ks)
#pragma unroll
            for (int c = 0; c < 4; ++c) { const float v0 = bflo(xc[ks][c]), v1 = bfhi(xc[ks][c]); s += v0 + v1; s2 = fmaf(v0, v0, s2); s2 = fmaf(v1, v1, s2); }
        s += __shfl_xor(s, 16); s2 += __shfl_xor(s2, 16); s += __shfl_xor(s, 32); s2 += __shfl_xor(s2, 32);
        if (g == 0) red[wave * 16 + r16] = (f32x2){s, s2};
        __syncthreads();
        float S = 0.f, S2 = 0.f;
#pragma unroll
        for (int w = 0; w < 8; ++w) { const f32x2 t = red[w * 16 + r16]; S += t.x; S2 += t.y; }
        const float mean = S * (1.f / DM); const float rstd = rsqrtf(fmaxf(S2 * (1.f / DM) - mean * mean, 0.f) + LN_EPS);
        f32x4 acc[3];
#pragma unroll
        for (int nt = 0; nt < 3; ++nt) acc[nt] = (f32x4){0.f, 0.f, 0.f, 0.f};
#pragma unroll
        for (int ks = 0; ks < 4; ++ks) {
            float y[8];
#pragma unroll
            for (int q = 0; q < 2; ++q) { const f32x4 gm = *(const LAS f32x4*)(sgam + kb + 32 * ks + 4 * q), bt = *(const LAS f32x4*)(sbet + kb + 32 * ks + 4 * q);
#pragma unroll
                for (int c = 0; c < 4; ++c) { const unsigned w = xc[ks][2 * q + (c >> 1)]; const float xv = (c & 1) ? bfhi(w) : bflo(w); y[4 * q + c] = (xv - mean) * rstd * gm[c] + bt[c]; } }
            unsigned h[8], l[8];
#pragma unroll
            for (int j = 0; j < 8; ++j) { h[j] = f2bf(y[j]); l[j] = f2bf(y[j] - __uint_as_float(h[j] << 16)); }
            u32x4 ph, pl; ph.x = h[0] | (h[1] << 16); ph.y = h[2] | (h[3] << 16); ph.z = h[4] | (h[5] << 16); ph.w = h[6] | (h[7] << 16);
            pl.x = l[0] | (l[1] << 16); pl.y = l[2] | (l[3] << 16); pl.z = l[4] | (l[5] << 16); pl.w = l[6] | (l[7] << 16);
            *(u32x4*)(X1B + (size_t)(it * 16 + r16) * DM + kb + 32 * ks) = ph;
            const bf16x8 AH = __builtin_bit_cast(bf16x8, ph), AL = __builtin_bit_cast(bf16x8, pl);
#pragma unroll
            for (int nt = 0; nt < 3; ++nt) {
                acc[nt] = __builtin_amdgcn_mfma_f32_16x16x32_bf16(AH, WH[ks][nt], acc[nt], 0, 0, 0);
                acc[nt] = __builtin_amdgcn_mfma_f32_16x16x32_bf16(AL, WH[ks][nt], acc[nt], 0, 0, 0);
                acc[nt] = __builtin_amdgcn_mfma_f32_16x16x32_bf16(AH, WL[ks][nt], acc[nt], 0, 0, 0);
            }
        }
#pragma unroll
        for (int nt = 0; nt < 3; ++nt)
#pragma unroll
            for (int r = 0; r < 4; ++r) part[(wave * 16 + 4 * g + r) * 48 + 16 * nt + r16] = acc[nt][r];
        __syncthreads();
        { const int row = tid >> 5, c = tid & 31; float t = 0.f, t2 = 0.f;
#pragma unroll
          for (int w = 0; w < 8; ++w) { t += part[(w * 16 + row) * 48 + 4 + c]; if (c < 4) t2 += part[(w * 16 + row) * 48 + c]; }
          lgs[row * 36 + 4 + c] = t; if (c < 4) lgs[row * 36 + c] = t2; }
        __syncthreads();
        if (tid < 16) {
            const LAS float* lg = lgs + tid * 36;
            float gl[4]; int gs = 0;
#pragma unroll
            for (int o = 0; o < 4; ++o) gl[o] = lg[o] + rgb[o];
            float gm = gl[0];
#pragma unroll
            for (int o = 1; o < 4; ++o) if (gl[o] > gm) { gm = gl[o]; gs = o; }
            float gsum = 0.f;
#pragma unroll
            for (int o = 0; o < 4; ++o) gsum += __expf(gl[o] - gm);
            const float gw = 1.f / gsum;
            float el[8];
#pragma unroll
            for (int o = 0; o < 8; ++o) el[o] = lg[4 + gs * 8 + o] + reb[gs * 8 + o];
            int i1 = 0; float m1 = el[0];
#pragma unroll
            for (int o = 1; o < 8; ++o) if (el[o] > m1) { m1 = el[o]; i1 = o; }
            int i2 = -1; float m2 = -3.0e38f;
#pragma unroll
            for (int o = 0; o < 8; ++o) if (o != i1 && el[o] > m2) { m2 = el[o]; i2 = o; }
            const float e2 = __expf(m2 - m1); const float w1 = gw / (1.f + e2), w2 = gw * e2 / (1.f + e2);
            const int x1 = gs * 8 + i1, x2 = gs * 8 + i2; const int si = (jj * 16 + tid) * 2;
            sel_e[si] = x1; sel_e[si + 1] = x2; sel_w[si] = w1; sel_w[si + 1] = w2;
            sel_r[si] = atomicAdd((int*)(hist + x1), 1); sel_r[si + 1] = atomicAdd((int*)(hist + x2), 1);
        }
    }
    __syncthreads();
    if (tid < 32) { const int hcount = hist[tid]; base[tid] = hcount > 0 ? (int)atomicAdd(ctl + CW_CNT + tid, (unsigned)hcount) : 0; }
    __syncthreads();
    for (int idx = tid; idx < jj * 32; idx += NTHREADS) {
        const int j2 = idx >> 5, rem = idx & 31; const int token = (blockIdx.x + j2 * gridDim.x) * 16 + (rem >> 1); const int asg = token * 2 + (rem & 1);
        const int e = sel_e[idx]; const int pos = base[e] + sel_r[idx];
        slot[(size_t)e * CAP + pos] = asg; asgw[asg] = sel_w[idx]; asgep[asg] = e | (pos << 5);
    }
}

__device__ __forceinline__ void p7_final(const Args& a, const LAS int* tp) {
    const int tid = threadIdx.x, lane = tid & 63, wave = tid >> 6;
    const bf16_t* X1B = (const bf16_t*)(a.ws + WS_RA); const bf16_t* Y = (const bf16_t*)(a.ws + WS_RB);
    const float* asgw = (const float*)(a.ws + WS_ASGW); const int* asgep = (const int*)(a.ws + WS_ASGEP);
    const float* g2 = a.in[17]; const float* b2 = a.in[18];
    f32x4 gv[4], bv[4];
#pragma unroll
    for (int j = 0; j < 4; ++j) { gv[j] = *(const f32x4*)(g2 + 4 * lane + 256 * j); bv[j] = *(const f32x4*)(b2 + 4 * lane + 256 * j); }
    const int gw = blockIdx.x * NWAVES + wave, NGW = gridDim.x * NWAVES;
    const int per = (T_ + NGW - 1) / NGW;
    for (int r0 = gw * per; r0 < min(T_, (gw + 1) * per); r0 += 32) {
        int yr0 = 0, yr1 = 0; float w0 = 0.f, w1 = 0.f;
        if (lane < 32 && r0 + lane < T_) { const int t = r0 + lane; const int p0 = asgep[2 * t], p1 = asgep[2 * t + 1];
            yr0 = tp[p0 & 31] * BM + (p0 >> 5); yr1 = tp[p1 & 31] * BM + (p1 >> 5); w0 = asgw[2 * t]; w1 = asgw[2 * t + 1]; }
        const int nr = min(32, min(T_, (gw + 1) * per) - r0);
        for (int jj = 0; jj < nr; jj += 2) {
            f32x4 v[2][4]; float s[2];
#pragma unroll
            for (int q = 0; q < 2; ++q) {
                const int jq = min(jj + q, nr - 1); const int row = r0 + jq;
                const int ya = __shfl(yr0, jq), yb = __shfl(yr1, jq); const float wa = __shfl(w0, jq), wb = __shfl(w1, jq);
                s[q] = 0.f;
#pragma unroll
                for (int j = 0; j < 4; ++j) {
                    const u32x2 xw = *(const u32x2*)(X1B + (size_t)row * DM + 4 * lane + 256 * j);
                    const u32x2 y0 = *(const u32x2*)(Y + (size_t)ya * DM + 4 * lane + 256 * j);
                    const u32x2 y1 = *(const u32x2*)(Y + (size_t)yb * DM + 4 * lane + 256 * j);
                    v[q][j][0] = DN_ALPHA * bflo(xw.x) + (wa * bflo(y0.x) + wb * bflo(y1.x)); v[q][j][1] = DN_ALPHA * bfhi(xw.x) + (wa * bfhi(y0.x) + wb * bfhi(y1.x));
                    v[q][j][2] = DN_ALPHA * bflo(xw.y) + (wa * bflo(y0.y) + wb * bflo(y1.y)); v[q][j][3] = DN_ALPHA * bfhi(xw.y) + (wa * bfhi(y0.y) + wb * bfhi(y1.y));
                    s[q] += (v[q][j][0] + v[q][j][1]) + (v[q][j][2] + v[q][j][3]);
                }
            }
#pragma unroll
            for (int q = 0; q < 2; ++q) {
                if (jj + q < nr) {
                    const int row = r0 + jj + q;
                    const float mean = wave_sum(s[q]) * (1.f / DM); float s2 = 0.f;
#pragma unroll
                    for (int j = 0; j < 4; ++j) { v[q][j] = v[q][j] - mean; s2 += (v[q][j][0] * v[q][j][0] + v[q][j][1] * v[q][j][1]) + (v[q][j][2] * v[q][j][2] + v[q][j][3] * v[q][j][3]); }
                    const float rstd = rsqrtf(wave_sum(s2) * (1.f / DM) + LN_EPS);
#pragma unroll
                    for (int j = 0; j < 4; ++j) *(f32x4*)(a.out + (size_t)row * DM + 4 * lane + 256 * j) = v[q][j] * rstd * gv[j] + bv[j];
                }
            }
        }
    }
}

__device__ __forceinline__ void moe_tables(const Args& a, LAS unsigned char* lds) {
    LAS int* cn = (LAS int*)(lds + MISC_OFF); LAS int* tp = cn + 32;
    const unsigned* ctl = (const unsigned*)(a.ws + WS_CTL);
    __syncthreads();
    if (threadIdx.x < 32) cn[threadIdx.x] = (int)__hip_atomic_load(ctl + CW_CNT + threadIdx.x, __ATOMIC_RELAXED, __HIP_MEMORY_SCOPE_AGENT);
    __syncthreads();
    if (threadIdx.x == 0) { int s = 0; for (int e = 0; e < 32; ++e) { tp[e] = s; s += (cn[e] + BM - 1) / BM; } tp[32] = s; }
    __syncthreads();
}

constexpr int NPHASES = 10;
__global__ void __launch_bounds__(NTHREADS, 2) mk_fwd(Args a) {
    extern __shared__ __attribute__((aligned(16))) unsigned char lds_raw[];
    LAS unsigned char* lds = (LAS unsigned char*)lds_raw;
    unsigned char* ws = a.ws;
    const int lo = a.ph_lo, hi = a.ph_hi;
    const int G = gridDim.x, bid = blockIdx.x;
#ifndef PHASE_MASK
#define PHASE_MASK 0x3ff
#endif
#define IN(k) (((PHASE_MASK >> (k)) & 1) && lo <= (k) && (k) < hi)
#if PROBE_PHASE >= 0
    unsigned long long t_lo = 0, t_hi = 0;
#define STAMP(k) do { if ((k) == PROBE_PHASE) t_lo = __builtin_amdgcn_s_memrealtime(); if ((k) == PROBE_PHASE + 1) t_hi = __builtin_amdgcn_s_memrealtime(); } while (0)
#else
#define STAMP(k) do { } while (0)
#endif
#if XCD_BARRIER
#define SEAM(k) do { if (IN(k) && IN((k) + 1) && a.coop) { if (a.coop == 2) cg::this_grid().sync(); else xcd_barrier(xbar); } STAMP((k) + 1); } while (0)
#else
#define SEAM(k) do { if (IN(k) && IN((k) + 1) && a.coop) { cg::this_grid().sync(); } STAMP((k) + 1); } while (0)
#endif
    bf16_t* XB = (bf16_t*)(ws + WS_RA); bf16_t* MG = (bf16_t*)(ws + WS_RA); bf16_t* X1B = (bf16_t*)(ws + WS_RA);
    bf16_t* HB = (bf16_t*)(ws + WS_RB); bf16_t* Yb = (bf16_t*)(ws + WS_RB);
    bf16_t* AB = (bf16_t*)(ws + WS_RC); bf16_t* GB = (bf16_t*)(ws + WS_RD); bf16_t* HM = (bf16_t*)(ws + WS_RD);
    bf16_t* OH = (bf16_t*)(ws + WS_RE); bf16_t* OA = (bf16_t*)(ws + WS_RF);

    volatile LAS unsigned* xst = (volatile LAS unsigned*)(lds + LDS_BYTES - 16);
    if (threadIdx.x == 0) { xst[0] = 0u; xst[1] = 0u; }
    __syncthreads();
    XcdBarrier xbar; xbar.bar = (unsigned*)(ws + WS_CTL) + CW_BAR; xbar.x = 0; xbar.st = xst;
    if (a.coop) xbar = xcd_barrier_post((unsigned*)(ws + WS_CTL) + CW_BAR, xst);
    STAMP(0);
    if (IN(0)) { p0_prologue(a, lds); }
    SEAM(0);
    if (IN(1)) {
        DenseProb P; P.init(XB, ws + WS_WIN, T_, PW, DM, G, bid);
        EpiProj E{HB, AB, GB, (const float*)(ws + WS_LB)};
        gemm_phase<DenseProb, EpiProj>(lds, P, E);
    }
    SEAM(1);
    if (IN(2)) {
        if (bid >= 128) { __syncthreads(); p0_rest(a, lds, (bid - 128) * NWAVES + (int)(threadIdx.x >> 6), (G - 128) * NWAVES); }
#if HGRN_MFMA
        if (bid < 128) hgrn_mfma(lds, HB, a.in[3], OH, bid);
#else
        if (bid < 128) hgrn_naive(lds, HB, a.in[3], OH, bid);
#endif
        unsigned* ctl = (unsigned*)(ws + WS_CTL);
        LAS int* qi = (LAS int*)(lds + MISC_OFF + 1024);
#if ATTN_MFMA
        {
            __syncthreads();
            if (threadIdx.x == 0) { qi[0] = (int)atomicAdd(ctl + CW_ATTQ, 1u); qi[1] = (int)atomicAdd(ctl + CW_ATTQ, 1u); }
            __syncthreads();
            int item = qi[0], nitem = qi[1], par = 0;
            AttnStage stg;
            if (item < 1024) attn_stage_load(stg, AB, item);
            while (item < 1024) {
                if (threadIdx.x == 0) qi[2 + par] = (int)atomicAdd(ctl + CW_ATTQ, 1u);
                attn_mfma(lds, AB, a.in[4], OA, item, stg, nitem < 1024 ? nitem : -1);
                item = nitem; nitem = qi[2 + par]; par ^= 1;
            }
        }
#else
        for (;;) {
            __syncthreads();
            if (threadIdx.x == 0) qi[0] = (int)atomicAdd(ctl + CW_ATTQ, 1u);
            __syncthreads();
            const int item = qi[0];
            if (item >= 1024) break;
            attn_naive(lds, AB, a.in[4], OA, item);
        }
#endif
    }
    SEAM(2);
    if (IN(3)) {
        DenseProb P; P.init(OH, ws + WS_WA, T_, DM, 512, G, bid);
        EpiGate<0> E{MG, GB};
        gemm_phase<DenseProb, EpiGate<0>>(lds, P, E);
    }
    STAMP(4);
    if (IN(4)) {
        DenseProb P; P.init(OA, ws + WS_WB, T_, DM, 512, G, bid);
        EpiGate<1> E{MG, GB};
        gemm_phase<DenseProb, EpiGate<1>>(lds, P, E);
    }
    SEAM(4);
    if (IN(5)) {
        DenseProb P; P.init(MG, ws + WS_WO, T_, DM, DM, G, bid);
        EpiPre1 E{a.in[0], (bf16_t*)a.out};
        gemm_phase<DenseProb, EpiPre1>(lds, P, E);
    }
    SEAM(5);
#if ROUTER_MFMA
    if (IN(6)) { p5_ln_router_mfma(a, lds); }
#else
    if (IN(6)) { p5_ln_router(a, lds); }
#endif
    SEAM(6);
    if (IN(7)) {
        moe_tables(a, lds);
        MoeProb<true> P; P.Abase = (const char*)X1B; P.Bt = (const char*)(ws + WS_WGU); P.K = DM; P.G = G; P.c = bid;
        P.tp = (const LAS int*)(lds + MISC_OFF) + 32; P.cn = (const LAS int*)(lds + MISC_OFF); P.slot = (const int*)(ws + WS_SLOT); P.estride = (size_t)DM * DM * 2;
        EpiSwiGLU E{HM};
        gemm_phase<MoeProb<true>, EpiSwiGLU>(lds, P, E);
    }
    SEAM(7);
    if (IN(8)) {
        moe_tables(a, lds);
        MoeProb<false> P; P.Abase = (const char*)HM; P.Bt = (const char*)(ws + WS_WD); P.K = DE; P.G = G; P.c = bid;
        P.tp = (const LAS int*)(lds + MISC_OFF) + 32; P.cn = (const LAS int*)(lds + MISC_OFF); P.slot = (const int*)(ws + WS_SLOT); P.estride = (size_t)DM * DE * 2;
        EpiDown E{Yb};
        gemm_phase<MoeProb<false>, EpiDown>(lds, P, E);
    }
    SEAM(8);
    if (IN(9)) { moe_tables(a, lds); p7_final(a, (const LAS int*)(lds + MISC_OFF) + 32); }
#if PROBE_SECTION >= 0
    if (bid == 0 && threadIdx.x == 0) { const unsigned long long dt = *(LAS unsigned long long*)(lds + LDS_BYTES - 32);
        const unsigned long long target = __builtin_amdgcn_s_memrealtime() + (unsigned long long)PROBE_MULT * dt;
        while (__builtin_amdgcn_s_memrealtime() < target) __builtin_amdgcn_s_sleep(8); }
#endif
#if PROBE_PHASE >= 0
    STAMP(10);
    if (bid == 0 && threadIdx.x == 0) { const unsigned long long target = __builtin_amdgcn_s_memrealtime() + (unsigned long long)PROBE_MULT * (t_hi - t_lo);
        while (__builtin_amdgcn_s_memrealtime() < target) __builtin_amdgcn_s_sleep(8); }
#endif
#undef IN
#undef SEAM
}

extern "C" void kernel_launch(void* const* d_in, const int* in_sizes, int n_in, void* d_out, int out_size, void* d_ws, size_t ws_size, hipStream_t stream) {
    static int grid = 0;
    if (grid == 0) {
        if (n_in != 19 || out_size != T_ * DM || ws_size < WS_END) { fprintf(stderr, "kernel_launch: unexpected shapes (n_in %d out %d ws %zu)\n", n_in, out_size, ws_size); grid = -1; return; }
        int dev = 0, cus = 0, per_cu = 0;
        (void)hipGetDevice(&dev); (void)hipDeviceGetAttribute(&cus, hipDeviceAttributeMultiprocessorCount, dev);
        (void)hipFuncSetAttribute((const void*)mk_fwd, hipFuncAttributeMaxDynamicSharedMemorySize, LDS_BYTES);
        (void)hipOccupancyMaxActiveBlocksPerMultiprocessor(&per_cu, (const void*)mk_fwd, NTHREADS, LDS_BYTES);
        if (per_cu < 1) { fprintf(stderr, "kernel_launch: occupancy query says %d blocks/CU\n", per_cu); per_cu = 1; }
        (void)hipGetLastError();
        grid = cus * 1;
        fprintf(stderr, "kernel_launch: cus %d per_cu %d grid %d\n", cus, per_cu, grid);
    }
    if (grid < 0) return;
    (void)hipMemsetAsync((char*)d_ws + WS_CTL, 0, 65536, stream);
    Args a{};
    for (int i = 0; i < 19; ++i) a.in[i] = (const float*)d_in[i];
    a.out = (float*)d_out; a.ws = (unsigned char*)d_ws;
#if N_LAUNCH_MODE == 1
    a.ph_lo = 0; a.ph_hi = NPHASES; a.coop = 1;
    void* args[] = {&a};
    hipError_t e = hipLaunchCooperativeKernel((const void*)mk_fwd, dim3(grid), dim3(NTHREADS), args, LDS_BYTES, stream);
    if (e != hipSuccess) fprintf(stderr, "cooperative launch failed: %s (grid %d)\n", hipGetErrorString(e), grid);
#else
    for (int p = 0; p < NPHASES; ++p) {
        a.ph_lo = p; a.ph_hi = p + 1; a.coop = 0;
        hipLaunchKernelGGL(mk_fwd, dim3(grid), dim3(NTHREADS), LDS_BYTES, stream, a);
    }
#endif
}
```
